# Optimizing an MI355X kernel written in HIP

```python
import math
import jax
import jax.numpy as jnp
from jax import lax
import numpy as np

D_MODEL = 4096
BATCH = 2
SEQ = 8192
DEPTH = 4

CTX_LEN = 256
GRID_W = 64
N_BRANCH = 4
MIX_W = D_MODEL // N_BRANCH
HEAD_DIM = 128
ROPE_BASE = 10000.0
Q_BLOCK = 128
NEG_INF = -1e30
EPS = 1e-6

WA_HEADS = MIX_W // HEAD_DIM
WA_KV_HEADS = 2
WA_GROUP = WA_HEADS // WA_KV_HEADS
WINDOW = 128

NA_HEADS = MIX_W // HEAD_DIM
NA_KH = 8
NA_KW = 16

MLA_HEADS = MIX_W // 128
MLA_Q_LORA = 896
MLA_KV_LORA = 512
MLA_NOPE = 128
MLA_ROPE = 64
MLA_V = 128

DIFF_DIM = 64
DIFF_HEADS = MIX_W // (2 * DIFF_DIM)
DIFF_V = 2 * DIFF_DIM

IN_SIZES = (
    WA_HEADS * HEAD_DIM, WA_KV_HEADS * HEAD_DIM, WA_KV_HEADS * HEAD_DIM, MIX_W,
    MIX_W, MIX_W, MIX_W, MIX_W,
    MLA_Q_LORA, MLA_KV_LORA, MLA_ROPE, MIX_W,
    DIFF_HEADS * 2 * DIFF_DIM, DIFF_HEADS * 2 * DIFF_DIM, DIFF_HEADS * DIFF_V, MIX_W,
    N_BRANCH * D_MODEL,
)
N_IN = sum(IN_SIZES)

kernel_name = "hybrid_parallel_branch_diffusion_trunk"


def rms_norm(x, g):
    xf = x.astype(jnp.float32)
    y = xf * lax.rsqrt(jnp.mean(xf * xf, axis=-1, keepdims=True) + EPS)
    return (y * g).astype(x.dtype)


def heads(a, *dims):
    return a.reshape(a.shape[:2] + dims)


def split_columns(p):
    points = [int(v) for v in np.cumsum(IN_SIZES)[:-1]]
    return jnp.split(p, points, axis=-1)


def axial_rope_tables(n_tok, d_rot):
    t = jnp.arange(n_tok, dtype=jnp.int32)
    row = (t // GRID_W).astype(jnp.float32)
    col = (t % GRID_W).astype(jnp.float32)
    n_f = d_rot // 4
    inv = jnp.power(ROPE_BASE, -jnp.arange(n_f, dtype=jnp.float32) / n_f)
    ang = jnp.concatenate([row[:, None] * inv, col[:, None] * inv], axis=-1)
    return jnp.cos(ang), jnp.sin(ang)


def apply_rope(x, cos, sin):
    d2 = x.shape[-1] // 2
    shape = (x.shape[1],) + (1,) * (x.ndim - 3) + (d2,)
    cs = cos.reshape(shape).astype(x.dtype)
    sn = sin.reshape(shape).astype(x.dtype)
    x1, x2 = x[..., :d2], x[..., d2:]
    return jnp.concatenate([x1 * cs - x2 * sn, x2 * cs + x1 * sn], axis=-1)


def softmax_f32(s):
    return jax.nn.softmax(s.astype(jnp.float32), axis=-1)


def sweep_query_blocks(f, *qs):
    B, S = qs[0].shape[:2]
    nb = S // Q_BLOCK
    blocks = tuple(jnp.moveaxis(a.reshape((B, nb, Q_BLOCK) + a.shape[2:]), 1, 0) for a in qs)
    out = lax.map(lambda args: f(*args), blocks)
    out = jnp.moveaxis(out, 0, 1)
    return out.reshape((B, S) + out.shape[3:])


def window_gqa(q, k, v, qc, kc, vc, qn, kn, sink, cos, sin, ctx_out):
    B, S = q.shape[:2]
    C = kc.shape[1]
    nb = S // Q_BLOCK
    G, R, d = WA_KV_HEADS, WA_GROUP, HEAD_DIM
    scale = d ** -0.5
    q = apply_rope(rms_norm(q, qn), cos, sin)
    k = apply_rope(rms_norm(k, kn), cos, sin)
    kc = rms_norm(kc, kn)
    qb = q.reshape(B, nb, Q_BLOCK, G, R, d)

    def band(a):
        ap = jnp.pad(a, ((0, 0), (Q_BLOCK, Q_BLOCK), (0, 0), (0, 0))).reshape(B, nb + 2, Q_BLOCK, G, d)
        return jnp.concatenate([ap[:, :-2], ap[:, 1:-1], ap[:, 2:]], axis=2)

    kb, vb = band(k), band(v)
    q_pos = jnp.arange(S).reshape(nb, Q_BLOCK, 1)
    k_pos = (jnp.arange(nb) * Q_BLOCK - Q_BLOCK)[:, None, None] + jnp.arange(3 * Q_BLOCK)[None, None, :]
    valid = (k_pos >= 0) & (k_pos < S) & (jnp.abs(q_pos - k_pos) <= WINDOW)
    s_lat = jnp.einsum('bnqgrd,bnkgd->bgrnqk', qb, kb).astype(jnp.float32) * scale
    s_lat = jnp.where(valid, s_lat, NEG_INF)
    s_ctx = jnp.einsum('bnqgrd,bcgd->bgrnqc', qb, kc).astype(jnp.float32) * scale
    sink_col = jnp.broadcast_to(sink.astype(jnp.float32).reshape(1, G, R, 1, 1, 1), s_ctx.shape[:-1] + (1,))
    p = softmax_f32(jnp.concatenate([s_lat, s_ctx, sink_col], axis=-1))
    nk = 3 * Q_BLOCK
    o = (jnp.einsum('bgrnqk,bnkgd->bnqgrd', p[..., :nk].astype(v.dtype), vb)
         + jnp.einsum('bgrnqc,bcgd->bnqgrd', p[..., nk:nk + C].astype(v.dtype), vc))
    o = o.reshape(B, S, WA_HEADS * d)
    oc = None
    if ctx_out:
        qcn = rms_norm(qc, qn).reshape(B, C, G, R, d)
        s = jnp.einsum('bqgrd,bkgd->bgrqk', qcn, kc).astype(jnp.float32) * scale
        sc = jnp.broadcast_to(sink.astype(jnp.float32).reshape(1, G, R, 1, 1), s.shape[:-1] + (1,))
        pc = softmax_f32(jnp.concatenate([s, sc], axis=-1))
        oc = jnp.einsum('bgrqk,bkgd->bqgrd', pc[..., :C].astype(vc.dtype), vc).reshape(B, C, WA_HEADS * d)
    return o, oc


def neighbourhood_attn(q, k, v, qc, kc, vc, qn, kn, rpb, rows, ctx_out):
    B, S = q.shape[:2]
    C = kc.shape[1]
    H, d, W = NA_HEADS, HEAD_DIM, GRID_W
    kh = min(NA_KH, rows)
    scale = d ** -0.5
    q = rms_norm(q, qn)
    k = rms_norm(k, kn)
    kc = rms_norm(kc, kn)
    qg = q.reshape(B, rows, W, H, d)
    kg = k.reshape(B, rows, W, H, d)
    vg = v.reshape(B, rows, W, H, d)
    r = jnp.arange(rows)
    row_start = jnp.clip(r - kh // 2, 0, rows - kh)
    key_rows = row_start[:, None] + jnp.arange(kh)[None, :]
    k_rows = kg[:, key_rows]
    v_rows = vg[:, key_rows]
    w = jnp.arange(W)
    col_start = jnp.clip(w - NA_KW // 2, 0, W - NA_KW)
    col_ok = (w[None, :] >= col_start[:, None]) & (w[None, :] < col_start[:, None] + NA_KW)
    dr = key_rows - r[:, None] + (NA_KH - 1)
    dc = jnp.clip(w[None, :] - w[:, None], -(NA_KW - 1), NA_KW - 1) + (NA_KW - 1)
    bias = rpb[:, dr[:, None, :, None], dc[None, :, None, :]]
    s_lat = jnp.einsum('brqhd,brkwhd->bhrqkw', qg, k_rows).astype(jnp.float32) * scale + bias.astype(jnp.float32)
    s_lat = jnp.where(col_ok[:, None, :], s_lat, NEG_INF).reshape(B, H, rows, W, kh * W)
    s_ctx = jnp.einsum('brqhd,bchd->bhrqc', qg, kc).astype(jnp.float32) * scale
    p = softmax_f32(jnp.concatenate([s_lat, s_ctx], axis=-1))
    p_lat = p[..., :kh * W].reshape(B, H, rows, W, kh, W).astype(v.dtype)
    o = (jnp.einsum('bhrqkw,brkwhd->brqhd', p_lat, v_rows)
         + jnp.einsum('bhrqc,bchd->brqhd', p[..., kh * W:].astype(v.dtype), vc))
    o = o.reshape(B, S, H * d)
    oc = None
    if ctx_out:
        qcn = rms_norm(qc, qn)
        pc = softmax_f32(jnp.einsum('bqhd,bkhd->bhqk', qcn, kc) * scale)
        oc = jnp.einsum('bhqk,bkhd->bqhd', pc.astype(vc.dtype), vc).reshape(B, C, H * d)
    return o, oc


def latent_attn(cq, ckv, kpe, cq_c, ckv_c, kpe_c, g_qa, g_kva, w_q_up, w_kv_up,
                qn_nope, qn_pe, kn_nope, kn_pe, cos, sin, ctx_out):
    B, S = cq.shape[:2]
    C = cq_c.shape[1]
    H = MLA_HEADS
    scale = (MLA_NOPE + MLA_ROPE) ** -0.5

    def queries(cqx):
        qh = heads(rms_norm(cqx, g_qa) @ w_q_up, H, MLA_NOPE + MLA_ROPE)
        return rms_norm(qh[..., :MLA_NOPE], qn_nope), rms_norm(qh[..., MLA_NOPE:], qn_pe)

    def keys_values(ckvx, kpex):
        kv = heads(rms_norm(ckvx, g_kva) @ w_kv_up, H, MLA_NOPE + MLA_V)
        return rms_norm(kv[..., :MLA_NOPE], kn_nope), rms_norm(kpex, kn_pe), kv[..., MLA_NOPE:]

    def attend(qn_, qp_, kn_, kp_, vv):
        s = (jnp.einsum('bqhd,bkhd->bhqk', qn_, kn_) + jnp.einsum('bqhd,bkd->bhqk', qp_, kp_)).astype(jnp.float32) * scale
        p = softmax_f32(s).astype(vv.dtype)
        return jnp.einsum('bhqk,bkhd->bqhd', p, vv)

    q_nope, q_pe = queries(cq)
    q_pe = apply_rope(q_pe, cos, sin)
    k_nope, k_pe, v = keys_values(ckv, kpe)
    k_pe = apply_rope(k_pe, cos, sin)
    kn_c, kpe_cn, v_c = keys_values(ckv_c, kpe_c)
    K_nope = jnp.concatenate([k_nope, kn_c], axis=1)
    K_pe = jnp.concatenate([k_pe, kpe_cn], axis=1)
    V = jnp.concatenate([v, v_c], axis=1)
    o = sweep_query_blocks(lambda a, b_: attend(a, b_, K_nope, K_pe, V), q_nope, q_pe).reshape(B, S, H * MLA_V)
    oc = None
    if ctx_out:
        qc_n, qc_p = queries(cq_c)
        oc = attend(qc_n, qc_p, kn_c, kpe_cn, v_c).reshape(B, C, H * MLA_V)
    return o, oc


def diff_attn(q, k, v, qc, kc, vc, qn, kn, lam_q1, lam_k1, lam_q2, lam_k2, subln, lambda_init, cos, sin, ctx_out):
    B, S = q.shape[:2]
    C = kc.shape[1]
    scale = DIFF_DIM ** -0.5
    lam = (jnp.exp(jnp.sum(lam_q1.astype(jnp.float32) * lam_k1.astype(jnp.float32)))
           - jnp.exp(jnp.sum(lam_q2.astype(jnp.float32) * lam_k2.astype(jnp.float32))) + lambda_init)
    q = apply_rope(rms_norm(q, qn), cos, sin)
    k = apply_rope(rms_norm(k, kn), cos, sin)
    kc = rms_norm(kc, kn)

    def attend(qq, kk, vv):
        s = jnp.einsum('bqhid,bkhid->bihqk', qq, kk).astype(jnp.float32) * scale
        p = softmax_f32(s)
        a = (p[:, 0] - lam * p[:, 1]).astype(vv.dtype)
        o = jnp.einsum('bhqk,bkhd->bqhd', a, vv)
        return rms_norm(o, subln) * (1.0 - lambda_init)

    K = jnp.concatenate([k, kc], axis=1)
    V = jnp.concatenate([v, vc], axis=1)
    o = sweep_query_blocks(lambda a: attend(a, K, V), q).reshape(B, S, DIFF_HEADS * DIFF_V)
    oc = None
    if ctx_out:
        oc = attend(rms_norm(qc, qn), kc, vc).reshape(B, C, DIFF_HEADS * DIFF_V)
    return o, oc


def merge_branches(outs, gate_paths, merge_gate, w_branch, w_out):
    mg = merge_gate.reshape(merge_gate.shape[:2] + (N_BRANCH, D_MODEL))
    merged = sum(jax.nn.sigmoid(mg[:, :, i]) * ((outs[i] * jax.nn.silu(gate_paths[i])) @ w_branch[i])
                 for i in range(N_BRANCH))
    return merged @ w_out


def setup_inputs(seed: int = 0) -> dict:
    key = jax.random.key(seed)
    ks = iter(jax.random.split(key, 40))
    L, D = DEPTH, D_MODEL

    def nrm(shape, scale):
        return jax.random.normal(next(ks), shape, jnp.float32) * scale

    def gain(shape):
        return 1.0 + nrm(shape, 0.01)

    return {
        "x": nrm((BATCH, SEQ, D), 1.0),
        "c": nrm((BATCH, D), 1.0),
        "ctx": nrm((BATCH, CTX_LEN, D), 1.0),
        "c_ctx": nrm((D,), 1.0),
        "w_ada": nrm((L, D, 3 * D), 0.5 * D ** -0.5),
        "b_ada": nrm((L, 3 * D), 0.02),
        "g_norm": gain((L, D)),
        "w_in": nrm((L, D, N_IN), D ** -0.5),
        "qn_a": gain((L, HEAD_DIM)),
        "kn_a": gain((L, HEAD_DIM)),
        "sink_a": nrm((L, WA_HEADS), 0.5),
        "qn_b": gain((L, HEAD_DIM)),
        "kn_b": gain((L, HEAD_DIM)),
        "rpb_b": nrm((L, NA_HEADS, 2 * NA_KH - 1, 2 * NA_KW - 1), 0.1),
        "g_qa": gain((L, MLA_Q_LORA)),
        "g_kva": gain((L, MLA_KV_LORA)),
        "w_q_up": nrm((L, MLA_Q_LORA, MLA_HEADS * (MLA_NOPE + MLA_ROPE)), MLA_Q_LORA ** -0.5),
        "w_kv_up": nrm((L, MLA_KV_LORA, MLA_HEADS * (MLA_NOPE + MLA_V)), MLA_KV_LORA ** -0.5),
        "qn_nope": gain((L, MLA_NOPE)),
        "qn_pe": gain((L, MLA_ROPE)),
        "kn_nope": gain((L, MLA_NOPE)),
        "kn_pe": gain((L, MLA_ROPE)),
        "qn_d": gain((L, DIFF_DIM)),
        "kn_d": gain((L, DIFF_DIM)),
        "lam_q1": nrm((L, DIFF_DIM), 0.1),
        "lam_k1": nrm((L, DIFF_DIM), 0.1),
        "lam_q2": nrm((L, DIFF_DIM), 0.1),
        "lam_k2": nrm((L, DIFF_DIM), 0.1),
        "subln_d": gain((L, DIFF_V)),
        "w_branch": nrm((L, N_BRANCH, MIX_W, D), MIX_W ** -0.5),
        "w_out": nrm((L, D, D), D ** -0.5),
    }


def reference(x, c, ctx, c_ctx, w_ada, b_ada, g_norm, w_in, qn_a, kn_a, sink_a,
              qn_b, kn_b, rpb_b, g_qa, g_kva, w_q_up, w_kv_up, qn_nope, qn_pe, kn_nope, kn_pe,
              qn_d, kn_d, lam_q1, lam_k1, lam_q2, lam_k2, subln_d, w_branch, w_out):
    B, S, _ = x.shape
    rows = S // GRID_W
    cos_a, sin_a = axial_rope_tables(S, HEAD_DIM)
    cos_c, sin_c = axial_rope_tables(S, MLA_ROPE)
    cos_d, sin_d = axial_rope_tables(S, DIFF_DIM)
    silu_c = jax.nn.silu(c)
    silu_cc = jax.nn.silu(c_ctx)
    for l in range(DEPTH):
        ctx_out = l < DEPTH - 1
        lambda_init = 0.8 - 0.6 * math.exp(-0.3 * l)
        sh, sc, gt = jnp.split(silu_c @ w_ada[l] + b_ada[l], 3, axis=-1)
        sh_c, sc_c, gt_c = jnp.split(silu_cc @ w_ada[l] + b_ada[l], 3, axis=-1)
        h = rms_norm(x, g_norm[l]) * (1.0 + sc[:, None]) + sh[:, None]
        hc = rms_norm(ctx, g_norm[l]) * (1.0 + sc_c) + sh_c
        (aq, ak, av, ag, bq, bk, bv, bg, cq, ckv, cpe, cg, dq, dk, dv, dg, mg) = split_columns(h @ w_in[l])
        (aq_c, ak_c, av_c, ag_c, bq_c, bk_c, bv_c, bg_c, cq_c, ckv_c, cpe_c, cg_c,
         dq_c, dk_c, dv_c, dg_c, mg_c) = split_columns(hc @ w_in[l])

        ya, ya_c = window_gqa(heads(aq, WA_HEADS, HEAD_DIM), heads(ak, WA_KV_HEADS, HEAD_DIM), heads(av, WA_KV_HEADS, HEAD_DIM),
                              heads(aq_c, WA_HEADS, HEAD_DIM), heads(ak_c, WA_KV_HEADS, HEAD_DIM), heads(av_c, WA_KV_HEADS, HEAD_DIM),
                              qn_a[l], kn_a[l], sink_a[l], cos_a, sin_a, ctx_out)
        yb, yb_c = neighbourhood_attn(heads(bq, NA_HEADS, HEAD_DIM), heads(bk, NA_HEADS, HEAD_DIM), heads(bv, NA_HEADS, HEAD_DIM),
                                      heads(bq_c, NA_HEADS, HEAD_DIM), heads(bk_c, NA_HEADS, HEAD_DIM), heads(bv_c, NA_HEADS, HEAD_DIM),
                                      qn_b[l], kn_b[l], rpb_b[l], rows, ctx_out)
        yc, yc_c = latent_attn(cq, ckv, cpe, cq_c, ckv_c, cpe_c, g_qa[l], g_kva[l], w_q_up[l], w_kv_up[l],
                               qn_nope[l], qn_pe[l], kn_nope[l], kn_pe[l], cos_c, sin_c, ctx_out)
        yd, yd_c = diff_attn(heads(dq, DIFF_HEADS, 2, DIFF_DIM), heads(dk, DIFF_HEADS, 2, DIFF_DIM), heads(dv, DIFF_HEADS, DIFF_V),
                             heads(dq_c, DIFF_HEADS, 2, DIFF_DIM), heads(dk_c, DIFF_HEADS, 2, DIFF_DIM), heads(dv_c, DIFF_HEADS, DIFF_V),
                             qn_d[l], kn_d[l], lam_q1[l], lam_k1[l], lam_q2[l], lam_k2[l], subln_d[l], lambda_init,
                             cos_d, sin_d, ctx_out)

        x = x + gt[:, None] * merge_branches((ya, yb, yc, yd), (ag, bg, cg, dg), mg, w_branch[l], w_out[l])
        if ctx_out:
            ctx = ctx + gt_c * merge_branches((ya_c, yb_c, yc_c, yd_c), (ag_c, bg_c, cg_c, dg_c), mg_c, w_branch[l], w_out[l])
    return x
```

```cpp
#include <hip/hip_runtime.h>
#include <cstdio>
#include <cstdint>

#define LAS __attribute__((address_space(3)))
typedef unsigned short bf16_t;
typedef short bf16x8 __attribute__((ext_vector_type(8)));
typedef short s16x4 __attribute__((ext_vector_type(4)));
typedef float f32x2 __attribute__((ext_vector_type(2)));
typedef float f32x4 __attribute__((ext_vector_type(4)));
typedef float f32x16 __attribute__((ext_vector_type(16)));
typedef unsigned u32x2 __attribute__((ext_vector_type(2)));
typedef unsigned u32x4 __attribute__((ext_vector_type(4)));

#ifndef MK_LAUNCH_PER_PHASE
#define MK_LAUNCH_PER_PHASE 0
#endif

constexpr int DM = 4096, NBATCH = 2, SEQ = 8192, DEPTH = 4, CTXL = 256, GRIDW = 64;
constexpr int MLAT = NBATCH * SEQ, MCTX = NBATCH * CTXL, MTOT = MLAT + MCTX;
constexpr int NIN = 29632, NINP = 29696;
constexpr float LOG2E = 1.4426950408889634f;
constexpr float EPS = 1e-6f;

constexpr size_t al256(size_t x) { return (x + 255) / 256 * 256; }
constexpr size_t WS_CTL = 0;
constexpr size_t WS_MODS = 65536;
constexpr size_t WS_MODP = WS_MODS + al256((size_t)4 * 3 * 12288 * 4);
constexpr size_t WS_ROPE = WS_MODP + al256((size_t)4 * 32 * 3 * 12288 * 4);
constexpr size_t WS_BND = WS_ROPE + al256((size_t)(4096 * 2 + 2048 * 2) * 4);
constexpr size_t WS_WIN = WS_BND + 4096;
constexpr size_t WS_WQ = WS_WIN + (size_t)4 * NINP * 4096 * 2;
constexpr size_t WS_WKV = WS_WQ + (size_t)4 * 1536 * 896 * 2;
constexpr size_t WS_WB = WS_WKV + (size_t)4 * 2048 * 512 * 2;
constexpr size_t WS_WO = WS_WB + (size_t)4 * 4096 * 4096 * 2;
constexpr size_t WS_H = WS_WO + (size_t)4 * 4096 * 4096 * 2;
constexpr size_t WS_QA = WS_H + (size_t)MTOT * 4096 * 2;
constexpr size_t WS_KA = WS_QA + (size_t)MTOT * 1024 * 2;
constexpr size_t WS_VA = WS_KA + (size_t)MTOT * 256 * 2;
constexpr size_t WS_QB = WS_VA + (size_t)MTOT * 256 * 2;
constexpr size_t WS_KB = WS_QB + (size_t)MTOT * 1024 * 2;
constexpr size_t WS_VB = WS_KB + (size_t)MTOT * 1024 * 2;
constexpr size_t WS_CC = WS_VB + (size_t)MTOT * 1024 * 2;
constexpr size_t WS_QD = WS_CC + (size_t)MTOT * 1536 * 2;
constexpr size_t WS_KD = WS_QD + (size_t)MTOT * 1024 * 2;
constexpr size_t WS_VD = WS_KD + (size_t)MTOT * 1024 * 2;
constexpr size_t WS_G4 = WS_VD + (size_t)MTOT * 1024 * 2;
constexpr size_t WS_MG = WS_G4 + (size_t)MTOT * 4096 * 2;
constexpr size_t WS_QUP = WS_MG + (size_t)MTOT * 16384 * 2;
constexpr size_t WS_KVUP = WS_QUP + (size_t)MTOT * 1536 * 2;
constexpr size_t WS_KC = WS_KVUP + (size_t)MTOT * 2048 * 2;
constexpr size_t WS_OD = WS_KC + (size_t)MTOT * 1536 * 2;
constexpr size_t WS_Y = WS_OD + (size_t)MTOT * 2048 * 4;
constexpr size_t WS_MERGED = WS_Y + (size_t)MTOT * 4096 * 2;
constexpr size_t WS_XBUF = WS_MERGED + (size_t)MTOT * 4096 * 2;
constexpr size_t WS_END = WS_XBUF + (size_t)MTOT * 4096 * 4;

__device__ __forceinline__ unsigned cvt_pk_bf16(float lo, float hi) { unsigned r; asm volatile("v_cvt_pk_bf16_f32 %0, %1, %2" : "=v"(r) : "v"(lo), "v"(hi)); return r; }
__device__ __forceinline__ float bf2f(unsigned short b) { return __uint_as_float(((unsigned)b) << 16); }
__device__ __forceinline__ float bflo(unsigned w) { return __uint_as_float(w << 16); }
__device__ __forceinline__ float bfhi(unsigned w) { return __uint_as_float(w & 0xffff0000u); }
__device__ __forceinline__ bf16_t f2bf(float f) { return (bf16_t)(cvt_pk_bf16(f, f) & 0xffffu); }
__device__ __forceinline__ float fast_exp2(float x) { return __builtin_amdgcn_exp2f(x); }
__device__ __forceinline__ float fast_rcp(float x) { return __builtin_amdgcn_rcpf(x); }
__device__ __forceinline__ float silu_f(float v) { return v * fast_rcp(1.0f + fast_exp2(-v * LOG2E)); }
__device__ __forceinline__ float sigm_f(float v) { const float c = fminf(fmaxf(v, -30.f), 30.f); return fast_rcp(1.0f + fast_exp2(-c * LOG2E)); }
__device__ __forceinline__ int lane_id() { return (int)__builtin_amdgcn_mbcnt_hi(~0u, __builtin_amdgcn_mbcnt_lo(~0u, 0u)); }
__device__ __forceinline__ float wave_sum(float v) {
#pragma unroll
    for (int o = 32; o >= 1; o >>= 1) v += __shfl_xor(v, o);
    return v;
}
__device__ __forceinline__ float wave_max(float v) {
#pragma unroll
    for (int o = 32; o >= 1; o >>= 1) v = fmaxf(v, __shfl_xor(v, o));
    return v;
}
__device__ __forceinline__ float half_sum(float v) {
#pragma unroll
    for (int o = 16; o >= 1; o >>= 1) v += __shfl_xor(v, o);
    return v;
}

#define XB_TMO      128
#define XB_XCNT(j)  (256  + 64 * (j))
#define XB_XSUB(j)  (1280 + 64 * (j))
#define XB_XGEN(j)  (2304 + 64 * (j))
#define XB_TOP      3328
#define XB_TOPGEN   3392
#define XCD_BAR_WORDS 3456
#define XB_SPIN_CAP (1u << 22)

__device__ __forceinline__ unsigned xb_ld(unsigned* p)              { return __hip_atomic_load(p, __ATOMIC_RELAXED, __HIP_MEMORY_SCOPE_AGENT); }
__device__ __forceinline__ unsigned xb_add(unsigned* p, unsigned v) { return __hip_atomic_fetch_add(p, v, __ATOMIC_RELAXED, __HIP_MEMORY_SCOPE_AGENT); }
__device__ __forceinline__ unsigned xb_xcc_id() { return (unsigned)__builtin_amdgcn_s_getreg((3 << 11) | 20) & 0xFu; }
#define XB_SPIN(cond, bar) do { unsigned _sp = 0; while (cond) { __builtin_amdgcn_s_sleep(1); \
    if ((++_sp & 255u) == 0u) { if (xb_ld(&(bar)[XB_TMO])) break; if (_sp > XB_SPIN_CAP) { atomicAdd(&(bar)[XB_TMO], 1u); break; } } } } while (0)

struct XcdBarrier { unsigned* bar; unsigned x; volatile LAS unsigned* st; };

__device__ __forceinline__ XcdBarrier xcd_barrier_post(unsigned* bar, volatile LAS unsigned* st, const int wv0) {
    XcdBarrier b; b.bar = bar; b.x = xb_xcc_id(); b.st = st;
    if (wv0 == 0 && lane_id() == 0) (void)xb_add(&bar[XB_XCNT(b.x)], 1u);
    return b;
}
__device__ __forceinline__ void xcd_barrier_complete(unsigned* bar, unsigned x, unsigned& nloc, unsigned& nx) {
    const unsigned G = gridDim.x * gridDim.y * gridDim.z;
    unsigned sum, cnt, mine, sp = 0u;
    for (;;) {
        sum = 0u; cnt = 0u; mine = 0u;
#pragma unroll
        for (unsigned j = 0; j < 16; ++j) { const unsigned c = xb_ld(&bar[XB_XCNT(j)]); sum += c; cnt += (c > 0u) ? 1u : 0u; mine = (j == x) ? c : mine; }
        if (sum == G) break;
        __builtin_amdgcn_s_sleep(1);
        if ((++sp & 255u) == 0u) { if (xb_ld(&bar[XB_TMO])) break; if (sp > XB_SPIN_CAP) { atomicAdd(&bar[XB_TMO], 1u); break; } }
    }
    nloc = mine > 0u ? mine : 1u; nx = cnt > 0u ? cnt : 1u;
}
__device__ __forceinline__ void xcd_barrier(const XcdBarrier& b, const int wv0) {
    asm volatile("s_waitcnt vmcnt(0)" ::: "memory");
    __syncthreads();
    if (wv0 == 0 && lane_id() == 0) {
        unsigned* bar = b.bar;
        __builtin_amdgcn_s_waitcnt(0);
        unsigned nloc = b.st[0], nx = b.st[1];
        if (nloc == 0u) { xcd_barrier_complete(bar, b.x, nloc, nx); b.st[0] = nloc; b.st[1] = nx; }
        const unsigned old = xb_add(&bar[XB_XSUB(b.x)], 1u);
        const unsigned gen = old / nloc;
        if (old + 1u == (gen + 1u) * nloc) {
            __builtin_amdgcn_fence(__ATOMIC_RELEASE, "agent");
            asm volatile("s_waitcnt vmcnt(0)" ::: "memory");
            const unsigned og = xb_add(&bar[XB_TOP], 1u);
            const unsigned tg = og / nx;
            if (og + 1u == (tg + 1u) * nx) xb_add(&bar[XB_TOPGEN], 1u);
            else XB_SPIN(xb_ld(&bar[XB_TOPGEN]) == tg, bar);
            __builtin_amdgcn_fence(__ATOMIC_ACQUIRE, "agent");
            xb_add(&bar[XB_XGEN(b.x)], 1u);
            asm volatile("s_waitcnt vmcnt(0)" ::: "memory");
        } else {
            XB_SPIN(xb_ld(&bar[XB_XGEN(b.x)]) == gen, bar);
            __builtin_amdgcn_fence(__ATOMIC_ACQUIRE, "agent");
            asm volatile("s_waitcnt vmcnt(0)" ::: "memory");
        }
    }
    __syncthreads();
}

namespace pg8 {
constexpr int BM = 256, BK = 64, HALF = 128, HTB = HALF * BK * 2, STAGE_BYTES = 8 * HTB, NXCD = 8, WGM = 8;
__host__ __device__ __forceinline__ int lds_byte(int r, int c) { const int st = (r >> 4) * 2 + (c >> 5), rr = r & 15, cc = c & 31, ob = rr * 64 + cc * 2; return st * 1024 + (ob ^ (((ob >> 9) & 1) << 5)); }
__host__ __device__ __forceinline__ void stage_rc(int b, int& R, int& C) { const int st = b / 1024, sb = b % 1024, swz = sb ^ (((sb >> 9) & 1) << 5); R = (st >> 1) * 16 + swz / 64; C = (st & 1) * 32 + (swz % 64) / 2; }
__host__ __device__ __forceinline__ int perm32(int rho) { const int n = rho >> 4, i = rho & 15; return 8 * (i >> 2) + 4 * n + (i & 3); }

struct Unit { int pm, pn; };
struct Gemm { const bf16_t* A; const bf16_t* Bt; int M, N, K, lda, ldb; };

struct StaticOrder {
    int nM, nN, nwg, G, c;
    __device__ void init(int M, int N, int G_, int c_) { nM = M / BM; nN = N / BM; nwg = nM * nN; G = G_; c = c_; }
    __device__ bool next(int i, Unit& u) const {
        const long L = (long)i * G + c; if (L >= nwg) return false;
        int wgid = (int)L; { const int q = nwg / NXCD, r = nwg % NXCD, xcd = wgid % NXCD, off = wgid / NXCD; wgid = (xcd < r ? xcd * (q + 1) : r * (q + 1) + (xcd - r) * q) + off; }
        const int nig = WGM * nN, gid = wgid / nig, fm = gid * WGM, gsz = (nM - fm) < WGM ? (nM - fm) : WGM;
        u.pm = fm + ((wgid % nig) % gsz); u.pn = (wgid % nig) / gsz; return true;
    }
};
struct NoHook { static constexpr bool ON = false; __device__ __forceinline__ void operator()(f32x4 (&)[2][2][4][2], const Unit&, int, int, int, int, int) const {} };

template <class Epi, class Sched, class Hook>
__device__ __forceinline__ void gemm_phase(LAS unsigned char* lds, const Gemm g, const Sched& S, const Epi& E, const Hook& HK, const int wv0) {
    int tid_ = wv0 * 64 + lane_id(); asm volatile("" : "+v"(tid_));
    const int tid = tid_, wid = __builtin_amdgcn_readfirstlane(tid >> 6), lane = tid & 63, wr = wid >> 2, wc = wid & 3, fr = lane & 15, fq = lane >> 4;
    const int K = g.K, nt = K / BK;
    unsigned voffA[2], voffB[2];
#pragma unroll
    for (int i = 0; i < 2; ++i) { int R, C; stage_rc(tid * 16 + i * 8192, R, C); const int Rb = Epi::PERM ? ((R & ~31) + perm32(R & 31)) : R;
        voffA[i] = (unsigned)(R * g.lda + C) * 2u; voffB[i] = (unsigned)(Rb * g.ldb + C) * 2u; }
    const size_t kstep = (size_t)(BK * 2);
    const size_t hstepA = (size_t)HALF * g.lda * 2, hstepB = (size_t)HALF * g.ldb * 2;
    const size_t tstepA = 2 * hstepA, tstepB = 2 * hstepB;
    const unsigned ldsw = (unsigned)wid * 1024u;
    const int aoff = lds_byte(wr * 64 + fr, fq * 8), boff = lds_byte(wc * 32 + fr, fq * 8);
#define PG8_SA(b, h) (((b) * 2 + (h)) * HTB)
#define PG8_SB(b, h) ((4 + (b) * 2 + (h)) * HTB)
#define PG8_STAGE(bufoff, gbase, voff) do { _Pragma("unroll") for (int _i = 0; _i < 2; ++_i) \
        __builtin_amdgcn_global_load_lds((const unsigned*)((const char*)(gbase) + (voff)[_i]), (LAS unsigned*)(lds + (bufoff) + ldsw + _i * 8192), 16, 0, 0); } while (0)
#define PG8_LDA(dst, b, h) do { _Pragma("unroll") for (int m = 0; m < 4; ++m) _Pragma("unroll") for (int k = 0; k < 2; ++k) dst[m][k] = *(const LAS bf16x8*)(lds + PG8_SA(b, h) + aoff + m * 2048 + k * 1024); } while (0)
#define PG8_LDB(dst, b, h) do { _Pragma("unroll") for (int n = 0; n < 2; ++n) _Pragma("unroll") for (int k = 0; k < 2; ++k) dst[n][k] = *(const LAS bf16x8*)(lds + PG8_SB(b, h) + boff + n * 2048 + k * 1024); } while (0)
#define PG8_MMA(ai, bj, At, Bt) do { __builtin_amdgcn_s_setprio(1); _Pragma("unroll") for (int m = 0; m < 4; ++m) _Pragma("unroll") for (int n = 0; n < 2; ++n) _Pragma("unroll") for (int k = 0; k < 2; ++k) \
        acc[ai][bj][m][n] = __builtin_amdgcn_mfma_f32_16x16x32_bf16(Bt[n][k], At[m][k], acc[ai][bj][m][n], 0, 0, 0); __builtin_amdgcn_s_setprio(0); } while (0)
#define PG8_WAIT_V(n) asm volatile("s_waitcnt vmcnt(" #n ")" ::: "memory")
#define PG8_WAIT_L(n) asm volatile("s_waitcnt lgkmcnt(" #n ")" ::: "memory")
#define PG8_BAR __builtin_amdgcn_s_barrier()
#define PG8_SCHED __builtin_amdgcn_sched_barrier(0)
    Unit cur, nxt; int ui = 0;
    if (!S.next(0, cur)) return;
    f32x4 acc[2][2][4][2];
#pragma unroll
    for (int a = 0; a < 2; ++a)
#pragma unroll
        for (int b = 0; b < 2; ++b)
#pragma unroll
            for (int m = 0; m < 4; ++m)
#pragma unroll
                for (int n = 0; n < 2; ++n) acc[a][b][m][n] = (f32x4){0.f, 0.f, 0.f, 0.f};
    bf16x8 At[4][2], B0[2][2], B1[2][2];
    const char* cA = (const char*)g.A + (size_t)cur.pm * tstepA; const char* cB = (const char*)g.Bt + (size_t)cur.pn * tstepB;
    PG8_STAGE(PG8_SB(0, 0), cB, voffB); PG8_STAGE(PG8_SA(0, 0), cA, voffA); PG8_STAGE(PG8_SB(0, 1), cB + hstepB, voffB); PG8_STAGE(PG8_SA(0, 1), cA + hstepA, voffA);
    if (wr == 1) PG8_BAR;
    PG8_WAIT_V(4); PG8_BAR;
    PG8_STAGE(PG8_SB(1, 0), cB + kstep, voffB); PG8_STAGE(PG8_SA(1, 0), cA + kstep, voffA); PG8_STAGE(PG8_SB(1, 1), cB + hstepB + kstep, voffB);
    PG8_WAIT_V(6); PG8_BAR;
    for (;;) {
        const bool has_next = S.next(ui + 1, nxt);
        const char* nA = has_next ? (const char*)g.A + (size_t)nxt.pm * tstepA : cA; const char* nB = has_next ? (const char*)g.Bt + (size_t)nxt.pn * tstepB : cB;
        for (int t = 0; t < nt; t += 2) {
            const bool last = (t == nt - 2);
            const char* a1 = cA + (size_t)(t + 1) * kstep;
            const char* a2 = last ? nA : cA + (size_t)(t + 2) * kstep; const char* b2 = last ? nB : cB + (size_t)(t + 2) * kstep;
            const char* a3 = a2 + kstep; const char* b3 = b2 + kstep;
            if (Hook::ON) { if (t > 0 && (t & 15) == 0) HK(acc, cur, t >> 4, wr, wc, fr, fq); }
            PG8_LDB(B0, 0, 0); PG8_SCHED; PG8_LDA(At, 0, 0); PG8_STAGE(PG8_SA(1, 1), a1 + hstepA, voffA);
            PG8_WAIT_L(8); PG8_BAR; PG8_WAIT_L(0); PG8_MMA(0, 0, At, B0); PG8_BAR; PG8_SCHED;
            PG8_LDB(B1, 0, 1); PG8_STAGE(PG8_SB(0, 0), b2, voffB);
            PG8_BAR; PG8_WAIT_L(0); PG8_MMA(0, 1, At, B1); PG8_BAR;
            PG8_LDA(At, 0, 1); PG8_STAGE(PG8_SA(0, 0), a2, voffA);
            PG8_BAR; PG8_WAIT_L(0); PG8_MMA(1, 0, At, B0); PG8_BAR; PG8_SCHED;
            PG8_STAGE(PG8_SB(0, 1), b2 + hstepB, voffB);
            PG8_WAIT_V(6); PG8_BAR; PG8_MMA(1, 1, At, B1); PG8_BAR;
            PG8_LDB(B0, 1, 0); PG8_SCHED; PG8_LDA(At, 1, 0); PG8_STAGE(PG8_SA(0, 1), a2 + hstepA, voffA);
            PG8_WAIT_L(8); PG8_BAR; PG8_WAIT_L(0); PG8_MMA(0, 0, At, B0); PG8_BAR; PG8_SCHED;
            PG8_LDB(B1, 1, 1); PG8_STAGE(PG8_SB(1, 0), b3, voffB);
            PG8_BAR; PG8_WAIT_L(0); PG8_MMA(0, 1, At, B1); PG8_BAR;
            PG8_LDA(At, 1, 1); PG8_STAGE(PG8_SA(1, 0), a3, voffA);
            PG8_BAR; PG8_WAIT_L(0); PG8_MMA(1, 0, At, B0); PG8_BAR; PG8_SCHED;
            PG8_STAGE(PG8_SB(1, 1), b3 + hstepB, voffB);
            PG8_WAIT_V(6); PG8_BAR; PG8_MMA(1, 1, At, B1); PG8_BAR;
        }
        E(acc, cur, wr, wc, fr, fq);
        if (!has_next) break;
#pragma unroll
        for (int a = 0; a < 2; ++a)
#pragma unroll
            for (int b = 0; b < 2; ++b)
#pragma unroll
                for (int m = 0; m < 4; ++m)
#pragma unroll
                    for (int n = 0; n < 2; ++n) acc[a][b][m][n] = (f32x4){0.f, 0.f, 0.f, 0.f};
        cur = nxt; cA = nA; cB = nB; ++ui;
    }
    PG8_WAIT_V(0);
    if (wr == 0) PG8_BAR;
    PG8_BAR;
#undef PG8_SA
#undef PG8_SB
#undef PG8_STAGE
#undef PG8_LDA
#undef PG8_LDB
#undef PG8_MMA
#undef PG8_WAIT_V
#undef PG8_WAIT_L
#undef PG8_BAR
#undef PG8_SCHED
}
}

__device__ __forceinline__ void g1_dest(unsigned char* ws, int pn, bf16_t*& base, int& ld, int& col, int& act) {
    act = 0;
    if (pn < 4)        { base = (bf16_t*)(ws + WS_QA); ld = 1024; col = pn * 256; }
    else if (pn == 4)  { base = (bf16_t*)(ws + WS_KA); ld = 256;  col = 0; }
    else if (pn == 5)  { base = (bf16_t*)(ws + WS_VA); ld = 256;  col = 0; }
    else if (pn < 10)  { base = (bf16_t*)(ws + WS_G4); ld = 4096; col = (pn - 6) * 256; act = 1; }
    else if (pn < 14)  { base = (bf16_t*)(ws + WS_QB); ld = 1024; col = (pn - 10) * 256; }
    else if (pn < 18)  { base = (bf16_t*)(ws + WS_KB); ld = 1024; col = (pn - 14) * 256; }
    else if (pn < 22)  { base = (bf16_t*)(ws + WS_VB); ld = 1024; col = (pn - 18) * 256; }
    else if (pn < 26)  { base = (bf16_t*)(ws + WS_G4); ld = 4096; col = 1024 + (pn - 22) * 256; act = 1; }
    else if (pn < 32)  { base = (bf16_t*)(ws + WS_CC); ld = 1536; col = (pn - 26) * 256; }
    else if (pn < 36)  { base = (bf16_t*)(ws + WS_G4); ld = 4096; col = 2048 + (pn - 32) * 256; act = 1; }
    else if (pn < 40)  { base = (bf16_t*)(ws + WS_QD); ld = 1024; col = (pn - 36) * 256; }
    else if (pn < 44)  { base = (bf16_t*)(ws + WS_KD); ld = 1024; col = (pn - 40) * 256; }
    else if (pn < 48)  { base = (bf16_t*)(ws + WS_VD); ld = 1024; col = (pn - 44) * 256; }
    else if (pn < 52)  { base = (bf16_t*)(ws + WS_G4); ld = 4096; col = 3072 + (pn - 48) * 256; act = 1; }
    else               { base = (bf16_t*)(ws + WS_MG); ld = 16384; col = (pn - 52) * 256; act = 2; }
}
struct EpiG1 {
    static constexpr bool PERM = true;
    unsigned char* ws;
    __device__ __forceinline__ void operator()(const f32x4 (&acc)[2][2][4][2], const pg8::Unit& u, int wr, int wc, int fr, int fq) const {
        bf16_t* base; int ld, col, act; g1_dest(ws, u.pn, base, ld, col, act);
        const int row0 = u.pm * 256 + wr * 64 + fr, col0 = col + wc * 32 + 8 * fq;
#pragma unroll
        for (int ai = 0; ai < 2; ++ai)
#pragma unroll
            for (int m = 0; m < 4; ++m) { bf16_t* rowp = base + (size_t)(row0 + ai * 128 + m * 16) * ld + col0;
#pragma unroll
                for (int bj = 0; bj < 2; ++bj) { f32x4 v0 = acc[ai][bj][m][0], v1 = acc[ai][bj][m][1];
                    if (act == 1) {
#pragma unroll
                        for (int j = 0; j < 4; ++j) { v0[j] = silu_f(v0[j]); v1[j] = silu_f(v1[j]); } }
                    else if (act == 2) {
#pragma unroll
                        for (int j = 0; j < 4; ++j) { v0[j] = sigm_f(v0[j]); v1[j] = sigm_f(v1[j]); } }
                    u32x4 w; w.x = cvt_pk_bf16(v0[0], v0[1]); w.y = cvt_pk_bf16(v0[2], v0[3]); w.z = cvt_pk_bf16(v1[0], v1[1]); w.w = cvt_pk_bf16(v1[2], v1[3]);
                    *(u32x4*)(rowp + bj * 128) = w; } }
    }
};
struct EpiPlain {
    static constexpr bool PERM = true;
    bf16_t* O; int ld;
    __device__ __forceinline__ void operator()(const f32x4 (&acc)[2][2][4][2], const pg8::Unit& u, int wr, int wc, int fr, int fq) const {
        const int row0 = u.pm * 256 + wr * 64 + fr, col0 = u.pn * 256 + wc * 32 + 8 * fq;
#pragma unroll
        for (int ai = 0; ai < 2; ++ai)
#pragma unroll
            for (int m = 0; m < 4; ++m) { bf16_t* rowp = O + (size_t)(row0 + ai * 128 + m * 16) * ld + col0;
#pragma unroll
                for (int bj = 0; bj < 2; ++bj) { const f32x4 v0 = acc[ai][bj][m][0], v1 = acc[ai][bj][m][1];
                    u32x4 w; w.x = cvt_pk_bf16(v0[0], v0[1]); w.y = cvt_pk_bf16(v0[2], v0[3]); w.z = cvt_pk_bf16(v1[0], v1[1]); w.w = cvt_pk_bf16(v1[2], v1[3]);
                    *(u32x4*)(rowp + bj * 128) = w; } }
    }
};
struct HookMerge {
    static constexpr bool ON = true;
    const bf16_t* MG;
    __device__ __forceinline__ void operator()(f32x4 (&acc)[2][2][4][2], const pg8::Unit& u, int seg, int wr, int wc, int fr, int fq) const {
        const int row0 = u.pm * 256 + wr * 64 + fr, col0 = u.pn * 256 + wc * 32 + 8 * fq;
#pragma unroll
        for (int ai = 0; ai < 2; ++ai)
#pragma unroll
            for (int m = 0; m < 4; ++m) { const bf16_t* rowp = MG + (size_t)(row0 + ai * 128 + m * 16) * 16384 + col0;
                u32x4 sp[2], sn[2];
#pragma unroll
                for (int bj = 0; bj < 2; ++bj) { sp[bj] = *(const u32x4*)(rowp + (seg - 1) * 4096 + bj * 128); sn[bj] = *(const u32x4*)(rowp + seg * 4096 + bj * 128); }
#pragma unroll
                for (int bj = 0; bj < 2; ++bj) {
                    f32x4 r0, r1;
                    r0[0] = bflo(sp[bj].x) * fast_rcp(bflo(sn[bj].x)); r0[1] = bfhi(sp[bj].x) * fast_rcp(bfhi(sn[bj].x));
                    r0[2] = bflo(sp[bj].y) * fast_rcp(bflo(sn[bj].y)); r0[3] = bfhi(sp[bj].y) * fast_rcp(bfhi(sn[bj].y));
                    r1[0] = bflo(sp[bj].z) * fast_rcp(bflo(sn[bj].z)); r1[1] = bfhi(sp[bj].z) * fast_rcp(bfhi(sn[bj].z));
                    r1[2] = bflo(sp[bj].w) * fast_rcp(bflo(sn[bj].w)); r1[3] = bfhi(sp[bj].w) * fast_rcp(bfhi(sn[bj].w));
                    acc[ai][bj][m][0] *= r0; acc[ai][bj][m][1] *= r1; } }
    }
};
struct EpiMerge {
    static constexpr bool PERM = true;
    const bf16_t* MG; bf16_t* O;
    __device__ __forceinline__ void operator()(const f32x4 (&acc)[2][2][4][2], const pg8::Unit& u, int wr, int wc, int fr, int fq) const {
        const int row0 = u.pm * 256 + wr * 64 + fr, col0 = u.pn * 256 + wc * 32 + 8 * fq;
#pragma unroll
        for (int ai = 0; ai < 2; ++ai)
#pragma unroll
            for (int m = 0; m < 4; ++m) { const size_t row = (size_t)(row0 + ai * 128 + m * 16);
#pragma unroll
                for (int bj = 0; bj < 2; ++bj) { const u32x4 s = *(const u32x4*)(MG + row * 16384 + 3 * 4096 + col0 + bj * 128);
                    const f32x4 v0 = acc[ai][bj][m][0], v1 = acc[ai][bj][m][1];
                    u32x4 w; w.x = cvt_pk_bf16(v0[0] * bflo(s.x), v0[1] * bfhi(s.x)); w.y = cvt_pk_bf16(v0[2] * bflo(s.y), v0[3] * bfhi(s.y));
                    w.z = cvt_pk_bf16(v1[0] * bflo(s.z), v1[1] * bfhi(s.z)); w.w = cvt_pk_bf16(v1[2] * bflo(s.w), v1[3] * bfhi(s.w));
                    *(u32x4*)(O + row * 4096 + col0 + bj * 128) = w; } }
    }
};
struct EpiResid {
    static constexpr bool PERM = false;
    const float* xin; const float* cin; float* xout; float* cout; const float* mods;
    __device__ __forceinline__ void operator()(const f32x4 (&acc)[2][2][4][2], const pg8::Unit& u, int wr, int wc, int fr, int fq) const {
        const int j = u.pm < 32 ? 0 : (u.pm < 64 ? 1 : 2);
        const int rloc = (u.pm < 64 ? u.pm * 256 : (u.pm - 64) * 256) + wr * 64 + fr, col0 = u.pn * 256 + wc * 32 + 4 * fq;
        const float* bi = u.pm < 64 ? xin : cin; float* bo = u.pm < 64 ? xout : cout;
        const float* gt = mods + j * 12288 + 8192 + col0;
        f32x4 gv[2][2];
#pragma unroll
        for (int bj = 0; bj < 2; ++bj)
#pragma unroll
            for (int n = 0; n < 2; ++n) gv[bj][n] = *(const f32x4*)(gt + bj * 128 + n * 16);
#pragma unroll
        for (int ai = 0; ai < 2; ++ai)
#pragma unroll
            for (int m = 0; m < 4; ++m) { const size_t off = (size_t)(rloc + ai * 128 + m * 16) * 4096 + col0;
#pragma unroll
                for (int bj = 0; bj < 2; ++bj)
#pragma unroll
                    for (int n = 0; n < 2; ++n) { const f32x4 b = *(const f32x4*)(bi + off + bj * 128 + n * 16);
                        *(f32x4*)(bo + off + bj * 128 + n * 16) = b + gv[bj][n] * acc[ai][bj][m][n]; }
                asm volatile("" ::: "memory"); }
    }
};

namespace att {
#define SBAR() __builtin_amdgcn_sched_barrier(0)
__device__ __forceinline__ int crowc(int r) { return (r & 3) + 8 * (r >> 2); }
template <int DQK> __device__ __forceinline__ int kaddr(int row, int g) {
    const int r = row & 31;
    if (DQK == 128) { const int f = (r & 7) | ((r >> 1) & 8); return row * 256 + ((g ^ f) << 4); }
    else { const int s = ((r >> 1) & 3) | ((r >> 2) & 4); return row * (DQK * 2) + ((g ^ s) << 4); }
}
__device__ __forceinline__ int v_st(int k, int c) { const int kk = (k & ~0xC) | ((k & 4) << 1) | ((k & 8) >> 1); return ((kk >> 3) * 4 + (c >> 5)) * 512 + ((kk & 7) * 32 + (c & 31)) * 2; }
__device__ __forceinline__ int v_rd_base(int lane) { return ((lane & 3) << 3) | (((lane >> 2) & 3) << 6) | (((lane >> 4) & 1) << 5) | (((lane >> 5) & 1) << 8); }
constexpr int v_rd_off(int d0, int ks, int half) { return d0 * 512 + ks * 4096 + half * 2048; }
template <int OFF> __device__ __forceinline__ s16x4 tr_read(int vb) {
    s16x4 r; asm volatile("ds_read_b64_tr_b16 %0, %1 offset:%2" : "=&v"(r) : "v"(vb), "i"(OFF) : "memory"); return r;
}
template <int D0> __device__ __forceinline__ void pv_one(f32x16& od, int vb, bf16x8 pa0, bf16x8 pa1, bf16x8 pa2, bf16x8 pa3) {
    const s16x4 l0 = tr_read<v_rd_off(D0, 0, 0)>(vb), h0 = tr_read<v_rd_off(D0, 0, 1)>(vb), l1 = tr_read<v_rd_off(D0, 1, 0)>(vb), h1 = tr_read<v_rd_off(D0, 1, 1)>(vb);
    const s16x4 l2 = tr_read<v_rd_off(D0, 2, 0)>(vb), h2 = tr_read<v_rd_off(D0, 2, 1)>(vb), l3 = tr_read<v_rd_off(D0, 3, 0)>(vb), h3 = tr_read<v_rd_off(D0, 3, 1)>(vb);
    asm volatile("s_waitcnt lgkmcnt(0)" ::: "memory"); SBAR();
#define PK(L, H) (bf16x8){L[0], L[1], L[2], L[3], H[0], H[1], H[2], H[3]}
    od = __builtin_amdgcn_mfma_f32_32x32x16_bf16(pa0, PK(l0, h0), od, 0, 0, 0);
    od = __builtin_amdgcn_mfma_f32_32x32x16_bf16(pa1, PK(l1, h1), od, 0, 0, 0);
    od = __builtin_amdgcn_mfma_f32_32x32x16_bf16(pa2, PK(l2, h2), od, 0, 0, 0);
    od = __builtin_amdgcn_mfma_f32_32x32x16_bf16(pa3, PK(l3, h3), od, 0, 0, 0);
#undef PK
}
__device__ __forceinline__ void pv_d0(f32x16* o, int vb, bf16x8 pa0, bf16x8 pa1, bf16x8 pa2, bf16x8 pa3) {
    pv_one<0>(o[0], vb, pa0, pa1, pa2, pa3); pv_one<1>(o[1], vb, pa0, pa1, pa2, pa3); pv_one<2>(o[2], vb, pa0, pa1, pa2, pa3); pv_one<3>(o[3], vb, pa0, pa1, pa2, pa3);
}

constexpr int V_BYTES = 64 * 128 * 2;
constexpr int OFF_K = 2 * V_BYTES;
template <int DQK> constexpr int k_bytes() { return 64 * DQK * 2; }
template <int DQK> constexpr int off_li() { return OFF_K + 2 * k_bytes<DQK>(); }
template <int DQK> constexpr int off_bias() { return off_li<DQK>() + 1024; }
constexpr int BIAS_SLACK = 256;
constexpr int ATT_LDS_MAX = OFF_K + 2 * 64 * 192 * 2 + 1024 + 256 + 15 * 32 * 4 + 512;

struct AU {
    const bf16_t* Q;  int ldq;
    const bf16_t* Kl; const bf16_t* Vl;
    const bf16_t* Kc; const bf16_t* Vc;
    int ldk, ldv, nlat, nt;
    float C, MC, sinkL;
    int m0, m1;
    const float* rpb;
    int out_f32;
    void* out; const bf16_t* gate; int ldo;
};

template <int DQK, int MODE>
__device__ __forceinline__ void attn_unit(const AU& u, LAS unsigned char* lds, const int wv0) {
    constexpr int NQ = DQK / 16, KB = k_bytes<DQK>(), NKP = DQK / 64, GPR = DQK / 8;
    int tid_ = wv0 * 64 + lane_id(); asm volatile("" : "+v"(tid_));
    const int tid = tid_, wid = __builtin_amdgcn_readfirstlane(tid >> 6), lane = tid & 63, r32 = lane & 31, hi = lane >> 5;
    LAS unsigned char* V_lds = lds; LAS unsigned char* K_lds = lds + OFF_K;
    LAS float* li_l = (LAS float*)(lds + off_li<DQK>()) + wid * 32;
    LAS float* biasL = (LAS float*)(lds + off_bias<DQK>() + BIAS_SLACK);
    __syncthreads();
    if (MODE == 2) { if (tid < 480) { const int dr = tid >> 5, dc = tid & 31; biasL[tid] = dc < 31 ? u.rpb[dr * 31 + dc] * LOG2E - u.MC : 0.f; } }
    f32x16 o[4];
#pragma unroll
    for (int d = 0; d < 4; ++d)
#pragma unroll
        for (int r = 0; r < 16; ++r) o[d][r] = 0.f;
    float l_part = 0.f;
    bf16x8 qr[NQ];
    { const bf16_t* Qw = u.Q + (size_t)(wid * 32 + r32) * u.ldq + hi * 8;
#pragma unroll
      for (int d0 = 0; d0 < NQ; ++d0) qr[d0] = *(const bf16x8*)(Qw + d0 * 16); }
    int kgo[NKP], vgo[2];
#pragma unroll
    for (int p = 0; p < NKP; ++p) { const int pos = (wid + 8 * p) * 1024 + lane * 16, row = pos / (DQK * 2), slot = (pos % (DQK * 2)) >> 4, r = row & 31;
        const int g = (DQK == 128) ? (slot ^ ((r & 7) | ((r >> 1) & 8))) : (slot ^ (((r >> 1) & 3) | ((r >> 2) & 4)));
        kgo[p] = row * u.ldk + g * 8; }
#pragma unroll
    for (int p = 0; p < 2; ++p) { const int pos = (wid + 8 * p) * 1024 + lane * 16, sub = pos >> 9, within = pos & 511;
        const int kk = (sub >> 2) * 8 + (within >> 6), k = (kk & ~0xC) | ((kk & 4) << 1) | ((kk & 8) >> 1), cc = (sub & 3) * 32 + ((within & 63) >> 1);
        vgo[p] = k * u.ldv + cc; }
    const int vb0 = (int)(unsigned)(uintptr_t)V_lds + v_rd_base(lane);
    const int nlat = u.nlat, NT = u.nt;
#define TILE_K(j) ((j) < nlat ? u.Kl + (size_t)(j) * 64 * u.ldk : u.Kc + (size_t)((j) - nlat) * 64 * u.ldk)
#define TILE_V(j) ((j) < nlat ? u.Vl + (size_t)(j) * 64 * u.ldv : u.Vc + (size_t)((j) - nlat) * 64 * u.ldv)
#define DMA_K(j) do { const bf16_t* kp_ = TILE_K(j); LAS unsigned char* kd_ = K_lds + ((j) & 1) * KB + wid * 1024; \
        _Pragma("unroll") for (int p = 0; p < NKP; ++p) __builtin_amdgcn_global_load_lds((const unsigned*)(kp_ + kgo[p]), (LAS unsigned*)(kd_ + p * 8192), 16, 0, 0); } while (0)
#define DMA_V(j) do { const bf16_t* vp_ = TILE_V(j); LAS unsigned char* vd_ = V_lds + ((j) & 1) * V_BYTES + wid * 1024; \
        _Pragma("unroll") for (int p = 0; p < 2; ++p) __builtin_amdgcn_global_load_lds((const unsigned*)(vp_ + vgo[p]), (LAS unsigned*)(vd_ + p * 8192), 16, 0, 0); } while (0)
#define LANDED() do { asm volatile("s_waitcnt vmcnt(0)" ::: "memory"); __syncthreads(); } while (0)
#define QKT(P0, P1, b) do { const LAS unsigned char* kb_ = K_lds + (b) * KB; \
        _Pragma("unroll") for (int r = 0; r < 16; ++r) { P0[r] = 0.f; P1[r] = 0.f; } \
        bf16x8 kf_[2][2]; \
        { const int ka_ = kaddr<DQK>(r32, hi); kf_[0][0] = *(const LAS bf16x8*)(kb_ + ka_); kf_[0][1] = *(const LAS bf16x8*)(kb_ + ka_ + 32 * DQK * 2); } \
        _Pragma("unroll") for (int d0 = 0; d0 < NQ; ++d0) { \
            if (d0 + 1 < NQ) { const int ka_ = kaddr<DQK>(r32, (d0 + 1) * 2 + hi); kf_[(d0 + 1) & 1][0] = *(const LAS bf16x8*)(kb_ + ka_); kf_[(d0 + 1) & 1][1] = *(const LAS bf16x8*)(kb_ + ka_ + 32 * DQK * 2); } \
            P0 = __builtin_amdgcn_mfma_f32_32x32x16_bf16(kf_[d0 & 1][0], qr[d0], P0, 0, 0, 0); P1 = __builtin_amdgcn_mfma_f32_32x32x16_bf16(kf_[d0 & 1][1], qr[d0], P1, 0, 0, 0); \
            SBAR(); } } while (0)
    const float C = u.C, nMC = -u.MC;
#define PART1(p0, p1, jj) do { const int j_ = (jj); bool plain = true; \
        if (MODE == 1) { if (j_ < nlat) { plain = false; \
            const int base = u.m0 + 64 * j_ - (wid * 32 + r32) + 128 + 4 * hi; \
            _Pragma("unroll") for (int r = 0; r < 16; ++r) { const int d0_ = base + crowc(r), d1_ = d0_ + 32; \
                p0[r] = ((unsigned)d0_ <= 256u) ? fmaf(p0[r], C, nMC) : -1e30f; p1[r] = ((unsigned)d1_ <= 256u) ? fmaf(p1[r], C, nMC) : -1e30f; } } } \
        if (MODE == 2) { if (j_ < nlat) { plain = false; \
            const int kr = u.m1 + j_, qrow = u.m0 + (wid >> 1); int rs = qrow - 4; rs = rs < 0 ? 0 : (rs > 120 ? 120 : rs); \
            if (kr < rs || kr >= rs + 8) { \
                _Pragma("unroll") for (int r = 0; r < 16; ++r) { p0[r] = -1e30f; p1[r] = -1e30f; } \
            } else { \
                const int wq = (wid & 1) * 32 + r32; int cs = wq - 8; cs = cs < 0 ? 0 : (cs > 48 ? 48 : cs); \
                const LAS float* bl = biasL + (kr - qrow + 7) * 32 + 15 - wq + 4 * hi; \
                const int cb = 4 * hi - cs; \
                _Pragma("unroll") for (int r = 0; r < 16; ++r) { const int k0_ = crowc(r), k1_ = k0_ + 32; \
                    const float b0_ = bl[k0_], b1_ = bl[k1_]; \
                    p0[r] = ((unsigned)(cb + k0_) < 16u) ? fmaf(p0[r], C, b0_) : -1e30f; p1[r] = ((unsigned)(cb + k1_) < 16u) ? fmaf(p1[r], C, b1_) : -1e30f; } \
            } } } \
        if (plain) { _Pragma("unroll") for (int r = 0; r < 16; ++r) { p0[r] = fmaf(p0[r], C, nMC); p1[r] = fmaf(p1[r], C, nMC); } } \
        _Pragma("unroll") for (int r = 0; r < 16; ++r) p0[r] = fast_exp2(p0[r]); } while (0)
    bf16x8 pa0, pa1, pa2, pa3;
#define PK4(P, BASE, OUT) do { const unsigned a0 = cvt_pk_bf16(P[BASE + 0], P[BASE + 1]), a1 = cvt_pk_bf16(P[BASE + 2], P[BASE + 3]);   \
        const unsigned b0 = cvt_pk_bf16(P[BASE + 4], P[BASE + 5]), b1 = cvt_pk_bf16(P[BASE + 6], P[BASE + 7]);                              \
        auto r0 = __builtin_amdgcn_permlane32_swap(a0, b0, false, false); auto r1 = __builtin_amdgcn_permlane32_swap(a1, b1, false, false); \
        u32x4 w = {r0[0], r1[0], r0[1], r1[1]}; OUT = *reinterpret_cast<bf16x8*>(&w); } while (0)
#define PART2(p0, p1) do { \
        _Pragma("unroll") for (int r = 0; r < 16; ++r) p1[r] = fast_exp2(p1[r]); \
        float ps = 0.f; \
        _Pragma("unroll") for (int r = 0; r < 16; ++r) ps += p0[r]; \
        _Pragma("unroll") for (int r = 0; r < 16; ++r) ps += p1[r]; \
        l_part += ps; \
        PK4(p0, 0, pa0); PK4(p0, 8, pa1); PK4(p1, 0, pa2); PK4(p1, 8, pa3); } while (0)
    if constexpr (MODE == 0) {
        f32x16 pA0, pA1, pB0, pB1;
        DMA_K(0); LANDED();
        DMA_K(1); DMA_V(0); SBAR();
        QKT(pA0, pA1, 0); PART1(pA0, pA1, 0);
        LANDED();
        for (int t = 1; t + 1 < NT; t += 2) {
            DMA_K(t + 1); DMA_V(t); SBAR();
            QKT(pB0, pB1, 1);
            PART2(pA0, pA1); SBAR();
            pv_d0(o, vb0, pa0, pa1, pa2, pa3); PART1(pB0, pB1, t);
            LANDED();
            DMA_K(t + 2); DMA_V(t + 1); SBAR();
            QKT(pA0, pA1, 0);
            PART2(pB0, pB1); SBAR();
            pv_d0(o, vb0 + V_BYTES, pa0, pa1, pa2, pa3); PART1(pA0, pA1, t + 1);
            LANDED();
        }
        DMA_V(NT - 1); SBAR();
        QKT(pB0, pB1, 1);
        PART2(pA0, pA1); SBAR();
        pv_d0(o, vb0, pa0, pa1, pa2, pa3); PART1(pB0, pB1, NT - 1);
        LANDED();
        PART2(pB0, pB1); SBAR();
        pv_d0(o, vb0 + V_BYTES, pa0, pa1, pa2, pa3);
    } else {
        f32x16 pA0, pA1;
        DMA_K(0); DMA_V(0); LANDED();
        for (int t = 0; t < NT; ++t) {
            if (t + 1 < NT) { DMA_K(t + 1); DMA_V(t + 1); } SBAR();
            QKT(pA0, pA1, t & 1);
            PART1(pA0, pA1, t); PART2(pA0, pA1); SBAR();
            pv_d0(o, vb0 + (t & 1) * V_BYTES, pa0, pa1, pa2, pa3);
            LANDED();
        }
    }
    { auto rr = __builtin_amdgcn_permlane32_swap(__float_as_uint(l_part), __float_as_uint(l_part), false, false);
      l_part = __uint_as_float(rr[0]) + __uint_as_float(rr[1]); }
    l_part += fast_exp2(u.sinkL);
    if (hi == 0) li_l[r32] = l_part;
    asm volatile("s_waitcnt lgkmcnt(0)" ::: "memory");
    float rli[16];
#pragma unroll
    for (int r = 0; r < 16; ++r) rli[r] = fast_rcp(li_l[crowc(r) + 4 * hi]);
    {
        int ldo = u.ldo; asm volatile("" : "+s"(ldo));
        const unsigned voff = (unsigned)(4 * hi * ldo + r32);
        if (u.out_f32) {
            float* Ow = (float*)u.out + (size_t)(wid * 32) * ldo;
#pragma unroll
            for (int r = 0; r < 16; ++r) { float* Or = Ow + (size_t)(crowc(r) * ldo);
#pragma unroll
                for (int d0 = 0; d0 < 4; ++d0) Or[voff + d0 * 32] = o[d0][r] * rli[r]; }
        } else {
            bf16_t* Ow = (bf16_t*)u.out + (size_t)(wid * 32) * ldo; const bf16_t* Gw = u.gate + (size_t)(wid * 32) * ldo;
#pragma unroll
            for (int r = 0; r < 16; ++r) { bf16_t* Or = Ow + (size_t)(crowc(r) * ldo); const bf16_t* Gr = Gw + (size_t)(crowc(r) * ldo);
#pragma unroll
                for (int d0 = 0; d0 < 4; ++d0) Or[voff + d0 * 32] = f2bf(o[d0][r] * rli[r] * bf2f(Gr[voff + d0 * 32]));
                asm volatile("" ::: "memory"); }
        }
    }
#undef TILE_K
#undef TILE_V
#undef DMA_K
#undef DMA_V
#undef LANDED
#undef QKT
#undef PART1
#undef PART2
#undef PK4
}
}

struct Args { const float* in[31]; float* out; unsigned char* ws; int ph_lo, ph_hi; };
enum { I_X = 0, I_C, I_CTX, I_CCTX, I_WADA, I_BADA, I_GNORM, I_WIN, I_QNA, I_KNA, I_SINKA, I_QNB, I_KNB, I_RPB, I_GQA, I_GKVA, I_WQUP, I_WKVUP, I_QNNOPE, I_QNPE, I_KNNOPE, I_KNPE,
       I_QND, I_KND, I_LQ1, I_LK1, I_LQ2, I_LK2, I_SUBLN, I_WBR, I_WOUT };
constexpr int GRID = 256, NTHR = 512;
constexpr int LDS_BYTES = pg8::STAGE_BYTES + 256;
constexpr int LDS_MISC = pg8::STAGE_BYTES;

__device__ __forceinline__ void tr_tile_desc(const Args& a, int idx, const float*& src, int& lds_n, bf16_t*& dst, int& ldk, bool& zero) {
    const int l = idx / 19240; int r = idx % 19240; zero = false;
    if (r < 14848) { const int tk = r / 464, tn = r % 464; const int n0d = tn * 64; zero = (n0d == 8128); const int n0s = n0d < 8128 ? n0d : n0d - 64;
        src = a.in[I_WIN] + ((size_t)l * 4096 + tk * 128) * NIN + n0s; lds_n = NIN; dst = (bf16_t*)(a.ws + WS_WIN) + ((size_t)l * NINP + n0d) * 4096 + tk * 128; ldk = 4096; return; }
    r -= 14848;
    if (r < 168) { const int tk = r / 24, tn = r % 24;
        src = a.in[I_WQUP] + ((size_t)l * 896 + tk * 128) * 1536 + tn * 64; lds_n = 1536; dst = (bf16_t*)(a.ws + WS_WQ) + ((size_t)l * 1536 + tn * 64) * 896 + tk * 128; ldk = 896; return; }
    r -= 168;
    if (r < 128) { const int tk = r / 32, tn = r % 32;
        src = a.in[I_WKVUP] + ((size_t)l * 512 + tk * 128) * 2048 + tn * 64; lds_n = 2048; dst = (bf16_t*)(a.ws + WS_WKV) + ((size_t)l * 2048 + tn * 64) * 512 + tk * 128; ldk = 512; return; }
    r -= 128;
    if (r < 2048) { const int br = r / 512, r2 = r % 512, tk = r2 / 64, tn = r2 % 64;
        src = a.in[I_WBR] + (((size_t)l * 4 + br) * 1024 + tk * 128) * 4096 + tn * 64; lds_n = 4096; dst = (bf16_t*)(a.ws + WS_WB) + ((size_t)l * 4096 + tn * 64) * 4096 + br * 1024 + tk * 128; ldk = 4096; return; }
    r -= 2048;
    { const int tk = r / 64, tn = r % 64;
        src = a.in[I_WOUT] + ((size_t)l * 4096 + tk * 128) * 4096 + tn * 64; lds_n = 4096; dst = (bf16_t*)(a.ws + WS_WO) + ((size_t)l * 4096 + tn * 64) * 4096 + tk * 128; ldk = 4096; }
}
__device__ __forceinline__ void phase_prologue(const Args& a, LAS unsigned char* lds, const int wv0) {
    const int tid = wv0 * 64 + lane_id(), bid = blockIdx.x;
    LAS float* T = (LAS float*)lds;
    constexpr int NTILES = 4 * 19240;
    f32x4 rg[4];
    const float* src; int ldn; bf16_t* dst; int ldk; bool zero;
    int t = bid;
    if (t < NTILES) { tr_tile_desc(a, t, src, ldn, dst, ldk, zero);
#pragma unroll
        for (int i = 0; i < 4; ++i) { const int idx = tid + 512 * i, kr = idx >> 4, c4 = (idx & 15) * 4; rg[i] = zero ? (f32x4){0.f, 0.f, 0.f, 0.f} : *(const f32x4*)(src + (size_t)kr * ldn + c4); } }
    for (; t < NTILES; t += GRID) {
#pragma unroll
        for (int i = 0; i < 4; ++i) { const int idx = tid + 512 * i, kr = idx >> 4, c4 = (idx & 15) * 4;
            T[kr * 65 + c4 + 0] = rg[i][0]; T[kr * 65 + c4 + 1] = rg[i][1]; T[kr * 65 + c4 + 2] = rg[i][2]; T[kr * 65 + c4 + 3] = rg[i][3]; }
        __syncthreads();
        bf16_t* dcur = dst; const int ldkc = ldk;
        if (t + GRID < NTILES) { tr_tile_desc(a, t + GRID, src, ldn, dst, ldk, zero);
#pragma unroll
            for (int i = 0; i < 4; ++i) { const int idx = tid + 512 * i, kr = idx >> 4, c4 = (idx & 15) * 4; rg[i] = zero ? (f32x4){0.f, 0.f, 0.f, 0.f} : *(const f32x4*)(src + (size_t)kr * ldn + c4); } }
#pragma unroll
        for (int i = 0; i < 2; ++i) { const int idx = tid + 512 * i, n = idx >> 4, kc = (idx & 15) * 8;
            float v[8];
#pragma unroll
            for (int q = 0; q < 8; ++q) v[q] = T[(kc + q) * 65 + n];
            u32x4 w; w.x = cvt_pk_bf16(v[0], v[1]); w.y = cvt_pk_bf16(v[2], v[3]); w.z = cvt_pk_bf16(v[4], v[5]); w.w = cvt_pk_bf16(v[6], v[7]);
            *(u32x4*)(dcur + (size_t)n * ldkc + kc) = w; }
        __syncthreads();
    }
    LAS float* sv = (LAS float*)lds;
    for (int un = bid; un < 4 * 6 * 32; un += GRID) {
        const int l = un / 192, cb = (un % 192) / 32, ksp = un % 32;
        __syncthreads();
        if (tid < 384) { const int j = tid >> 7, k = ksp * 128 + (tid & 127); const float cv = j < 2 ? a.in[I_C][j * 4096 + k] : a.in[I_CCTX][k]; sv[tid] = silu_f(cv); }
        __syncthreads();
        const float* wp = a.in[I_WADA] + ((size_t)l * 4096 + ksp * 128) * 12288 + cb * 2048 + tid * 4;
        f32x4 a0 = {0.f, 0.f, 0.f, 0.f}, a1 = a0, a2 = a0;
#pragma unroll 8
        for (int k = 0; k < 128; ++k) { const f32x4 w = *(const f32x4*)(wp + (size_t)k * 12288); a0 += w * sv[k]; a1 += w * sv[128 + k]; a2 += w * sv[256 + k]; }
        float* pp = (float*)(a.ws + WS_MODP) + ((size_t)(l * 32 + ksp) * 3) * 12288 + cb * 2048 + tid * 4;
        *(f32x4*)(pp) = a0; *(f32x4*)(pp + 12288) = a1; *(f32x4*)(pp + 2 * 12288) = a2;
    }
}

__device__ __forceinline__ void sincos_acc(float ang, float& c, float& s) {
    const double x = (double)ang;
    const double q = __builtin_rint(x * 0.6366197723675814);
    const double y = x - q * 1.5707963267948966 - q * 6.123233995736766e-17;
    const double y2 = y * y;
    const double sy = y * (1.0 + y2 * (-1.0 / 6 + y2 * (1.0 / 120 + y2 * (-1.0 / 5040 + y2 * (1.0 / 362880 + y2 * (-1.0 / 39916800 + y2 * (1.0 / 6227020800.0)))))));
    const double cy = 1.0 + y2 * (-0.5 + y2 * (1.0 / 24 + y2 * (-1.0 / 720 + y2 * (1.0 / 40320 + y2 * (-1.0 / 3628800 + y2 * (1.0 / 479001600.0))))));
    const int qi = ((int)q) & 3;
    const double sd = (qi == 0) ? sy : (qi == 1) ? cy : (qi == 2) ? -sy : -cy;
    const double cd = (qi == 0) ? cy : (qi == 1) ? -sy : (qi == 2) ? -cy : sy;
    c = (float)cd; s = (float)sd;
}
__device__ __forceinline__ float wave_maxabs(const float* p, int n, int lane) { float m = 0.f; for (int i = lane; i < n; i += 64) m = fmaxf(m, fabsf(p[i])); return wave_max(m); }
__device__ __forceinline__ float wave_dot(const float* p, const float* q, int n, int lane) { float s = 0.f; for (int i = lane; i < n; i += 64) s += p[i] * q[i]; return wave_sum(s); }
__device__ __forceinline__ void phase_mods(const Args& a, const int wv0) {
    const int tid = wv0 * 64 + lane_id(), bid = blockIdx.x, gid = bid * NTHR + tid;
    float* mods = (float*)(a.ws + WS_MODS); const float* mp = (const float*)(a.ws + WS_MODP);
    for (int i = gid; i < 4 * 3 * 12288; i += GRID * NTHR) { const int l = i / 36864, r = i % 36864, j = r / 12288, c = r % 12288;
        float s = a.in[I_BADA][l * 12288 + c];
        for (int ks = 0; ks < 32; ++ks) s += mp[((size_t)(l * 32 + ks) * 3 + j) * 12288 + c];
        mods[i] = s; }
    float* rope = (float*)(a.ws + WS_ROPE);
    if (gid < 4096) { const int pos = gid >> 5, j = gid & 31; double inv = 1.0; for (int q = 0; q < j; ++q) inv *= 0.7498942093324558;
        const float ang = (float)pos * (float)inv; float c, s; sincos_acc(ang, c, s); rope[gid] = c; rope[4096 + gid] = s; }
    else if (gid < 4096 + 2048) { const int g2 = gid - 4096, pos = g2 >> 4, j = g2 & 15; double inv = 1.0; for (int q = 0; q < j; ++q) inv *= 0.5623413251903491;
        const float ang = (float)pos * (float)inv; float c, s; sincos_acc(ang, c, s); rope[8192 + g2] = c; rope[8192 + 2048 + g2] = s; }
    if (bid >= 16 && bid < 20 && tid < 64) {
        const int l = bid - 16, lane = tid; float* bnd = (float*)(a.ws + WS_BND) + l * 32;
        const float SAFE = 1.03f;
        const float mqa = wave_maxabs(a.in[I_QNA] + l * 128, 128, lane), mka = wave_maxabs(a.in[I_KNA] + l * 128, 128, lane);
        const float mqb = wave_maxabs(a.in[I_QNB] + l * 128, 128, lane), mkb = wave_maxabs(a.in[I_KNB] + l * 128, 128, lane);
        const float mqn = wave_maxabs(a.in[I_QNNOPE] + l * 128, 128, lane), mkn = wave_maxabs(a.in[I_KNNOPE] + l * 128, 128, lane);
        const float mqp = wave_maxabs(a.in[I_QNPE] + l * 64, 64, lane), mkp = wave_maxabs(a.in[I_KNPE] + l * 64, 64, lane);
        const float mqd = wave_maxabs(a.in[I_QND] + l * 64, 64, lane), mkd = wave_maxabs(a.in[I_KND] + l * 64, 64, lane);
        const float bA = SAFE * 11.313708498984761f * mqa * mka;
        const float bB = SAFE * 11.313708498984761f * mqb * mkb;
        const float bC = SAFE * 0.07216878364870323f * (128.f * mqn * mkn + 64.f * mqp * mkp);
        const float bD = SAFE * 8.0f * mqd * mkd;
        const float li_[4] = {0.2f, 0.35550906759096934f, 0.4707130183435842f, 0.5560582041556406f};
        const float d1 = wave_dot(a.in[I_LQ1] + l * 64, a.in[I_LK1] + l * 64, 64, lane), d2 = wave_dot(a.in[I_LQ2] + l * 64, a.in[I_LK2] + l * 64, 64, lane);
        for (int h = 0; h < 8; ++h) {
            const float sk = a.in[I_SINKA][l * 8 + h]; const float MA = fmaxf(bA, sk);
            const float mr = wave_maxabs(a.in[I_RPB] + ((size_t)l * 8 + h) * 465, 465, lane);
            if (lane == 0) { bnd[h] = MA * LOG2E; bnd[8 + h] = (bB + mr) * LOG2E; bnd[19 + h] = (sk - MA) * LOG2E; }
        }
        if (lane == 0) { bnd[16] = bC * LOG2E; bnd[17] = bD * LOG2E; bnd[18] = expf(d1) - expf(d2) + li_[l]; }
    }
}

__device__ __forceinline__ void phase_xnorm(const Args& a, int l, const float* xin, const float* cin, const int wv0) {
    int tid_ = wv0 * 64 + lane_id(); asm volatile("" : "+v"(tid_)); const int tid = tid_, lane = tid & 63, wv = blockIdx.x * 8 + (tid >> 6);
    const float* g = a.in[I_GNORM] + l * 4096; const float* mods = (const float*)(a.ws + WS_MODS) + l * 36864;
    bf16_t* H = (bf16_t*)(a.ws + WS_H);
    for (int row = wv; row < MTOT; row += GRID * 8) {
        const float* xr = row < MLAT ? xin + (size_t)row * 4096 : cin + (size_t)(row - MLAT) * 4096;
        const int j = row < SEQ ? 0 : (row < MLAT ? 1 : 2);
        const float* sh = mods + j * 12288; const float* sc = sh + 4096;
        f32x4 v[16]; float ss = 0.f;
#pragma unroll
        for (int i = 0; i < 16; ++i) { v[i] = *(const f32x4*)(xr + (i * 64 + lane) * 4); ss += v[i][0] * v[i][0] + v[i][1] * v[i][1] + v[i][2] * v[i][2] + v[i][3] * v[i][3]; }
        ss = wave_sum(ss);
        const float rs = 1.0f / sqrtf(ss * (1.0f / 4096.f) + EPS);
#pragma unroll
        for (int i = 0; i < 16; ++i) { const int c = (i * 64 + lane) * 4;
            const f32x4 gv = *(const f32x4*)(g + c), scv = *(const f32x4*)(sc + c), shv = *(const f32x4*)(sh + c);
            const f32x4 hv = v[i] * rs * gv * (1.0f + scv) + shv;
            u32x2 w; w.x = cvt_pk_bf16(hv[0], hv[1]); w.y = cvt_pk_bf16(hv[2], hv[3]);
            *(u32x2*)(H + (size_t)row * 4096 + c) = w; }
    }
}

__device__ __forceinline__ void norm128_task(bf16_t* p, const float* gain, bool rope, const float* c128, const float* s128, int grow, int gcol, int lane) {
    const float x1 = bf2f(p[lane]), x2 = bf2f(p[lane + 64]);
    const float ss = wave_sum(x1 * x1 + x2 * x2);
    const float rs = 1.0f / sqrtf(ss * (1.0f / 128.f) + EPS);
    float y1 = x1 * rs * gain[lane], y2 = x2 * rs * gain[lane + 64];
    if (rope) { const int ti = (lane < 32 ? grow : gcol) * 32 + (lane & 31); const float c = c128[ti], s = s128[ti]; const float o1 = y1 * c - y2 * s, o2 = y2 * c + y1 * s; y1 = o1; y2 = o2; }
    p[lane] = f2bf(y1); p[lane + 64] = f2bf(y2);
}
__device__ __forceinline__ void norm64x2_task(bf16_t* p, const float* gain, bool rope, const float* c64, const float* s64, int grow, int gcol, int lane) {
    const int q = lane & 31; bf16_t* pv = p + (lane >> 5) * 64;
    const float x1 = bf2f(pv[q]), x2 = bf2f(pv[q + 32]);
    const float ss = half_sum(x1 * x1 + x2 * x2);
    const float rs = 1.0f / sqrtf(ss * (1.0f / 64.f) + EPS);
    float y1 = x1 * rs * gain[q], y2 = x2 * rs * gain[q + 32];
    if (rope) { const int ti = (q < 16 ? grow : gcol) * 16 + (q & 15); const float c = c64[ti], s = s64[ti]; const float o1 = y1 * c - y2 * s, o2 = y2 * c + y1 * s; y1 = o1; y2 = o2; }
    pv[q] = f2bf(y1); pv[q + 32] = f2bf(y2);
}
__device__ __forceinline__ void phase_post1(const Args& a, int l, const int wv0) {
    int tid_ = wv0 * 64 + lane_id(); asm volatile("" : "+v"(tid_)); const int tid = tid_, lane = tid & 63, wid = tid >> 6;
    const float* rope = (const float*)(a.ws + WS_ROPE); const float* c128 = rope, *s128 = rope + 4096, *c64 = rope + 8192, *s64 = rope + 8192 + 2048;
    for (int row = blockIdx.x; row < MTOT; row += GRID) {
        const bool lat = row < MLAT; const int tpos = row & (SEQ - 1), grow = tpos >> 6, gcol = tpos & 63;
        for (int task = wid; task < 45; task += 8) {
            if (task < 8)       norm128_task((bf16_t*)(a.ws + WS_QA) + (size_t)row * 1024 + task * 128, a.in[I_QNA] + l * 128, lat, c128, s128, grow, gcol, lane);
            else if (task < 10) norm128_task((bf16_t*)(a.ws + WS_KA) + (size_t)row * 256 + (task - 8) * 128, a.in[I_KNA] + l * 128, lat, c128, s128, grow, gcol, lane);
            else if (task < 18) norm128_task((bf16_t*)(a.ws + WS_QB) + (size_t)row * 1024 + (task - 10) * 128, a.in[I_QNB] + l * 128, false, c128, s128, grow, gcol, lane);
            else if (task < 26) norm128_task((bf16_t*)(a.ws + WS_KB) + (size_t)row * 1024 + (task - 18) * 128, a.in[I_KNB] + l * 128, false, c128, s128, grow, gcol, lane);
            else if (task < 34) norm64x2_task((bf16_t*)(a.ws + WS_QD) + (size_t)row * 1024 + (task - 26) * 128, a.in[I_QND] + l * 64, lat, c64, s64, grow, gcol, lane);
            else if (task < 42) norm64x2_task((bf16_t*)(a.ws + WS_KD) + (size_t)row * 1024 + (task - 34) * 128, a.in[I_KND] + l * 64, lat, c64, s64, grow, gcol, lane);
            else if (task == 42) { bf16_t* p = (bf16_t*)(a.ws + WS_CC) + (size_t)row * 1536; const float* g = a.in[I_GQA] + l * 896;
                float x[14]; float ss = 0.f;
#pragma unroll
                for (int i = 0; i < 14; ++i) { x[i] = bf2f(p[i * 64 + lane]); ss += x[i] * x[i]; }
                ss = wave_sum(ss); const float rs = 1.0f / sqrtf(ss * (1.0f / 896.f) + EPS);
#pragma unroll
                for (int i = 0; i < 14; ++i) p[i * 64 + lane] = f2bf(x[i] * rs * g[i * 64 + lane]); }
            else if (task == 43) { bf16_t* p = (bf16_t*)(a.ws + WS_CC) + (size_t)row * 1536 + 896; const float* g = a.in[I_GKVA] + l * 512;
                float x[8]; float ss = 0.f;
#pragma unroll
                for (int i = 0; i < 8; ++i) { x[i] = bf2f(p[i * 64 + lane]); ss += x[i] * x[i]; }
                ss = wave_sum(ss); const float rs = 1.0f / sqrtf(ss * (1.0f / 512.f) + EPS);
#pragma unroll
                for (int i = 0; i < 8; ++i) p[i * 64 + lane] = f2bf(x[i] * rs * g[i * 64 + lane]); }
            else { if (lane < 32) { bf16_t* p = (bf16_t*)(a.ws + WS_CC) + (size_t)row * 1536 + 1408; const float* g = a.in[I_KNPE] + l * 64;
                    const float x1 = bf2f(p[lane]), x2 = bf2f(p[lane + 32]);
                    const float ss = half_sum(x1 * x1 + x2 * x2); const float rs = 1.0f / sqrtf(ss * (1.0f / 64.f) + EPS);
                    float y1 = x1 * rs * g[lane], y2 = x2 * rs * g[lane + 32];
                    if (lat) { const int ti = (lane < 16 ? grow : gcol) * 16 + (lane & 15); const float c = c64[ti], s = s64[ti]; const float o1 = y1 * c - y2 * s, o2 = y2 * c + y1 * s; y1 = o1; y2 = o2; }
                    p[lane] = f2bf(y1); p[lane + 32] = f2bf(y2); } }
        }
    }
}

__device__ __forceinline__ void phase_post2(const Args& a, int l, const int wv0) {
    int tid_ = wv0 * 64 + lane_id(); asm volatile("" : "+v"(tid_)); const int tid = tid_, lane = tid & 63, wid = tid >> 6;
    const float* rope = (const float*)(a.ws + WS_ROPE); const float* c64 = rope + 8192, *s64 = rope + 8192 + 2048;
    const float* gqn = a.in[I_QNNOPE] + l * 128, *gqp = a.in[I_QNPE] + l * 64, *gkn = a.in[I_KNNOPE] + l * 128;
    for (int row = blockIdx.x; row < MTOT; row += GRID) {
        const bool lat = row < MLAT; const int tpos = row & (SEQ - 1), grow = tpos >> 6, gcol = tpos & 63;
        for (int task = wid; task < 16; task += 8) {
            if (task < 8) { bf16_t* p = (bf16_t*)(a.ws + WS_QUP) + (size_t)row * 1536 + task * 192;
                const float x1 = bf2f(p[lane]), x2 = bf2f(p[lane + 64]), xp = bf2f(p[128 + lane]);
                const float ss = wave_sum(x1 * x1 + x2 * x2), sp = wave_sum(xp * xp);
                const float rs = 1.0f / sqrtf(ss * (1.0f / 128.f) + EPS), rp = 1.0f / sqrtf(sp * (1.0f / 64.f) + EPS);
                float yp = xp * rp * gqp[lane];
                const float other = __shfl_xor(yp, 32);
                if (lat) { const int q = lane & 31; const int ti = (q < 16 ? grow : gcol) * 16 + (q & 15); const float c = c64[ti], s = s64[ti];
                    yp = lane < 32 ? (yp * c - other * s) : (yp * c + other * s); }
                p[lane] = f2bf(x1 * rs * gqn[lane]); p[lane + 64] = f2bf(x2 * rs * gqn[lane + 64]); p[128 + lane] = f2bf(yp); }
            else { const int h = task - 8; const bf16_t* p = (const bf16_t*)(a.ws + WS_KVUP) + (size_t)row * 2048 + h * 256; bf16_t* kc = (bf16_t*)(a.ws + WS_KC) + (size_t)row * 1536 + h * 192;
                const float x1 = bf2f(p[lane]), x2 = bf2f(p[lane + 64]);
                const float ss = wave_sum(x1 * x1 + x2 * x2); const float rs = 1.0f / sqrtf(ss * (1.0f / 128.f) + EPS);
                kc[lane] = f2bf(x1 * rs * gkn[lane]); kc[lane + 64] = f2bf(x2 * rs * gkn[lane + 64]);
                kc[128 + lane] = ((const bf16_t*)(a.ws + WS_CC))[(size_t)row * 1536 + 1408 + lane]; }
        }
    }
}

__device__ __forceinline__ void phase_dcomb(const Args& a, int l, int mrows, const int wv0) {
    int tid_ = wv0 * 64 + lane_id(); asm volatile("" : "+v"(tid_)); const int tid = tid_, lane = tid & 63, wv = blockIdx.x * 8 + (tid >> 6);
    const float* bnd = (const float*)(a.ws + WS_BND) + l * 32; const float lam = bnd[18];
    const float li_[4] = {0.2f, 0.35550906759096934f, 0.4707130183435842f, 0.5560582041556406f};
    const float om = 1.0f - li_[l];
    const float* sub = a.in[I_SUBLN] + l * 128; const float g0 = sub[lane * 2] * om, g1 = sub[lane * 2 + 1] * om;
    const float* OD = (const float*)(a.ws + WS_OD); const bf16_t* G4 = (const bf16_t*)(a.ws + WS_G4); bf16_t* Y = (bf16_t*)(a.ws + WS_Y);
    for (int t = wv; t < mrows * 8; t += GRID * 8) { const int row = t >> 3, h = t & 7;
        const f32x2 o0 = *(const f32x2*)(OD + (size_t)row * 2048 + h * 256 + lane * 2), o1 = *(const f32x2*)(OD + (size_t)row * 2048 + h * 256 + 128 + lane * 2);
        const float d0 = o0[0] - lam * o1[0], d1 = o0[1] - lam * o1[1];
        const float ss = wave_sum(d0 * d0 + d1 * d1); const float rs = 1.0f / sqrtf(ss * (1.0f / 128.f) + EPS);
        const unsigned gw = *(const unsigned*)(G4 + (size_t)row * 4096 + 3072 + h * 128 + lane * 2);
        *(unsigned*)(Y + (size_t)row * 4096 + 3072 + h * 128 + lane * 2) = cvt_pk_bf16(d0 * rs * g0 * bflo(gw), d1 * rs * g1 * bfhi(gw)); }
}

__device__ __forceinline__ void phase_attn(const Args& a, int l, LAS unsigned char* lds, bool ctx_out, const int wv0) {
    const int c = blockIdx.x, xcd = c & 7, rank = c >> 3;
    const float* bnd = (const float*)(a.ws + WS_BND) + l * 32;
    const bf16_t* QA = (const bf16_t*)(a.ws + WS_QA); const bf16_t* KA = (const bf16_t*)(a.ws + WS_KA); const bf16_t* VA = (const bf16_t*)(a.ws + WS_VA);
    const bf16_t* QB = (const bf16_t*)(a.ws + WS_QB); const bf16_t* KB = (const bf16_t*)(a.ws + WS_KB); const bf16_t* VB = (const bf16_t*)(a.ws + WS_VB);
    const bf16_t* QD = (const bf16_t*)(a.ws + WS_QD); const bf16_t* KD = (const bf16_t*)(a.ws + WS_KD); const bf16_t* VD = (const bf16_t*)(a.ws + WS_VD);
    const bf16_t* QC = (const bf16_t*)(a.ws + WS_QUP); const bf16_t* KC = (const bf16_t*)(a.ws + WS_KC); const bf16_t* VC = (const bf16_t*)(a.ws + WS_KVUP);
    const bf16_t* G4 = (const bf16_t*)(a.ws + WS_G4); bf16_t* Y = (bf16_t*)(a.ws + WS_Y); float* OD = (float*)(a.ws + WS_OD);
#ifndef ATTK
#define ATTK -1
#endif
    if (ATTK < 0 || ATTK == 0)
    for (int rnd = 0; rnd < 5; ++rnd) {
        att::AU u; int b, h, i; size_t row0;
        if (rnd < 4) { const int vh = xcd + 8 * rnd; b = vh >> 4; h = (vh >> 1) & 7; i = vh & 1; row0 = (size_t)b * SEQ + rank * 256; u.nlat = 128; u.nt = 132; }
        else { if (!ctx_out || c < 48 || c >= 80) break; const int vh = c - 48; b = vh >> 4; h = (vh >> 1) & 7; i = vh & 1; row0 = (size_t)MLAT + b * CTXL; u.nlat = 0; u.nt = 4; }
        const int col = h * 128 + i * 64;
        u.Q = QD + row0 * 1024 + col; u.ldq = 1024;
        u.Kl = KD + (size_t)b * SEQ * 1024 + col; u.Vl = VD + (size_t)b * SEQ * 1024 + h * 128;
        u.Kc = KD + ((size_t)MLAT + b * CTXL) * 1024 + col; u.Vc = VD + ((size_t)MLAT + b * CTXL) * 1024 + h * 128;
        u.ldk = 1024; u.ldv = 1024; u.C = 0.125f * LOG2E; u.MC = bnd[17]; u.sinkL = -1e30f; u.m0 = 0; u.m1 = 0; u.rpb = nullptr;
        u.out_f32 = 1; u.out = OD + row0 * 2048 + (h * 2 + i) * 128; u.gate = nullptr; u.ldo = 2048;
        att::attn_unit<64, 0>(u, lds, wv0);
    }
    if (ATTK < 0 || ATTK == 1)
    for (int rnd = 0; rnd < 3; ++rnd) {
        att::AU u; int b, h; size_t row0;
        if (rnd < 2) { const int bh = xcd + 8 * rnd; b = bh >> 3; h = bh & 7; row0 = (size_t)b * SEQ + rank * 256; u.nlat = 128; u.nt = 132; }
        else { if (!ctx_out || c < 32 || c >= 48) break; const int bh = c - 32; b = bh >> 3; h = bh & 7; row0 = (size_t)MLAT + b * CTXL; u.nlat = 0; u.nt = 4; }
        u.Q = QC + row0 * 1536 + h * 192; u.ldq = 1536;
        u.Kl = KC + (size_t)b * SEQ * 1536 + h * 192; u.Vl = VC + (size_t)b * SEQ * 2048 + h * 256 + 128;
        u.Kc = KC + ((size_t)MLAT + b * CTXL) * 1536 + h * 192; u.Vc = VC + ((size_t)MLAT + b * CTXL) * 2048 + h * 256 + 128;
        u.ldk = 1536; u.ldv = 2048; u.C = 0.07216878364870323f * LOG2E; u.MC = bnd[16]; u.sinkL = -1e30f; u.m0 = 0; u.m1 = 0; u.rpb = nullptr;
        u.out_f32 = 0; u.out = Y + row0 * 4096 + 2048 + h * 128; u.gate = G4 + row0 * 4096 + 2048 + h * 128; u.ldo = 4096;
        att::attn_unit<192, 0>(u, lds, wv0);
    }
    if (ATTK < 0 || ATTK == 2)
    for (int rnd = 0; rnd < 3; ++rnd) {
        att::AU u; int b, h; size_t row0; int kstart = 0, q0 = 0;
        if (rnd < 2) { const int bh = xcd + 8 * rnd; b = bh >> 3; h = bh & 7; q0 = rank * 256; row0 = (size_t)b * SEQ + q0;
            kstart = q0 - 128 < 0 ? 0 : q0 - 128; const int kend = q0 + 384 > SEQ ? SEQ : q0 + 384; u.nlat = (kend - kstart) >> 6; u.nt = u.nlat + 4; }
        else { if (!ctx_out || c >= 16) break; b = c >> 3; h = c & 7; row0 = (size_t)MLAT + b * CTXL; u.nlat = 0; u.nt = 4; }
        const int kvh = h >> 2;
        u.Q = QA + row0 * 1024 + h * 128; u.ldq = 1024;
        u.Kl = KA + ((size_t)b * SEQ + kstart) * 256 + kvh * 128; u.Vl = VA + ((size_t)b * SEQ + kstart) * 256 + kvh * 128;
        u.Kc = KA + ((size_t)MLAT + b * CTXL) * 256 + kvh * 128; u.Vc = VA + ((size_t)MLAT + b * CTXL) * 256 + kvh * 128;
        u.ldk = 256; u.ldv = 256; u.C = 0.08838834764831845f * LOG2E; u.MC = bnd[h]; u.sinkL = bnd[19 + h]; u.m0 = kstart - q0; u.m1 = 0; u.rpb = nullptr;
        u.out_f32 = 0; u.out = Y + row0 * 4096 + h * 128; u.gate = G4 + row0 * 4096 + h * 128; u.ldo = 4096;
        att::attn_unit<128, 1>(u, lds, wv0);
    }
    if (ATTK < 0 || ATTK == 3)
    for (int rnd = 0; rnd < 3; ++rnd) {
        att::AU u; int b, h; size_t row0; int krow0 = 0, rg = 0;
        if (rnd < 2) { const int bh = xcd + 8 * rnd; b = bh >> 3; h = bh & 7; rg = rank; row0 = (size_t)b * SEQ + rg * 256;
            krow0 = 4 * rg - 4 < 0 ? 0 : 4 * rg - 4; u.nlat = (rg == 0 || rg == 31) ? 8 : 12; u.nt = u.nlat + 4; }
        else { if (!ctx_out || c < 16 || c >= 32) break; b = (c - 16) >> 3; h = c & 7; row0 = (size_t)MLAT + b * CTXL; u.nlat = 0; u.nt = 4; }
        u.Q = QB + row0 * 1024 + h * 128; u.ldq = 1024;
        u.Kl = KB + ((size_t)b * SEQ + krow0 * 64) * 1024 + h * 128; u.Vl = VB + ((size_t)b * SEQ + krow0 * 64) * 1024 + h * 128;
        u.Kc = KB + ((size_t)MLAT + b * CTXL) * 1024 + h * 128; u.Vc = VB + ((size_t)MLAT + b * CTXL) * 1024 + h * 128;
        u.ldk = 1024; u.ldv = 1024; u.C = 0.08838834764831845f * LOG2E; u.MC = bnd[8 + h]; u.sinkL = -1e30f; u.m0 = 4 * rg; u.m1 = krow0;
        u.rpb = a.in[I_RPB] + ((size_t)l * 8 + h) * 465;
        u.out_f32 = 0; u.out = Y + row0 * 4096 + 1024 + h * 128; u.gate = G4 + row0 * 4096 + 1024 + h * 128; u.ldo = 4096;
        att::attn_unit<128, 2>(u, lds, wv0);
    }
}


__device__ __forceinline__ Args load_args(const Args& a) {
#if defined(__HIP_DEVICE_COMPILE__)
    typedef const Args __attribute__((address_space(4)))* KArgsP;
    KArgsP p = (KArgsP)__builtin_amdgcn_kernarg_segment_ptr();
    asm volatile("" : "+s"(p));
    Args b;
#pragma unroll
    for (int i = 0; i < 31; ++i) b.in[i] = p->in[i];
    b.out = p->out; b.ws = p->ws; b.ph_lo = p->ph_lo; b.ph_hi = p->ph_hi;
    return b;
#else
    return a;
#endif
}

constexpr int N_PHASES = 2 + 9 * DEPTH;
__global__ void __launch_bounds__(NTHR, 2) mega_fwd(Args a) {
    extern __shared__ __attribute__((aligned(16))) unsigned char lds_raw[];
    LAS unsigned char* lds = (LAS unsigned char*)lds_raw;
    volatile LAS unsigned* misc = (volatile LAS unsigned*)(lds + LDS_MISC);
    const int wv0 = __builtin_amdgcn_readfirstlane((int)threadIdx.x >> 6);
    if (threadIdx.x < 4) misc[threadIdx.x] = 0u;
    __syncthreads();
    const int lo = a.ph_lo, hi = a.ph_hi;
    XcdBarrier bar; bar.bar = (unsigned*)(a.ws + WS_CTL); bar.x = 0; bar.st = misc;
    if (hi - lo > 1) bar = xcd_barrier_post((unsigned*)(a.ws + WS_CTL), misc, wv0);
#ifndef TESTKIND
#define TESTKIND -1
#endif
#define KIND_OK(kind) (TESTKIND < 0 || TESTKIND == (kind))
#define IN(k) (lo <= (k) && (k) < hi)
#define SEAM(k) do { if (IN((k) + 1)) xcd_barrier(bar, wv0); } while (0)
#define PA() load_args(a)
    if (KIND_OK(0) && IN(0)) { phase_prologue(PA(), lds, wv0); SEAM(0); }
    if (KIND_OK(1) && IN(1)) { phase_mods(PA(), wv0); SEAM(1); }
    for (int l = 0; l < DEPTH; ++l) {
        const Args al = PA(); float* XB = (float*)(al.ws + WS_XBUF);
        const int pb = 2 + 9 * l;
        const bool ctx_out = l < DEPTH - 1;
        const float* xin = l == 0 ? al.in[I_X] : XB; const float* cin = l == 0 ? al.in[I_CTX] : XB + (size_t)MLAT * 4096;
        float* xout = l == DEPTH - 1 ? al.out : XB; float* cout = XB + (size_t)MLAT * 4096;
        const int mrows = ctx_out ? MTOT : MLAT;
        if (KIND_OK(2) && IN(pb + 0)) { phase_xnorm(PA(), l, xin, cin, wv0); SEAM(pb + 0); }
        if (KIND_OK(3) && IN(pb + 1)) { const Args b = PA();
            pg8::Gemm g{(const bf16_t*)(b.ws + WS_H), (const bf16_t*)(b.ws + WS_WIN) + (size_t)l * NINP * 4096, MTOT, NINP, 4096, 4096, 4096};
            pg8::StaticOrder S; S.init(MTOT, NINP, (int)gridDim.x, (int)blockIdx.x);
            EpiG1 E{b.ws}; pg8::NoHook nh;
            pg8::gemm_phase(lds, g, S, E, nh, wv0); SEAM(pb + 1); }
        if (KIND_OK(4) && IN(pb + 2)) { phase_post1(PA(), l, wv0); SEAM(pb + 2); }
        if (KIND_OK(5) && IN(pb + 3)) { const Args b = PA();
            { pg8::Gemm g{(const bf16_t*)(b.ws + WS_CC), (const bf16_t*)(b.ws + WS_WQ) + (size_t)l * 1536 * 896, MTOT, 1536, 896, 1536, 896};
              pg8::StaticOrder S; S.init(MTOT, 1536, (int)gridDim.x, (int)blockIdx.x);
              EpiPlain E{(bf16_t*)(b.ws + WS_QUP), 1536}; pg8::NoHook nh;
              pg8::gemm_phase(lds, g, S, E, nh, wv0); }
            { pg8::Gemm g{(const bf16_t*)(b.ws + WS_CC) + 896, (const bf16_t*)(b.ws + WS_WKV) + (size_t)l * 2048 * 512, MTOT, 2048, 512, 1536, 512};
              pg8::StaticOrder S; S.init(MTOT, 2048, (int)gridDim.x, (int)blockIdx.x);
              EpiPlain E{(bf16_t*)(b.ws + WS_KVUP), 2048}; pg8::NoHook nh;
              pg8::gemm_phase(lds, g, S, E, nh, wv0); }
            SEAM(pb + 3); }
        if (KIND_OK(6) && IN(pb + 4)) { phase_post2(PA(), l, wv0); SEAM(pb + 4); }
        if (KIND_OK(7) && IN(pb + 5)) { phase_attn(PA(), l, lds, ctx_out, wv0); SEAM(pb + 5); }
        if (KIND_OK(8) && IN(pb + 6)) { phase_dcomb(PA(), l, mrows, wv0); SEAM(pb + 6); }
        if (KIND_OK(9) && IN(pb + 7)) { const Args b = PA();
            pg8::Gemm g{(const bf16_t*)(b.ws + WS_Y), (const bf16_t*)(b.ws + WS_WB) + (size_t)l * 4096 * 4096, mrows, 4096, 4096, 4096, 4096};
            pg8::StaticOrder S; S.init(mrows, 4096, (int)gridDim.x, (int)blockIdx.x);
            EpiMerge E{(const bf16_t*)(b.ws + WS_MG), (bf16_t*)(b.ws + WS_MERGED)}; HookMerge hk{(const bf16_t*)(b.ws + WS_MG)};
            pg8::gemm_phase(lds, g, S, E, hk, wv0); SEAM(pb + 7); }
        if (KIND_OK(10) && IN(pb + 8)) { const Args b = PA();
            pg8::Gemm g{(const bf16_t*)(b.ws + WS_MERGED), (const bf16_t*)(b.ws + WS_WO) + (size_t)l * 4096 * 4096, mrows, 4096, 4096, 4096, 4096};
            pg8::StaticOrder S; S.init(mrows, 4096, (int)gridDim.x, (int)blockIdx.x);
            EpiResid E{xin, cin, xout, cout, (const float*)(b.ws + WS_MODS) + l * 36864}; pg8::NoHook nh;
            pg8::gemm_phase(lds, g, S, E, nh, wv0); SEAM(pb + 8); }
    }
#undef IN
#undef SEAM
#undef PA
}

extern "C" void kernel_launch(void* const* d_in, const int* in_sizes, int n_in, void* d_out, int out_size, void* d_ws, size_t ws_size, hipStream_t stream) {
    static int ready = 0;
    if (ready == 0) {
        if (n_in != 31 || in_sizes[0] != MLAT * DM || out_size != MLAT * DM || ws_size < WS_END) {
            fprintf(stderr, "kernel_launch: shape mismatch: n_in %d in0 %d out %d ws %zu (need >= %zu)\n", n_in, n_in > 0 ? in_sizes[0] : -1, out_size, ws_size, (size_t)WS_END); ready = -1; return; }
        if (hipFuncSetAttribute((const void*)mega_fwd, hipFuncAttributeMaxDynamicSharedMemorySize, LDS_BYTES) != hipSuccess) { fprintf(stderr, "kernel_launch: hipFuncSetAttribute failed\n"); ready = -1; return; }
        int per_cu = 0, dev = 0, cus = 0;
        (void)hipGetDevice(&dev); (void)hipDeviceGetAttribute(&cus, hipDeviceAttributeMultiprocessorCount, dev);
        if (hipOccupancyMaxActiveBlocksPerMultiprocessor(&per_cu, (const void*)mega_fwd, NTHR, LDS_BYTES) != hipSuccess || per_cu < 1 || cus < GRID)
            fprintf(stderr, "kernel_launch: note: occupancy query %d blocks/CU, %d CUs (grid %d needs one resident block per CU)\n", per_cu, cus, GRID);
        (void)hipGetLastError();
        ready = 1;
    }
    if (ready < 0) return;
    (void)hipMemsetAsync((char*)d_ws + WS_CTL, 0, 65536, stream);
    Args a{};
    for (int i = 0; i < 31; ++i) a.in[i] = (const float*)d_in[i];
    a.out = (float*)d_out; a.ws = (unsigned char*)d_ws;
#if MK_LAUNCH_PER_PHASE
    for (int p = 0; p < N_PHASES; ++p) { a.ph_lo = p; a.ph_hi = p + 1; hipLaunchKernelGGL(mega_fwd, dim3(GRID), dim3(NTHR), LDS_BYTES, stream, a); }
#else
    a.ph_lo = 0; a.ph_hi = N_PHASES;
    hipLaunchKernelGGL(mega_fwd, dim3(GRID), dim3(NTHR), LDS_BYTES, stream, a);
#endif
    const hipError_t le = hipPeekAtLastError();
    if (le != hipSuccess) fprintf(stderr, "kernel_launch: launch failed: %s\n", hipGetErrorName(le));
}
```

```cpp
#include <hip/hip_runtime.h>
#include <cstdio>
#include <cstdint>

#define LAS __attribute__((address_space(3)))
typedef unsigned short bf16_t;
typedef short bf16x8 __attribute__((ext_vector_type(8)));
typedef short s16x4 __attribute__((ext_vector_type(4)));
typedef float f32x2 __attribute__((ext_vector_type(2)));
typedef float f32x4 __attribute__((ext_vector_type(4)));
typedef float f32x16 __attribute__((ext_vector_type(16)));
typedef unsigned u32x2 __attribute__((ext_vector_type(2)));
typedef unsigned u32x4 __attribute__((ext_vector_type(4)));
typedef int i32x4_t __attribute__((ext_vector_type(4)));
typedef int i32x8_t __attribute__((ext_vector_type(8)));

#ifndef MK_LAUNCH_PER_PHASE
#define MK_LAUNCH_PER_PHASE 0
#endif

constexpr int DM = 4096, NBATCH = 2, SEQ = 8192, DEPTH = 4, CTXL = 256, GRIDW = 64;
constexpr int MLAT = NBATCH * SEQ, MCTX = NBATCH * CTXL, MTOT = MLAT + MCTX;
constexpr int NIN = 29632, NINP = 29696;
constexpr float LOG2E = 1.4426950408889634f;
constexpr float EPS = 1e-6f;

constexpr size_t al256(size_t x) { return (x + 255) / 256 * 256; }
constexpr size_t WS_CTL = 0;
constexpr size_t WS_MODS = 65536 + 2 * (((size_t)4 * 29632 * 4 + 255) / 256 * 256);
constexpr size_t WS_MODP = WS_MODS + al256((size_t)4 * 3 * 12288 * 4);
constexpr size_t WS_ROPE = WS_MODP + al256((size_t)4 * 32 * 3 * 12288 * 4);
constexpr size_t WS_BND = WS_ROPE + al256((size_t)(4096 * 2 + 2048 * 2) * 4);
constexpr size_t WS_WIN = WS_BND + 4096;
constexpr int NT_BF = 4, NT_F8 = 112;
constexpr size_t WS_WQ = WS_WIN + (size_t)4 * NT_BF * 256 * 4096 * 2;
constexpr size_t WS_WKV = WS_WQ + (size_t)4 * 1536 * 896 * 2;
constexpr size_t WS_WB = WS_WKV + (size_t)4 * 2048 * 512 * 2;
constexpr size_t WS_WO = WS_WB + (size_t)4 * 4096 * 4096 * 2;
constexpr size_t WS_H = WS_WO + (size_t)4 * 4096 * 4096 * 2;
constexpr size_t WS_QA = WS_H + (size_t)MTOT * 4096 * 2;
constexpr size_t WS_KA = WS_QA + (size_t)MTOT * 1024 * 2;
constexpr size_t WS_VA = WS_KA + (size_t)MTOT * 256 * 2;
constexpr size_t WS_QB = WS_VA + (size_t)MTOT * 256 * 2;
constexpr size_t WS_KB = WS_QB + (size_t)MTOT * 1024 * 2;
constexpr size_t WS_VB = WS_KB + (size_t)MTOT * 1024 * 2;
constexpr size_t WS_CC = WS_VB + (size_t)MTOT * 1024 * 2;
constexpr size_t WS_QD = WS_CC + (size_t)MTOT * 1536 * 2;
constexpr size_t WS_KD = WS_QD + (size_t)MTOT * 1024 * 2;
constexpr size_t WS_VD = WS_KD + (size_t)MTOT * 1024 * 2;
constexpr size_t WS_G4 = WS_VD + (size_t)MTOT * 1024 * 2;
constexpr size_t WS_MG = WS_G4 + (size_t)MTOT * 4096 * 2;
constexpr size_t WS_QUP = WS_MG + (size_t)MTOT * 16384 * 2;
constexpr size_t WS_KVUP = WS_QUP + (size_t)MTOT * 1536 * 2;
constexpr size_t WS_KC = WS_KVUP + (size_t)MTOT * 2048 * 2;
constexpr size_t WS_OD = WS_KC + (size_t)MTOT * 1536 * 2;
constexpr size_t WS_Y = WS_OD + (size_t)MTOT * 2048 * 4;
constexpr size_t WS_MERGED = WS_Y + (size_t)MTOT * 4096 * 2;
constexpr size_t WS_XBUF = WS_MERGED + (size_t)MTOT * 4096 * 2;
constexpr size_t WS_P3 = WS_XBUF + (size_t)MTOT * 4096 * 4;
constexpr size_t WS_P4 = WS_P3 + (size_t)8 * MCTX * 4096 * 4;
constexpr size_t WS_H8 = WS_P4 + (size_t)8 * MCTX * 4096 * 4;
constexpr size_t WS_W8 = WS_H8 + (size_t)MTOT * 4096;
constexpr size_t WS_HS = WS_W8 + (size_t)4 * NT_F8 * 256 * 4096;
constexpr size_t WS_WSC = WS_HS + al256((size_t)MTOT * 4);
constexpr size_t WS_END = WS_WSC + al256((size_t)4 * NINP * 4);
constexpr size_t WS_CMAX = 65536;
constexpr size_t WS_CSQ = WS_CMAX + al256((size_t)4 * NIN * 4);
constexpr int CS_ROWS = 256;
constexpr size_t CTL_ZERO_BYTES = 65536;

__device__ __forceinline__ unsigned cvt_pk_bf16(float lo, float hi) { unsigned r; asm volatile("v_cvt_pk_bf16_f32 %0, %1, %2" : "=v"(r) : "v"(lo), "v"(hi)); return r; }
__device__ __forceinline__ float bf2f(unsigned short b) { return __uint_as_float(((unsigned)b) << 16); }
__device__ __forceinline__ float bflo(unsigned w) { return __uint_as_float(w << 16); }
__device__ __forceinline__ float bfhi(unsigned w) { return __uint_as_float(w & 0xffff0000u); }
__device__ __forceinline__ bf16_t f2bf(float f) { return (bf16_t)(cvt_pk_bf16(f, f) & 0xffffu); }
__device__ __forceinline__ float fast_exp2(float x) { return __builtin_amdgcn_exp2f(x); }
__device__ __forceinline__ float fast_rcp(float x) { return __builtin_amdgcn_rcpf(x); }
__device__ __forceinline__ float silu_f(float v) { return v * fast_rcp(1.0f + fast_exp2(-v * LOG2E)); }
__device__ __forceinline__ float sigm_f(float v) { const float c = fminf(fmaxf(v, -30.f), 30.f); return fast_rcp(1.0f + fast_exp2(-c * LOG2E)); }
__device__ __forceinline__ int lane_id() { int v; asm volatile("v_mbcnt_lo_u32_b32 %0, -1, 0\n\tv_mbcnt_hi_u32_b32 %0, -1, %0" : "=v"(v)); return v; }
template <int M> __device__ __forceinline__ float swz_xor(float v) {
    return __int_as_float(__builtin_amdgcn_ds_swizzle(__float_as_int(v), (M << 10) | 0x1f));
}
__device__ __forceinline__ float half_swap_sum(float v) {
    auto rr = __builtin_amdgcn_permlane32_swap(__float_as_uint(v), __float_as_uint(v), false, false); return __uint_as_float(rr[0]) + __uint_as_float(rr[1]);
}
__device__ __forceinline__ float half_swap_max(float v) {
    auto rr = __builtin_amdgcn_permlane32_swap(__float_as_uint(v), __float_as_uint(v), false, false); return fmaxf(__uint_as_float(rr[0]), __uint_as_float(rr[1]));
}
__device__ __forceinline__ float half_sum(float v) {
    v += swz_xor<16>(v); v += swz_xor<8>(v); v += swz_xor<4>(v); v += swz_xor<2>(v); v += swz_xor<1>(v); return v;
}
__device__ __forceinline__ float wave_sum(float v) { return half_sum(half_swap_sum(v)); }
__device__ __forceinline__ float wave_max(float v) {
    v = half_swap_max(v); v = fmaxf(v, swz_xor<16>(v)); v = fmaxf(v, swz_xor<8>(v)); v = fmaxf(v, swz_xor<4>(v)); v = fmaxf(v, swz_xor<2>(v)); v = fmaxf(v, swz_xor<1>(v)); return v;
}

__device__ __forceinline__ void gld16(u32x4& d, const void* p) { asm volatile("global_load_dwordx4 %0, %1, off" : "=&v"(d) : "v"(p) : "memory"); }
__device__ __forceinline__ void gld16f(f32x4& d, const void* p) { asm volatile("global_load_dwordx4 %0, %1, off" : "=&v"(d) : "v"(p) : "memory"); }
#define GLD_WAIT() do { asm volatile("s_waitcnt vmcnt(0)" ::: "memory"); __builtin_amdgcn_sched_barrier(0); } while (0)

#define XB_TMO      128
#define XB_XCNT(j)  (256  + 64 * (j))
#define XB_XSUB(j)  (1280 + 64 * (j))
#define XB_XGEN(j)  (2304 + 64 * (j))
#define XB_TOP      3328
#define XB_TOPGEN   3392
#define XCD_BAR_WORDS 3456
#define XB_SPIN_CAP (1u << 22)

__device__ __forceinline__ unsigned xb_ld(unsigned* p)              { asm volatile("" : "+v"(p)); return __hip_atomic_load(p, __ATOMIC_RELAXED, __HIP_MEMORY_SCOPE_AGENT); }
__device__ __forceinline__ unsigned xb_add(unsigned* p, unsigned v) { asm volatile("" : "+v"(p), "+v"(v)); return __hip_atomic_fetch_add(p, v, __ATOMIC_RELAXED, __HIP_MEMORY_SCOPE_AGENT); }
__device__ __forceinline__ unsigned xb_xcc_id() { return (unsigned)__builtin_amdgcn_s_getreg((3 << 11) | 20) & 0xFu; }
#define XB_SPIN(cond, bar) do { unsigned _sp = 0; while (cond) { __builtin_amdgcn_s_sleep(1); \
    if ((++_sp & 255u) == 0u) { if (xb_ld(&(bar)[XB_TMO])) break; if (_sp > XB_SPIN_CAP) { (void)xb_add(&(bar)[XB_TMO], 1u); break; } } } } while (0)

struct XcdBarrier { unsigned* bar; unsigned x; volatile LAS unsigned* st; };

__device__ __forceinline__ XcdBarrier xcd_barrier_post(unsigned* bar, volatile LAS unsigned* st, const int wv0) {
    XcdBarrier b; b.bar = bar; b.x = xb_xcc_id(); b.st = st;
    if (wv0 == 0 && lane_id() == 0) (void)xb_add(&bar[XB_XCNT(b.x)], 1u);
    return b;
}
__device__ __forceinline__ void xcd_barrier_complete(unsigned* bar, unsigned x, unsigned& nloc, unsigned& nx) {
    const unsigned G = gridDim.x * gridDim.y * gridDim.z;
    unsigned sum, cnt, mine, sp = 0u;
    for (;;) {
        sum = 0u; cnt = 0u; mine = 0u;
#pragma unroll
        for (unsigned j = 0; j < 16; ++j) { const unsigned c = xb_ld(&bar[XB_XCNT(j)]); sum += c; cnt += (c > 0u) ? 1u : 0u; mine = (j == x) ? c : mine; }
        if (sum == G) break;
        __builtin_amdgcn_s_sleep(1);
        if ((++sp & 255u) == 0u) { if (xb_ld(&bar[XB_TMO])) break; if (sp > XB_SPIN_CAP) { (void)xb_add(&bar[XB_TMO], 1u); break; } }
    }
    nloc = mine > 0u ? mine : 1u; nx = cnt > 0u ? cnt : 1u;
}
__device__ __forceinline__ void xcd_barrier(const XcdBarrier& b, const int wv0) {
    asm volatile("s_waitcnt vmcnt(0)" ::: "memory");
    __syncthreads();
    if (wv0 == 0 && lane_id() == 0) {
        unsigned* bar = b.bar;
        __builtin_amdgcn_s_waitcnt(0);
        unsigned nloc = b.st[0], nx = b.st[1];
        if (nloc == 0u) { xcd_barrier_complete(bar, b.x, nloc, nx); b.st[0] = nloc; b.st[1] = nx; }
        const unsigned old = xb_add(&bar[XB_XSUB(b.x)], 1u);
        const unsigned gen = old / nloc;
        if (old + 1u == (gen + 1u) * nloc) {
            __builtin_amdgcn_fence(__ATOMIC_RELEASE, "agent");
            asm volatile("s_waitcnt vmcnt(0)" ::: "memory");
            const unsigned og = xb_add(&bar[XB_TOP], 1u);
            const unsigned tg = og / nx;
            if (og + 1u == (tg + 1u) * nx) xb_add(&bar[XB_TOPGEN], 1u);
            else XB_SPIN(xb_ld(&bar[XB_TOPGEN]) == tg, bar);
            __builtin_amdgcn_fence(__ATOMIC_ACQUIRE, "agent");
            xb_add(&bar[XB_XGEN(b.x)], 1u);
            asm volatile("s_waitcnt vmcnt(0)" ::: "memory");
        } else {
            XB_SPIN(xb_ld(&bar[XB_XGEN(b.x)]) == gen, bar);
            __builtin_amdgcn_fence(__ATOMIC_ACQUIRE, "agent");
            asm volatile("s_waitcnt vmcnt(0)" ::: "memory");
        }
    }
    __syncthreads();
}

namespace pg8 {
constexpr int BM = 256, BK = 64, HALF = 128, HTB = HALF * BK * 2, STAGE_BYTES = 8 * HTB, NXCD = 8, WGM = 8;
__host__ __device__ __forceinline__ int lds_byte(int r, int c) { const int st = (r >> 4) * 2 + (c >> 5), rr = r & 15, cc = c & 31, ob = rr * 64 + cc * 2; return st * 1024 + (ob ^ (((ob >> 9) & 1) << 5)); }
__host__ __device__ __forceinline__ void stage_rc(int b, int& R, int& C) { const int st = b / 1024, sb = b % 1024, swz = sb ^ (((sb >> 9) & 1) << 5); R = (st >> 1) * 16 + swz / 64; C = (st & 1) * 32 + (swz % 64) / 2; }
__host__ __device__ __forceinline__ int perm32(int rho) { const int n = rho >> 4, i = rho & 15; return 8 * (i >> 2) + 4 * n + (i & 3); }

struct Unit { int pm, pn, kb; };
struct Gemm { const void* A; const void* Bt; int M, N, K, ldaB, ldbB; };

struct StaticOrder {
    static constexpr bool DYN = false;
    int nM, nN, nwg, G, c;
    __device__ void init(int M, int N, int G_, int c_) { nM = M / BM; nN = N / BM; nwg = nM * nN; G = G_; c = c_; }
    __device__ void map(int L, Unit& u) const {
        int wgid = L; { const int q = nwg / NXCD, r = nwg % NXCD, xcd = wgid % NXCD, off = wgid / NXCD; wgid = (xcd < r ? xcd * (q + 1) : r * (q + 1) + (xcd - r) * q) + off; }
        const int nig = WGM * nN, gid = wgid / nig, fm = gid * WGM, gsz = (nM - fm) < WGM ? (nM - fm) : WGM;
        u.pm = fm + ((wgid % nig) % gsz); u.pn = (wgid % nig) / gsz; u.kb = 0;
    }
    __device__ bool next(int i, Unit& u) const { const long L = (long)i * G + c; if (L >= nwg) return false; map((int)L, u); return true; }
};
struct DynTailOrder {
    static constexpr bool DYN = true;
    StaticOrder S; int R; unsigned* ctr;
    __device__ bool next(int i, Unit& u) const { return S.next(i, u); }
    __device__ int claim() const {
        const int x0 = S.c & 7, base = R * S.G;
        for (int k = 0; k < 8; ++k) { const int x = (x0 + k) & 7; const int L = base + 8 * (int)xb_add(ctr + x * 16, 1u) + x; if (L < S.nwg) return L; }
        return -1;
    }
};
struct G1Int8Order {
    static constexpr bool DYN = false;
    StaticOrder S;
    __device__ bool next(int i, Unit& u) const {
        const int c = S.c;
        if (c >= 248 && i >= 27) return false;
        if (i == 28 && c >= 224 && c < 232) { StaticOrder T = S; T.c = c + 24; return T.next(27, u); }
        return S.next(i, u);
    }
};
struct CtxSplitOrder {
    static constexpr bool DYN = false;
    int c;
    __device__ bool next(int i, Unit& u) const { if (i > 0 || c >= 256) return false; u.pm = 64 + (c >> 7); u.pn = (c >> 3) & 15; u.kb = (c & 7) * 512 * 2; return true; }
};
struct NoHook { static constexpr bool ON = false; __device__ __forceinline__ void operator()(f32x4 (&)[2][2][4][2], const Unit&, int, int, int, int, int) const {} };

template <bool F8, class Epi, class Sched, class Hook>
__device__ __forceinline__ void gemm_phase(LAS unsigned char* lds, const Gemm g, const Sched& S, const Epi& E, const Hook& HK, const int wv0) {
    int tid_ = wv0 * 64 + lane_id(); asm volatile("" : "+v"(tid_));
    const int tid = tid_, wid = __builtin_amdgcn_readfirstlane(tid >> 6), lane = tid & 63, wr = wid >> 2, wc = wid & 3, fr = lane & 15, fq = lane >> 4;
    const int K = g.K, nt = F8 ? K / 128 : K / BK;
    unsigned voffA, voffB;
    { int R, C; stage_rc(tid * 16, R, C); const int Rb = Epi::PERM ? ((R & ~31) + perm32(R & 31)) : R;
      voffA = (unsigned)(R * g.ldaB + C * 2); voffB = (unsigned)(Rb * g.ldbB + C * 2); }
    const size_t p1A = (size_t)64 * g.ldaB, p1B = (size_t)64 * g.ldbB;
    const size_t kstep = (size_t)(BK * 2);
    const size_t hstepA = (size_t)HALF * g.ldaB, hstepB = (size_t)HALF * g.ldbB;
    const size_t tstepA = 2 * hstepA, tstepB = 2 * hstepB;
    const unsigned ldsw = (unsigned)wid * 1024u;
    const unsigned ldsbase = (unsigned)(uintptr_t)lds;
    const int aoff = lds_byte(wr * 64 + fr, fq * 8), boff = lds_byte(wc * 32 + fr, fq * 8);
#define PG8_SA(b, h) (((b) * 2 + (h)) * HTB)
#define PG8_SB(b, h) ((4 + (b) * 2 + (h)) * HTB)
#define PG8_STAGE(bufoff, gbase, voff) do { const char* sb_ = (const char*)(gbase); const unsigned ld_ = ldsbase + (unsigned)(bufoff) + ldsw; \
        _Pragma("unroll") for (int _i = 0; _i < 2; ++_i) { unsigned keep_; const char* sbi_ = sb_ + (_i ? voff##_p1 : 0); \
            asm volatile("s_mov_b32 %0, m0\n\ts_mov_b32 m0, %3\n\ts_nop 0\n\tglobal_load_lds_dwordx4 %1, %2\n\ts_mov_b32 m0, %0" : "=&s"(keep_) : "v"(voff), "s"(sbi_), "s"(ld_ + _i * 8192) : "memory"); } } while (0)
#define voffA_p1 p1A
#define voffB_p1 p1B
#define PG8_LDA(dst, b, h) do { _Pragma("unroll") for (int m = 0; m < 4; ++m) _Pragma("unroll") for (int k = 0; k < 2; ++k) dst[m][k] = *(const LAS bf16x8*)(lds + PG8_SA(b, h) + aoff + m * 2048 + k * 1024); } while (0)
#define PG8_LDB(dst, b, h) do { _Pragma("unroll") for (int n = 0; n < 2; ++n) _Pragma("unroll") for (int k = 0; k < 2; ++k) dst[n][k] = *(const LAS bf16x8*)(lds + PG8_SB(b, h) + boff + n * 2048 + k * 1024); } while (0)
#define PG8_MMA(ai, bj, At, Bt) do { __builtin_amdgcn_s_setprio(1); \
        if constexpr (F8) { _Pragma("unroll") for (int m = 0; m < 4; ++m) _Pragma("unroll") for (int n = 0; n < 2; ++n) _Pragma("unroll") for (int k = 0; k < 2; ++k) \
            acc[ai][bj][m][n] = __builtin_bit_cast(f32x4, __builtin_amdgcn_mfma_i32_16x16x64_i8(__builtin_bit_cast(i32x4_t, Bt[n][k]), __builtin_bit_cast(i32x4_t, At[m][k]), __builtin_bit_cast(i32x4_t, acc[ai][bj][m][n]), 0, 0, 0)); } \
        else { _Pragma("unroll") for (int m = 0; m < 4; ++m) _Pragma("unroll") for (int n = 0; n < 2; ++n) _Pragma("unroll") for (int k = 0; k < 2; ++k) \
            acc[ai][bj][m][n] = __builtin_amdgcn_mfma_f32_16x16x32_bf16(Bt[n][k], At[m][k], acc[ai][bj][m][n], 0, 0, 0); } \
        __builtin_amdgcn_s_setprio(0); } while (0)
#define PG8_WAIT_V(n) asm volatile("s_waitcnt vmcnt(" #n ")" ::: "memory")
#define PG8_WAIT_L(n) asm volatile("s_waitcnt lgkmcnt(" #n ")" ::: "memory")
#define PG8_BAR __builtin_amdgcn_s_barrier()
#define PG8_SCHED __builtin_amdgcn_sched_barrier(0)
    Unit cur, nxt; int ui = 0;
    if (!S.next(0, cur)) return;
    f32x4 acc[2][2][4][2];
#pragma unroll
    for (int a = 0; a < 2; ++a)
#pragma unroll
        for (int b = 0; b < 2; ++b)
#pragma unroll
            for (int m = 0; m < 4; ++m)
#pragma unroll
                for (int n = 0; n < 2; ++n) acc[a][b][m][n] = (f32x4){0.f, 0.f, 0.f, 0.f};
    bf16x8 At[4][2], B0[2][2], B1[2][2];
    const char* cA = (const char*)g.A + (size_t)cur.pm * tstepA + cur.kb; const char* cB = (const char*)g.Bt + (size_t)cur.pn * tstepB + cur.kb;
    PG8_STAGE(PG8_SB(0, 0), cB, voffB); PG8_STAGE(PG8_SA(0, 0), cA, voffA); PG8_STAGE(PG8_SB(0, 1), cB + hstepB, voffB); PG8_STAGE(PG8_SA(0, 1), cA + hstepA, voffA);
    if (wr == 1) PG8_BAR;
    PG8_WAIT_V(4); PG8_BAR;
    PG8_STAGE(PG8_SB(1, 0), cB + kstep, voffB); PG8_STAGE(PG8_SA(1, 0), cA + kstep, voffA); PG8_STAGE(PG8_SB(1, 1), cB + hstepB + kstep, voffB);
    PG8_WAIT_V(6); PG8_BAR;
    for (;;) {
        bool has_next = false, dyn_next = false;
        if constexpr (Sched::DYN) { dyn_next = (ui + 1 >= S.R); }
        if (dyn_next) { if constexpr (Sched::DYN) { if (wid == 0 && lane == 0) { *(volatile LAS int*)(lds + (144 * 1024 - 256) + 36) = S.claim(); } } }
        else has_next = S.next(ui + 1, nxt);
        const char* nA = has_next ? (const char*)g.A + (size_t)nxt.pm * tstepA + nxt.kb : cA; const char* nB = has_next ? (const char*)g.Bt + (size_t)nxt.pn * tstepB + nxt.kb : cB;
        for (int t = 0; t < nt; t += 2) {
            const bool last = (t == nt - 2);
            const char* a1 = cA + (size_t)(t + 1) * kstep;
            const char* a2 = last ? nA : cA + (size_t)(t + 2) * kstep; const char* b2 = last ? nB : cB + (size_t)(t + 2) * kstep;
            const char* a3 = a2 + kstep; const char* b3 = b2 + kstep;
            if constexpr (Sched::DYN) { if (dyn_next && t == 2) { const int L_ = __builtin_amdgcn_readfirstlane(*(volatile LAS int*)(lds + (144 * 1024 - 256) + 36));
                has_next = (L_ >= 0); if (has_next) { S.S.map(L_, nxt); nA = (const char*)g.A + (size_t)nxt.pm * tstepA + nxt.kb; nB = (const char*)g.Bt + (size_t)nxt.pn * tstepB + nxt.kb; } } }
            if (Hook::ON) { if (t > 0 && (t & 15) == 0) HK(acc, cur, t >> 4, wr, wc, fr, fq); }
            PG8_LDB(B0, 0, 0); PG8_SCHED; PG8_LDA(At, 0, 0); PG8_STAGE(PG8_SA(1, 1), a1 + hstepA, voffA);
            PG8_WAIT_L(8); PG8_BAR; PG8_WAIT_L(0); PG8_MMA(0, 0, At, B0); PG8_BAR; PG8_SCHED;
            PG8_LDB(B1, 0, 1); PG8_STAGE(PG8_SB(0, 0), b2, voffB);
            PG8_BAR; PG8_WAIT_L(0); PG8_MMA(0, 1, At, B1); PG8_BAR;
            PG8_LDA(At, 0, 1); PG8_STAGE(PG8_SA(0, 0), a2, voffA);
            PG8_BAR; PG8_WAIT_L(0); PG8_MMA(1, 0, At, B0); PG8_BAR; PG8_SCHED;
            PG8_STAGE(PG8_SB(0, 1), b2 + hstepB, voffB);
            PG8_WAIT_V(6); PG8_BAR; PG8_MMA(1, 1, At, B1); PG8_BAR;
            PG8_LDB(B0, 1, 0); PG8_SCHED; PG8_LDA(At, 1, 0); PG8_STAGE(PG8_SA(0, 1), a2 + hstepA, voffA);
            PG8_WAIT_L(8); PG8_BAR; PG8_WAIT_L(0); PG8_MMA(0, 0, At, B0); PG8_BAR; PG8_SCHED;
            PG8_LDB(B1, 1, 1); PG8_STAGE(PG8_SB(1, 0), b3, voffB);
            PG8_BAR; PG8_WAIT_L(0); PG8_MMA(0, 1, At, B1); PG8_BAR;
            PG8_LDA(At, 1, 1); PG8_STAGE(PG8_SA(1, 0), a3, voffA);
            PG8_BAR; PG8_WAIT_L(0); PG8_MMA(1, 0, At, B0); PG8_BAR; PG8_SCHED;
            PG8_STAGE(PG8_SB(1, 1), b3 + hstepB, voffB);
            PG8_WAIT_V(6); PG8_BAR; PG8_MMA(1, 1, At, B1); PG8_BAR;
        }
        E(acc, cur, wr, wc, fr, fq);
        if (!has_next) break;
#pragma unroll
        for (int a = 0; a < 2; ++a)
#pragma unroll
            for (int b = 0; b < 2; ++b)
#pragma unroll
                for (int m = 0; m < 4; ++m)
#pragma unroll
                    for (int n = 0; n < 2; ++n) acc[a][b][m][n] = (f32x4){0.f, 0.f, 0.f, 0.f};
        cur = nxt; cA = nA; cB = nB; ++ui;
    }
    PG8_WAIT_V(0);
    if (wr == 0) PG8_BAR;
    PG8_BAR;
#undef PG8_SA
#undef PG8_SB
#undef PG8_STAGE
#undef voffA_p1
#undef voffB_p1
#undef PG8_LDA
#undef PG8_LDB
#undef PG8_MMA
#undef PG8_WAIT_V
#undef PG8_WAIT_L
#undef PG8_BAR
#undef PG8_SCHED
}
}

__device__ static const unsigned char G1_ISF8[116] = {1,1,1,1,1,1,1,1,1,1,1,1,1,1,1,1,1,1,1,1,1,1,1,1,1,1,1,1,1,1,1,1,1,1,1,1,1,1,1,1,1,1,1,1,1,1,1,1,0,0,0,0,1,1,1,1,1,1,1,1,1,1,1,1,1,1,1,1,1,1,1,1,1,1,1,1,1,1,1,1,1,1,1,1,1,1,1,1,1,1,1,1,1,1,1,1,1,1,1,1,1,1,1,1,1,1,1,1,1,1,1,1,1,1,1,1};
__device__ static const unsigned char G1_LOCAL[116] = {0,1,2,3,4,5,6,7,8,9,10,11,12,13,14,15,16,17,18,19,20,21,22,23,24,25,26,27,28,29,30,31,32,33,34,35,36,37,38,39,40,41,42,43,44,45,46,47,0,1,2,3,48,49,50,51,52,53,54,55,56,57,58,59,60,61,62,63,64,65,66,67,68,69,70,71,72,73,74,75,76,77,78,79,80,81,82,83,84,85,86,87,88,89,90,91,92,93,94,95,96,97,98,99,100,101,102,103,104,105,106,107,108,109,110,111};
__device__ static const unsigned char G1_BF_LIST[4] = {48,49,50,51};
__device__ static const unsigned char G1_F8_LIST[112] = {0,1,2,3,4,5,6,7,8,9,10,11,12,13,14,15,16,17,18,19,20,21,22,23,24,25,26,27,28,29,30,31,32,33,34,35,36,37,38,39,40,41,42,43,44,45,46,47,52,53,54,55,56,57,58,59,60,61,62,63,64,65,66,67,68,69,70,71,72,73,74,75,76,77,78,79,80,81,82,83,84,85,86,87,88,89,90,91,92,93,94,95,96,97,98,99,100,101,102,103,104,105,106,107,108,109,110,111,112,113,114,115};
__device__ __forceinline__ int g1_global_bf(int lp) { return G1_BF_LIST[lp]; }
__device__ __forceinline__ int g1_global_f8(int lp) { return G1_F8_LIST[lp]; }
__device__ __forceinline__ void g1_dest(unsigned char* ws, int pn, bf16_t*& base, int& ld, int& col, int& act) {
    act = 0;
    if (pn < 4)        { base = (bf16_t*)(ws + WS_QA); ld = 1024; col = pn * 256; }
    else if (pn == 4)  { base = (bf16_t*)(ws + WS_KA); ld = 256;  col = 0; }
    else if (pn == 5)  { base = (bf16_t*)(ws + WS_VA); ld = 256;  col = 0; }
    else if (pn < 10)  { base = (bf16_t*)(ws + WS_G4); ld = 4096; col = (pn - 6) * 256; act = 1; }
    else if (pn < 14)  { base = (bf16_t*)(ws + WS_QB); ld = 1024; col = (pn - 10) * 256; }
    else if (pn < 18)  { base = (bf16_t*)(ws + WS_KB); ld = 1024; col = (pn - 14) * 256; }
    else if (pn < 22)  { base = (bf16_t*)(ws + WS_VB); ld = 1024; col = (pn - 18) * 256; }
    else if (pn < 26)  { base = (bf16_t*)(ws + WS_G4); ld = 4096; col = 1024 + (pn - 22) * 256; act = 1; }
    else if (pn < 32)  { base = (bf16_t*)(ws + WS_CC); ld = 1536; col = (pn - 26) * 256; }
    else if (pn < 36)  { base = (bf16_t*)(ws + WS_G4); ld = 4096; col = 2048 + (pn - 32) * 256; act = 1; }
    else if (pn < 40)  { base = (bf16_t*)(ws + WS_QD); ld = 1024; col = (pn - 36) * 256; }
    else if (pn < 44)  { base = (bf16_t*)(ws + WS_KD); ld = 1024; col = (pn - 40) * 256; }
    else if (pn < 48)  { base = (bf16_t*)(ws + WS_VD); ld = 1024; col = (pn - 44) * 256; }
    else if (pn < 52)  { base = (bf16_t*)(ws + WS_G4); ld = 4096; col = 3072 + (pn - 48) * 256; act = 1; }
    else               { base = (bf16_t*)(ws + WS_MG); ld = 16384; col = (pn - 52) * 256; act = 2; }
}
struct EpiG1 {
    static constexpr bool PERM = true;
    unsigned char* ws; int f8; const float* hs; const float* wsc;
    __device__ __forceinline__ void operator()(const f32x4 (&acc)[2][2][4][2], const pg8::Unit& u, int wr, int wc, int fr, int fq) const {
        unsigned char* wsl = ws; asm volatile("" : "+s"(wsl));
        const int gpn = f8 ? g1_global_f8(u.pn) : g1_global_bf(u.pn);
        bf16_t* base; int ld, col, act; g1_dest(wsl, gpn, base, ld, col, act);
        const int row0 = u.pm * 256 + wr * 64 + fr, col0 = col + wc * 32 + 8 * fq;
        f32x4 cs[2][2];
        if (f8) {
#pragma unroll
            for (int bj = 0; bj < 2; ++bj) { const float* wp = wsc + gpn * 256 + bj * 128 + wc * 32 + 8 * fq; cs[bj][0] = *(const f32x4*)wp; cs[bj][1] = *(const f32x4*)(wp + 4); }
            if (act == 2) {
#pragma unroll
                for (int bj = 0; bj < 2; ++bj)
#pragma unroll
                    for (int n = 0; n < 2; ++n) cs[bj][n] = *(const f32x4*)(wsc + 13312 + (2 * bj + n) * 4096 + (gpn - 52) * 64 + wc * 16 + fq * 4) * -LOG2E; }
        }
        float rs8[2][4];
#pragma unroll
        for (int ai = 0; ai < 2; ++ai)
#pragma unroll
            for (int m = 0; m < 4; ++m) rs8[ai][m] = f8 ? hs[row0 + ai * 128 + m * 16] : 1.0f;
        if (f8 && act == 2) {
            bf16_t* mgb = (bf16_t*)(wsl + WS_MG) + (gpn - 52) * 64 + wc * 16 + fq * 4;
#pragma unroll
            for (int ai = 0; ai < 2; ++ai)
#pragma unroll
                for (int m = 0; m < 4; ++m) { const int row = row0 + ai * 128 + m * 16; bf16_t* rowp = mgb + (size_t)row * 16384;
                    const float rsc = rs8[ai][m];
                    f32x4 u[4];
#pragma unroll
                    for (int bj = 0; bj < 2; ++bj)
#pragma unroll
                        for (int n = 0; n < 2; ++n)
#pragma unroll
                            for (int j = 0; j < 4; ++j) u[bj * 2 + n][j] = 1.0f + fast_exp2(fminf((float)__float_as_int(acc[ai][bj][m][n][j]) * (rsc * cs[bj][n][j]), 60.0f));
                    f32x4 sv[4];
#pragma unroll
                    for (int b = 0; b < 4; ++b)
#pragma unroll
                        for (int j = 0; j < 4; ++j) sv[b][j] = fast_rcp(u[b][j]);
#pragma unroll
                    for (int pl = 0; pl < 4; ++pl) { const f32x4 av = pl < 3 ? sv[pl] * u[pl < 3 ? pl + 1 : 3] : sv[3];
                        u32x2 w; w.x = cvt_pk_bf16(av[0], av[1]); w.y = cvt_pk_bf16(av[2], av[3]);
                        *(u32x2*)(rowp + pl * 4096) = w; }
                    asm volatile("" ::: "memory"); }
            return;
        }
#pragma unroll
        for (int ai = 0; ai < 2; ++ai)
#pragma unroll
            for (int m = 0; m < 4; ++m) { const int row = row0 + ai * 128 + m * 16; bf16_t* rowp = base + (size_t)row * ld + col0;
                const float rsc = rs8[ai][m];
#pragma unroll
                for (int bj = 0; bj < 2; ++bj) { f32x4 v0 = acc[ai][bj][m][0], v1 = acc[ai][bj][m][1];
                    {
                    if (f8) {
#pragma unroll
                        for (int j = 0; j < 4; ++j) { v0[j] = (float)__float_as_int(v0[j]) * (rsc * cs[bj][0][j]); v1[j] = (float)__float_as_int(v1[j]) * (rsc * cs[bj][1][j]); } }
                    if (act == 1) {
#pragma unroll
                        for (int j = 0; j < 4; ++j) { v0[j] = silu_f(v0[j]); v1[j] = silu_f(v1[j]); } }
                    else if (act == 2) {
#pragma unroll
                        for (int j = 0; j < 4; ++j) { v0[j] = sigm_f(v0[j]); v1[j] = sigm_f(v1[j]); } }
                    }
                    u32x4 w; w.x = cvt_pk_bf16(v0[0], v0[1]); w.y = cvt_pk_bf16(v0[2], v0[3]); w.z = cvt_pk_bf16(v1[0], v1[1]); w.w = cvt_pk_bf16(v1[2], v1[3]);
                    *(u32x4*)(rowp + bj * 128) = w; }
                asm volatile("" ::: "memory"); }
    }
};
struct EpiPlain {
    static constexpr bool PERM = true;
    bf16_t* O; int ld;
    __device__ __forceinline__ void operator()(const f32x4 (&acc)[2][2][4][2], const pg8::Unit& u, int wr, int wc, int fr, int fq) const {
        const int row0 = u.pm * 256 + wr * 64 + fr, col0 = u.pn * 256 + wc * 32 + 8 * fq;
#pragma unroll
        for (int ai = 0; ai < 2; ++ai)
#pragma unroll
            for (int m = 0; m < 4; ++m) { bf16_t* rowp = O + (size_t)(row0 + ai * 128 + m * 16) * ld + col0;
#pragma unroll
                for (int bj = 0; bj < 2; ++bj) { const f32x4 v0 = acc[ai][bj][m][0], v1 = acc[ai][bj][m][1];
                    u32x4 w; w.x = cvt_pk_bf16(v0[0], v0[1]); w.y = cvt_pk_bf16(v0[2], v0[3]); w.z = cvt_pk_bf16(v1[0], v1[1]); w.w = cvt_pk_bf16(v1[2], v1[3]);
                    *(u32x4*)(rowp + bj * 128) = w; } }
    }
};
struct HookMerge {
    static constexpr bool ON = true;
    const bf16_t* MG;
    __device__ __forceinline__ void operator()(f32x4 (&acc)[2][2][4][2], const pg8::Unit& u, int seg, int wr, int wc, int fr, int fq) const {
        const int row0 = u.pm * 256 + wr * 64 + fr, col0 = u.pn * 256 + wc * 32 + 8 * fq;
        u32x4 gA[4][2], gB[4][2];
#define HK_LOAD(G, AI) do { _Pragma("unroll") for (int mm = 0; mm < 4; ++mm) { const bf16_t* rowp = MG + (size_t)(row0 + (AI) * 128 + mm * 16) * 16384 + (seg - 1) * 4096 + col0; \
            _Pragma("unroll") for (int bj = 0; bj < 2; ++bj) gld16(G[mm][bj], rowp + bj * 128); } } while (0)
#define HK_COMP(G, AI) do { _Pragma("unroll") for (int mm = 0; mm < 4; ++mm) _Pragma("unroll") for (int bj = 0; bj < 2; ++bj) { const u32x4 p = G[mm][bj]; \
            f32x4 r0, r1; r0[0] = bflo(p.x); r0[1] = bfhi(p.x); r0[2] = bflo(p.y); r0[3] = bfhi(p.y); r1[0] = bflo(p.z); r1[1] = bfhi(p.z); r1[2] = bflo(p.w); r1[3] = bfhi(p.w); \
            acc[AI][bj][mm][0] *= r0; acc[AI][bj][mm][1] *= r1; } } while (0)
#define HK_WAIT(N) do { asm volatile("s_waitcnt vmcnt(" #N ")" ::: "memory"); __builtin_amdgcn_sched_barrier(0); } while (0)
        HK_LOAD(gA, 0); HK_LOAD(gB, 1);
        HK_WAIT(8); HK_COMP(gA, 0);
        HK_WAIT(0); HK_COMP(gB, 1);
#undef HK_LOAD
#undef HK_COMP
#undef HK_WAIT
    }
};
struct EpiMerge {
    static constexpr bool PERM = true;
    const bf16_t* MG; bf16_t* O;
    __device__ __forceinline__ void operator()(const f32x4 (&acc)[2][2][4][2], const pg8::Unit& u, int wr, int wc, int fr, int fq) const {
        const int row0 = u.pm * 256 + wr * 64 + fr, col0 = u.pn * 256 + wc * 32 + 8 * fq;
        u32x4 sg[2][4][2];
#pragma unroll
        for (int ai = 0; ai < 2; ++ai)
#pragma unroll
            for (int m = 0; m < 4; ++m)
#pragma unroll
                for (int bj = 0; bj < 2; ++bj) sg[ai][m][bj] = *(const u32x4*)(MG + (size_t)(row0 + ai * 128 + m * 16) * 16384 + 3 * 4096 + col0 + bj * 128);
#pragma unroll
        for (int ai = 0; ai < 2; ++ai)
#pragma unroll
            for (int m = 0; m < 4; ++m) { const size_t row = (size_t)(row0 + ai * 128 + m * 16);
#pragma unroll
                for (int bj = 0; bj < 2; ++bj) { const u32x4 sv = sg[ai][m][bj];
                    const f32x4 v0 = acc[ai][bj][m][0], v1 = acc[ai][bj][m][1];
                    u32x4 w; w.x = cvt_pk_bf16(v0[0] * bflo(sv.x), v0[1] * bfhi(sv.x)); w.y = cvt_pk_bf16(v0[2] * bflo(sv.y), v0[3] * bfhi(sv.y));
                    w.z = cvt_pk_bf16(v1[0] * bflo(sv.z), v1[1] * bfhi(sv.z)); w.w = cvt_pk_bf16(v1[2] * bflo(sv.w), v1[3] * bfhi(sv.w));
                    *(u32x4*)(O + row * 4096 + col0 + bj * 128) = w; } }
    }
};
struct EpiCtxPart3 {
    static constexpr bool PERM = true;
    const bf16_t* MG; float* P;
    __device__ __forceinline__ void operator()(f32x4 (&acc)[2][2][4][2], const pg8::Unit& u, int wr, int wc, int fr, int fq) const {
        const int kc = u.kb >> 10, br = kc >> 1;
        const int row0 = u.pm * 256 + wr * 64 + fr, col0 = u.pn * 256 + wc * 32 + 8 * fq;
        for (int pl = br; pl < 4; ++pl) {
            u32x4 sg[2][4][2];
#pragma unroll
            for (int ai = 0; ai < 2; ++ai)
#pragma unroll
                for (int m = 0; m < 4; ++m)
#pragma unroll
                    for (int bj = 0; bj < 2; ++bj) gld16(sg[ai][m][bj], MG + (size_t)(row0 + ai * 128 + m * 16) * 16384 + pl * 4096 + col0 + bj * 128);
            GLD_WAIT();
#pragma unroll
            for (int ai = 0; ai < 2; ++ai)
#pragma unroll
                for (int m = 0; m < 4; ++m)
#pragma unroll
                    for (int bj = 0; bj < 2; ++bj) { const u32x4 sv = sg[ai][m][bj];
                        f32x4 r0, r1; r0[0] = bflo(sv.x); r0[1] = bfhi(sv.x); r0[2] = bflo(sv.y); r0[3] = bfhi(sv.y); r1[0] = bflo(sv.z); r1[1] = bfhi(sv.z); r1[2] = bflo(sv.w); r1[3] = bfhi(sv.w);
                        acc[ai][bj][m][0] *= r0; acc[ai][bj][m][1] *= r1; }
        }
        float* Pk = P + (size_t)kc * MCTX * 4096;
#pragma unroll
        for (int ai = 0; ai < 2; ++ai)
#pragma unroll
            for (int m = 0; m < 4; ++m) { const size_t rowc = (size_t)(row0 + ai * 128 + m * 16 - MLAT);
#pragma unroll
                for (int bj = 0; bj < 2; ++bj) { *(f32x4*)(Pk + rowc * 4096 + col0 + bj * 128) = acc[ai][bj][m][0]; *(f32x4*)(Pk + rowc * 4096 + col0 + bj * 128 + 4) = acc[ai][bj][m][1]; } }
    }
};
struct EpiCtxPart4 {
    static constexpr bool PERM = true;
    float* P;
    __device__ __forceinline__ void operator()(const f32x4 (&acc)[2][2][4][2], const pg8::Unit& u, int wr, int wc, int fr, int fq) const {
        const int kc = u.kb >> 10;
        const int row0 = u.pm * 256 + wr * 64 + fr - MLAT, col0 = u.pn * 256 + wc * 32 + 8 * fq;
        float* Pk = P + (size_t)kc * MCTX * 4096;
#pragma unroll
        for (int ai = 0; ai < 2; ++ai)
#pragma unroll
            for (int m = 0; m < 4; ++m) { const size_t rowc = (size_t)(row0 + ai * 128 + m * 16);
#pragma unroll
                for (int bj = 0; bj < 2; ++bj) { *(f32x4*)(Pk + rowc * 4096 + col0 + bj * 128) = acc[ai][bj][m][0]; *(f32x4*)(Pk + rowc * 4096 + col0 + bj * 128 + 4) = acc[ai][bj][m][1]; } }
    }
};
struct EpiResid {
    static constexpr bool PERM = false;
    const float* xin; const float* cin; float* xout; float* cout; const float* mods;
    __device__ __forceinline__ void operator()(const f32x4 (&acc)[2][2][4][2], const pg8::Unit& u, int wr, int wc, int fr, int fq) const {
        const int j = u.pm < 32 ? 0 : (u.pm < 64 ? 1 : 2);
        const int rloc = (u.pm < 64 ? u.pm * 256 : (u.pm - 64) * 256) + wr * 64 + fr, col0 = u.pn * 256 + wc * 32 + 4 * fq;
        const float* bi = u.pm < 64 ? xin : cin; float* bo = u.pm < 64 ? xout : cout;
        const float* gt = mods + j * 12288 + 8192 + col0;
        f32x4 gv[2][2];
#pragma unroll
        for (int bj = 0; bj < 2; ++bj)
#pragma unroll
            for (int n = 0; n < 2; ++n) gv[bj][n] = *(const f32x4*)(gt + bj * 128 + n * 16);
#pragma unroll
        for (int ai = 0; ai < 2; ++ai) {
            f32x4 rb[4][2][2];
#pragma unroll
            for (int m = 0; m < 4; ++m) { const size_t off = (size_t)(rloc + ai * 128 + m * 16) * 4096 + col0;
#pragma unroll
                for (int bj = 0; bj < 2; ++bj)
#pragma unroll
                    for (int n = 0; n < 2; ++n) gld16f(rb[m][bj][n], bi + off + bj * 128 + n * 16); }
            GLD_WAIT();
#pragma unroll
            for (int m = 0; m < 4; ++m) { const size_t off = (size_t)(rloc + ai * 128 + m * 16) * 4096 + col0;
#pragma unroll
                for (int bj = 0; bj < 2; ++bj)
#pragma unroll
                    for (int n = 0; n < 2; ++n) *(f32x4*)(bo + off + bj * 128 + n * 16) = rb[m][bj][n] + gv[bj][n] * acc[ai][bj][m][n]; }
            asm volatile("" ::: "memory"); }
    }
};

namespace att {
#define SBAR() __builtin_amdgcn_sched_barrier(0)
__device__ __forceinline__ int crowc(int r) { return (r & 3) + 8 * (r >> 2); }
template <int DQK> __device__ __forceinline__ int kaddr(int row, int g) {
    const int r = row & 31;
    if (DQK == 128) { const int f = (r & 7) | ((r >> 1) & 8); return row * 256 + ((g ^ f) << 4); }
    else { const int s = ((r >> 1) & 3) | ((r >> 2) & 4); return row * (DQK * 2) + ((g ^ s) << 4); }
}
__device__ __forceinline__ int v_st(int k, int c) { const int kk = (k & ~0xC) | ((k & 4) << 1) | ((k & 8) >> 1); return ((kk >> 3) * 4 + (c >> 5)) * 512 + ((kk & 7) * 32 + (c & 31)) * 2; }
__device__ __forceinline__ int v_rd_base(int lane) { return ((lane & 3) << 3) | (((lane >> 2) & 3) << 6) | (((lane >> 4) & 1) << 5) | (((lane >> 5) & 1) << 8); }
constexpr int v_rd_off(int d0, int ks, int half) { return d0 * 512 + ks * 4096 + half * 2048; }
template <int OFF> __device__ __forceinline__ s16x4 tr_read(int vb) {
    s16x4 r; asm volatile("ds_read_b64_tr_b16 %0, %1 offset:%2" : "=&v"(r) : "v"(vb), "i"(OFF) : "memory"); return r;
}
template <int D0> __device__ __forceinline__ void pv_one(f32x16& od, int vb, bf16x8 pa0, bf16x8 pa1, bf16x8 pa2, bf16x8 pa3) {
    const s16x4 l0 = tr_read<v_rd_off(D0, 0, 0)>(vb), h0 = tr_read<v_rd_off(D0, 0, 1)>(vb), l1 = tr_read<v_rd_off(D0, 1, 0)>(vb), h1 = tr_read<v_rd_off(D0, 1, 1)>(vb);
    const s16x4 l2 = tr_read<v_rd_off(D0, 2, 0)>(vb), h2 = tr_read<v_rd_off(D0, 2, 1)>(vb), l3 = tr_read<v_rd_off(D0, 3, 0)>(vb), h3 = tr_read<v_rd_off(D0, 3, 1)>(vb);
    asm volatile("s_waitcnt lgkmcnt(0)" ::: "memory"); SBAR();
#define PK(L, H) (bf16x8){L[0], L[1], L[2], L[3], H[0], H[1], H[2], H[3]}
    od = __builtin_amdgcn_mfma_f32_32x32x16_bf16(pa0, PK(l0, h0), od, 0, 0, 0);
    od = __builtin_amdgcn_mfma_f32_32x32x16_bf16(pa1, PK(l1, h1), od, 0, 0, 0);
    od = __builtin_amdgcn_mfma_f32_32x32x16_bf16(pa2, PK(l2, h2), od, 0, 0, 0);
    od = __builtin_amdgcn_mfma_f32_32x32x16_bf16(pa3, PK(l3, h3), od, 0, 0, 0);
#undef PK
}
__device__ __forceinline__ void pv_d0(f32x16* o, int vb, bf16x8 pa0, bf16x8 pa1, bf16x8 pa2, bf16x8 pa3) {
    pv_one<0>(o[0], vb, pa0, pa1, pa2, pa3); pv_one<1>(o[1], vb, pa0, pa1, pa2, pa3); pv_one<2>(o[2], vb, pa0, pa1, pa2, pa3); pv_one<3>(o[3], vb, pa0, pa1, pa2, pa3);
}

constexpr int V_BYTES = 64 * 128 * 2;
template <int DQK> constexpr int k_bytes() { return 64 * DQK * 2; }
template <int DQK> constexpr int ring_k() { return DQK == 192 ? 3 : 4; }
template <int DQK> constexpr int ring_v() { return 4; }
template <int DQK> constexpr int off_k() { return ring_v<DQK>() * V_BYTES; }
template <int DQK> constexpr int off_li() { return off_k<DQK>() + ring_k<DQK>() * k_bytes<DQK>(); }
template <int DQK> constexpr int off_bias() { return off_li<DQK>() + 1024; }
constexpr int BIAS_SLACK = 256;
constexpr int ATT_LDS_MAX = 4 * V_BYTES + 3 * 64 * 192 * 2 + 1024 + 256 + 15 * 32 * 4 + 512;

struct AU {
    const bf16_t* Q;  int ldq;
    const bf16_t* Kl; const bf16_t* Vl;
    const bf16_t* Kc; const bf16_t* Vc;
    int ldk, ldv, nlat, nt;
    float C, MC, sinkL;
    int m0, m1;
    const float* rpb;
    const float* gq; const float* gq2;
    const float* rope; int qrope, tpos0;
    int out_mode;
    void* out; const bf16_t* gate; int ldo;
    const float* o0; const float* subw; float lam, om;
};

template <int DQK, int MODE>
__device__ __forceinline__ void attn_unit(const AU& u, LAS unsigned char* lds, const int wv0) {
    constexpr int NQ = DQK / 16, KB = k_bytes<DQK>(), NKP = DQK / 64, GPR = DQK / 8;
    int tid_ = wv0 * 64 + lane_id(); asm volatile("" : "+v"(tid_));
    const int tid = tid_, wid = __builtin_amdgcn_readfirstlane(tid >> 6), lane = tid & 63, r32 = lane & 31, hi = lane >> 5;
    constexpr int SK = ring_k<DQK>(), SV = ring_v<DQK>(), G_ = NKP + 2;
    LAS unsigned char* V_lds = lds; LAS unsigned char* K_lds = lds + off_k<DQK>();
    LAS float* li_l = (LAS float*)(lds + off_li<DQK>()) + wid * 32;
    LAS float* biasL = (LAS float*)(lds + off_bias<DQK>() + BIAS_SLACK);
    __syncthreads();
    if (MODE == 2) { if (tid < 480) { const int dr = tid >> 5, dc = tid & 31; biasL[tid] = dc < 31 ? u.rpb[dr * 31 + dc] * LOG2E - u.MC : 0.f; } }
    f32x16 o[4];
#pragma unroll
    for (int d = 0; d < 4; ++d)
#pragma unroll
        for (int r = 0; r < 16; ++r) o[d][r] = 0.f;
    float l_part = 0.f;
    bf16x8 qr[NQ];
    {
        constexpr int NQ1 = (DQK == 192) ? 8 : NQ;
        const bf16_t* Qw = u.Q + (size_t)(wid * 32 + r32) * u.ldq + hi * 8;
        u32x4 raw[NQ];
#pragma unroll
        for (int d0 = 0; d0 < NQ; ++d0) raw[d0] = *(const u32x4*)(Qw + d0 * 16);
        float qf[NQ][8];
#pragma unroll
        for (int d0 = 0; d0 < NQ; ++d0) { qf[d0][0] = bflo(raw[d0].x); qf[d0][1] = bfhi(raw[d0].x); qf[d0][2] = bflo(raw[d0].y); qf[d0][3] = bfhi(raw[d0].y);
            qf[d0][4] = bflo(raw[d0].z); qf[d0][5] = bfhi(raw[d0].z); qf[d0][6] = bflo(raw[d0].w); qf[d0][7] = bfhi(raw[d0].w); }
        float ss = 0.f;
#pragma unroll
        for (int d0 = 0; d0 < NQ1; ++d0)
#pragma unroll
            for (int q = 0; q < 8; ++q) ss += qf[d0][q] * qf[d0][q];
        ss = half_swap_sum(ss);
        const float qsc = (MODE == 0) ? u.C : 1.0f;
        const float rs = __builtin_amdgcn_rsqf(ss * (1.0f / (NQ1 * 16)) + EPS) * qsc;
#pragma unroll
        for (int d0 = 0; d0 < NQ1; ++d0) { const f32x4 g0 = *(const f32x4*)(u.gq + d0 * 16 + hi * 8), g1 = *(const f32x4*)(u.gq + d0 * 16 + hi * 8 + 4);
#pragma unroll
            for (int q = 0; q < 4; ++q) { qf[d0][q] *= rs * g0[q]; qf[d0][4 + q] *= rs * g1[q]; } }
        if constexpr (DQK == 192) {
            float s2 = 0.f;
#pragma unroll
            for (int d0 = 8; d0 < 12; ++d0)
#pragma unroll
                for (int q = 0; q < 8; ++q) s2 += qf[d0][q] * qf[d0][q];
            s2 = half_swap_sum(s2);
            const float rs2 = __builtin_amdgcn_rsqf(s2 * (1.0f / 64.f) + EPS) * qsc;
#pragma unroll
            for (int d0 = 8; d0 < 12; ++d0) { const f32x4 g0 = *(const f32x4*)(u.gq2 + (d0 - 8) * 16 + hi * 8), g1 = *(const f32x4*)(u.gq2 + (d0 - 8) * 16 + hi * 8 + 4);
#pragma unroll
                for (int q = 0; q < 4; ++q) { qf[d0][q] *= rs2 * g0[q]; qf[d0][4 + q] *= rs2 * g1[q]; } }
        }
        if (u.qrope) {
            const int tpos = u.tpos0 + wid * 32 + r32, grow = tpos >> 6, gcol = tpos & 63;
            if constexpr (DQK == 128) {
                const float* ct = u.rope; const float* st = u.rope + 4096;
#pragma unroll
                for (int d0 = 0; d0 < 4; ++d0) { const int idx = (d0 < 2 ? grow : gcol) * 32 + (d0 & 1) * 16 + hi * 8;
                    const f32x4 c0 = *(const f32x4*)(ct + idx), c1 = *(const f32x4*)(ct + idx + 4), s0 = *(const f32x4*)(st + idx), s1 = *(const f32x4*)(st + idx + 4);
#pragma unroll
                    for (int q = 0; q < 8; ++q) { const float c = q < 4 ? c0[q & 3] : c1[q & 3], sn = q < 4 ? s0[q & 3] : s1[q & 3]; const float x1 = qf[d0][q], x2 = qf[d0 + 4][q];
                        qf[d0][q] = x1 * c - x2 * sn; qf[d0 + 4][q] = x2 * c + x1 * sn; } }
            } else {
                constexpr int B0 = (DQK == 192) ? 8 : 0;
                const float* ct = u.rope + 8192; const float* st = u.rope + 8192 + 2048;
#pragma unroll
                for (int d0 = 0; d0 < 2; ++d0) { const int idx = (d0 == 0 ? grow : gcol) * 16 + hi * 8;
                    const f32x4 c0 = *(const f32x4*)(ct + idx), c1 = *(const f32x4*)(ct + idx + 4), s0 = *(const f32x4*)(st + idx), s1 = *(const f32x4*)(st + idx + 4);
#pragma unroll
                    for (int q = 0; q < 8; ++q) { const float c = q < 4 ? c0[q & 3] : c1[q & 3], sn = q < 4 ? s0[q & 3] : s1[q & 3]; const float x1 = qf[B0 + d0][q], x2 = qf[B0 + d0 + 2][q];
                        qf[B0 + d0][q] = x1 * c - x2 * sn; qf[B0 + d0 + 2][q] = x2 * c + x1 * sn; } }
            }
        }
#pragma unroll
        for (int d0 = 0; d0 < NQ; ++d0) { u32x4 w; w.x = cvt_pk_bf16(qf[d0][0], qf[d0][1]); w.y = cvt_pk_bf16(qf[d0][2], qf[d0][3]); w.z = cvt_pk_bf16(qf[d0][4], qf[d0][5]); w.w = cvt_pk_bf16(qf[d0][6], qf[d0][7]);
            qr[d0] = *reinterpret_cast<bf16x8*>(&w); }
    }
    int kgo[NKP], vgo[2];
#pragma unroll
    for (int p = 0; p < NKP; ++p) { const int pos = (wid + 8 * p) * 1024 + lane * 16, row = pos / (DQK * 2), slot = (pos % (DQK * 2)) >> 4, r = row & 31;
        const int g = (DQK == 128) ? (slot ^ ((r & 7) | ((r >> 1) & 8))) : (slot ^ (((r >> 1) & 3) | ((r >> 2) & 4)));
        kgo[p] = row * u.ldk + g * 8; }
#pragma unroll
    for (int p = 0; p < 2; ++p) { const int pos = (wid + 8 * p) * 1024 + lane * 16, sub = pos >> 9, within = pos & 511;
        const int kk = (sub >> 2) * 8 + (within >> 6), k = (kk & ~0xC) | ((kk & 4) << 1) | ((kk & 8) >> 1), cc = (sub & 3) * 32 + ((within & 63) >> 1);
        vgo[p] = k * u.ldv + cc; }
    const int vb0 = (int)(unsigned)(uintptr_t)V_lds + v_rd_base(lane);
    const int nlat = u.nlat, NT = u.nt;
#define TILE_K(j) ((j) < nlat ? u.Kl + (size_t)(j) * 64 * u.ldk : u.Kc + (size_t)((j) - nlat) * 64 * u.ldk)
#define TILE_V(j) ((j) < nlat ? u.Vl + (size_t)(j) * 64 * u.ldv : u.Vc + (size_t)((j) - nlat) * 64 * u.ldv)
    const int lastT = NT - 1;
    const unsigned kldsb = (unsigned)(uintptr_t)K_lds, vldsb = (unsigned)(uintptr_t)V_lds;
#define GLDS(sbase, voffb, ldsaddr) do { unsigned keep_; asm volatile("s_mov_b32 %0, m0\n\ts_mov_b32 m0, %3\n\ts_nop 0\n\tglobal_load_lds_dwordx4 %1, %2\n\ts_mov_b32 m0, %0" : "=&s"(keep_) : "v"(voffb), "s"(sbase), "s"(ldsaddr) : "memory"); } while (0)
#define DMA_K(j, slot) do { const int jj_ = (j) < lastT ? (j) : lastT; const bf16_t* kp_ = TILE_K(jj_); const unsigned kd_ = kldsb + (unsigned)((slot) * KB + wid * 1024); \
        _Pragma("unroll") for (int p = 0; p < NKP; ++p) GLDS(kp_, (unsigned)(kgo[p] * 2), kd_ + p * 8192); } while (0)
#define DMA_V(j, slot) do { const int jj_ = (j) < lastT ? (j) : lastT; const bf16_t* vp_ = TILE_V(jj_); const unsigned vd_ = vldsb + (unsigned)((slot) * V_BYTES + wid * 1024); \
        _Pragma("unroll") for (int p = 0; p < 2; ++p) GLDS(vp_, (unsigned)(vgo[p] * 2), vd_ + p * 8192); } while (0)
#define STEP_SYNC(N) do { asm volatile("s_waitcnt vmcnt(%0) lgkmcnt(0)" :: "n"(N) : "memory"); __builtin_amdgcn_s_barrier(); asm volatile("" ::: "memory"); SBAR(); } while (0)
#define INC(x, S) do { x = (x + 1 == (S)) ? 0 : x + 1; } while (0)
    constexpr int QGRP = (NQ == 12) ? 2 : NQ;
    int kab[(DQK == 128) ? 8 : 4];
#pragma unroll
    for (int j = 0; j < ((DQK == 128) ? 8 : 4); ++j) kab[j] = kaddr<DQK>(r32, j * 2 + hi);
#define QKT(P0, P1, kslot) do { const LAS unsigned char* kb_ = K_lds + (kslot) * KB; \
        _Pragma("unroll") for (int r = 0; r < 16; ++r) { P0[r] = pinit; P1[r] = pinit; } \
        _Pragma("unroll") for (int d0 = 0; d0 < NQ; ++d0) { const int ka_ = (DQK == 128) ? kab[d0] : kab[d0 & 3] + (d0 >> 2) * 128; \
            const bf16x8 b0_ = *(const LAS bf16x8*)(kb_ + ka_); const bf16x8 b1_ = *(const LAS bf16x8*)(kb_ + ka_ + 32 * DQK * 2); \
            P0 = __builtin_amdgcn_mfma_f32_32x32x16_bf16(b0_, qr[d0], P0, 0, 0, 0); P1 = __builtin_amdgcn_mfma_f32_32x32x16_bf16(b1_, qr[d0], P1, 0, 0, 0); \
            if ((d0 + 1) % QGRP == 0 && d0 + 1 < NQ) SBAR(); } } while (0)
    const float C = u.C, nMC = -u.MC, pinit = (MODE == 0) ? -u.MC : 0.f;
#define PART1(p0, p1, jj) do { const int j_ = (jj); bool plain = true; \
        if (MODE == 1) { if (j_ < nlat) { plain = false; \
            const int base = u.m0 + 64 * j_ - (wid * 32 + r32) + 128 + 4 * hi; \
            _Pragma("unroll") for (int r = 0; r < 16; ++r) { const int d0_ = base + crowc(r), d1_ = d0_ + 32; \
                p0[r] = ((unsigned)d0_ <= 256u) ? fmaf(p0[r], C, nMC) : -1e30f; p1[r] = ((unsigned)d1_ <= 256u) ? fmaf(p1[r], C, nMC) : -1e30f; } } } \
        if (MODE == 2) { if (j_ < nlat) { plain = false; \
            const int kr = u.m1 + j_, qrow = u.m0 + (wid >> 1); int rs = qrow - 4; rs = rs < 0 ? 0 : (rs > 120 ? 120 : rs); \
            if (kr < rs || kr >= rs + 8) { \
                _Pragma("unroll") for (int r = 0; r < 16; ++r) { p0[r] = -1e30f; p1[r] = -1e30f; } \
            } else { \
                const int wq = (wid & 1) * 32 + r32; int cs = wq - 8; cs = cs < 0 ? 0 : (cs > 48 ? 48 : cs); \
                const LAS float* bl = biasL + (kr - qrow + 7) * 32 + 15 - wq + 4 * hi; \
                const int cb = 4 * hi - cs; \
                _Pragma("unroll") for (int r = 0; r < 16; ++r) { const int k0_ = crowc(r), k1_ = k0_ + 32; \
                    const float b0_ = bl[k0_], b1_ = bl[k1_]; \
                    p0[r] = ((unsigned)(cb + k0_) < 16u) ? fmaf(p0[r], C, b0_) : -1e30f; p1[r] = ((unsigned)(cb + k1_) < 16u) ? fmaf(p1[r], C, b1_) : -1e30f; } \
            } } } \
        if (plain && MODE != 0) { _Pragma("unroll") for (int r = 0; r < 16; ++r) { p0[r] = fmaf(p0[r], C, nMC); p1[r] = fmaf(p1[r], C, nMC); } } \
        _Pragma("unroll") for (int r = 0; r < 16; ++r) p0[r] = fast_exp2(p0[r]); } while (0)
    bf16x8 pa0, pa1, pa2, pa3;
#define PK4(P, BASE, OUT) do { const unsigned a0 = cvt_pk_bf16(P[BASE + 0], P[BASE + 1]), a1 = cvt_pk_bf16(P[BASE + 2], P[BASE + 3]);   \
        const unsigned b0 = cvt_pk_bf16(P[BASE + 4], P[BASE + 5]), b1 = cvt_pk_bf16(P[BASE + 6], P[BASE + 7]);                              \
        auto r0 = __builtin_amdgcn_permlane32_swap(a0, b0, false, false); auto r1 = __builtin_amdgcn_permlane32_swap(a1, b1, false, false); \
        u32x4 w = {r0[0], r1[0], r0[1], r1[1]}; OUT = *reinterpret_cast<bf16x8*>(&w); } while (0)
#define PART2(p0, p1) do { \
        _Pragma("unroll") for (int r = 0; r < 16; ++r) p1[r] = fast_exp2(p1[r]); \
        float ps = 0.f; \
        _Pragma("unroll") for (int r = 0; r < 16; ++r) ps += p0[r]; \
        _Pragma("unroll") for (int r = 0; r < 16; ++r) ps += p1[r]; \
        l_part += ps; \
        PK4(p0, 0, pa0); PK4(p0, 8, pa1); PK4(p1, 0, pa2); PK4(p1, 8, pa3); } while (0)
    if constexpr (MODE == 0) {
        constexpr int NW = ((SK - 2) * G_ + 2) < ((SV - 2) * G_) ? ((SK - 2) * G_ + 2) : ((SV - 2) * G_);
#define KADR(d0) ((DQK == 128) ? kab[(d0) & 7] : kab[(d0) & 3] + ((d0) >> 2) * 128)
#define TRL(dst, D0) do { dst[0] = tr_read<v_rd_off(D0, 0, 0)>(vb_); dst[1] = tr_read<v_rd_off(D0, 0, 1)>(vb_); dst[2] = tr_read<v_rd_off(D0, 1, 0)>(vb_); dst[3] = tr_read<v_rd_off(D0, 1, 1)>(vb_); \
        dst[4] = tr_read<v_rd_off(D0, 2, 0)>(vb_); dst[5] = tr_read<v_rd_off(D0, 2, 1)>(vb_); dst[6] = tr_read<v_rd_off(D0, 3, 0)>(vb_); dst[7] = tr_read<v_rd_off(D0, 3, 1)>(vb_); } while (0)
#define QKT_P2(P0, P1, kslot, Q0, Q1, vbase, dj, dslot) do { const LAS unsigned char* kb_ = K_lds + (kslot) * KB; const int vb_ = (vbase); \
        _Pragma("unroll") for (int r = 0; r < 16; ++r) { P0[r] = pinit; P1[r] = pinit; } \
        bf16x8 kf_[2][2]; float ps_ = 0.f; \
        { const int ka_ = KADR(0); kf_[0][0] = *(const LAS bf16x8*)(kb_ + ka_); kf_[0][1] = *(const LAS bf16x8*)(kb_ + ka_ + 32 * DQK * 2); } \
        SBAR(); DMA_K(dj, dslot); SBAR(); \
        _Pragma("unroll") for (int d0 = 0; d0 < NQ; ++d0) { \
            if (d0 + 1 < NQ) { const int ka_ = KADR(d0 + 1); kf_[(d0 + 1) & 1][0] = *(const LAS bf16x8*)(kb_ + ka_); kf_[(d0 + 1) & 1][1] = *(const LAS bf16x8*)(kb_ + ka_ + 32 * DQK * 2); } \
            P0 = __builtin_amdgcn_mfma_f32_32x32x16_bf16(kf_[d0 & 1][0], qr[d0], P0, 0, 0, 0); P1 = __builtin_amdgcn_mfma_f32_32x32x16_bf16(kf_[d0 & 1][1], qr[d0], P1, 0, 0, 0); \
            _Pragma("unroll") for (int r = (16 * d0) / NQ; r < (16 * (d0 + 1)) / NQ; ++r) { Q1[r] = fast_exp2(Q1[r]); ps_ += Q0[r] + Q1[r]; } \
            if (d0 == 0) PK4(Q0, 0, pa0); \
            if (d0 == 1) PK4(Q0, 8, pa1); \
            if (d0 == NQ / 2) PK4(Q1, 0, pa2); \
            if (d0 == NQ - 1) { TRL(ta_, 0); TRL(tb_, 1); } \
            SBAR(); } \
        PK4(Q1, 8, pa3); l_part += ps_; } while (0)
#define PKV(L, H) (bf16x8){L[0], L[1], L[2], L[3], H[0], H[1], H[2], H[3]}
#define PVBLK(D0, CUR, P0, P1) do { \
        o[D0] = __builtin_amdgcn_mfma_f32_32x32x16_bf16(pa0, PKV(CUR[0], CUR[1]), o[D0], 0, 0, 0); o[D0] = __builtin_amdgcn_mfma_f32_32x32x16_bf16(pa1, PKV(CUR[2], CUR[3]), o[D0], 0, 0, 0); \
        o[D0] = __builtin_amdgcn_mfma_f32_32x32x16_bf16(pa2, PKV(CUR[4], CUR[5]), o[D0], 0, 0, 0); o[D0] = __builtin_amdgcn_mfma_f32_32x32x16_bf16(pa3, PKV(CUR[6], CUR[7]), o[D0], 0, 0, 0); \
        _Pragma("unroll") for (int r = 4 * D0; r < 4 * D0 + 4; ++r) { P0[r] = fast_exp2(P0[r]); } \
        SBAR(); } while (0)
#define PV_P1(vbase, P0, P1, dj, dslot) do { const int vb_ = (vbase); \
        asm volatile("s_waitcnt lgkmcnt(8)" ::: "memory"); SBAR(); PVBLK(0, ta_, P0, P1); DMA_V(dj, dslot); SBAR(); \
        TRL(ta_, 2); asm volatile("s_waitcnt lgkmcnt(8)" ::: "memory"); SBAR(); PVBLK(1, tb_, P0, P1); \
        TRL(tb_, 3); asm volatile("s_waitcnt lgkmcnt(8)" ::: "memory"); SBAR(); PVBLK(2, ta_, P0, P1); \
        asm volatile("s_waitcnt lgkmcnt(0)" ::: "memory"); SBAR(); PVBLK(3, tb_, P0, P1); } while (0)
        f32x16 pA0, pA1, pB0, pB1; s16x4 ta_[8], tb_[8];
#pragma unroll
        for (int j = 0; j < SK - 1; ++j) DMA_K(j, j);
#pragma unroll
        for (int j = 0; j < SV - 2; ++j) DMA_V(j, j);
        asm volatile("s_waitcnt vmcnt(0)" ::: "memory"); __syncthreads();
        int kc = 0, kl = SK - 1, vc = SV - 1, vl = SV - 2;
        DMA_K(SK - 1, kl); DMA_V(SV - 2, vl); SBAR();
        QKT(pA0, pA1, kc); PART1(pA0, pA1, 0);
        STEP_SYNC(NW); INC(kc, SK); INC(kl, SK); INC(vc, SV); INC(vl, SV);
        for (int t = 1; t + 1 < NT; t += 2) {
            QKT_P2(pB0, pB1, kc, pA0, pA1, vb0 + vc * V_BYTES, t + SK - 1, kl);
            PV_P1(vb0 + vc * V_BYTES, pB0, pB1, t + SV - 2, vl);
            STEP_SYNC(NW); INC(kc, SK); INC(kl, SK); INC(vc, SV); INC(vl, SV);
            QKT_P2(pA0, pA1, kc, pB0, pB1, vb0 + vc * V_BYTES, t + SK, kl);
            PV_P1(vb0 + vc * V_BYTES, pA0, pA1, t + SV - 1, vl);
            STEP_SYNC(NW); INC(kc, SK); INC(kl, SK); INC(vc, SV); INC(vl, SV);
        }
        QKT_P2(pB0, pB1, kc, pA0, pA1, vb0 + vc * V_BYTES, NT - 1, kl);
        PV_P1(vb0 + vc * V_BYTES, pB0, pB1, NT - 1, vl);
        STEP_SYNC(NW); INC(vc, SV);
        PART2(pB0, pB1); SBAR();
        pv_d0(o, vb0 + vc * V_BYTES, pa0, pa1, pa2, pa3);
#undef KADR
#undef QKT_P2
#undef TRL
#undef PKV
#undef PVBLK
#undef PV_P1
    } else {
        static_assert(SK == SV, "masked loop uses one ring index");
        f32x16 pA0, pA1;
#pragma unroll
        for (int j = 0; j < SK - 1; ++j) { DMA_K(j, j); DMA_V(j, j); }
        asm volatile("s_waitcnt vmcnt(0)" ::: "memory"); __syncthreads();
        int kc = 0, kl = SK - 1;
        for (int t = 0; t < NT; ++t) {
            DMA_K(t + SK - 1, kl); DMA_V(t + SK - 1, kl); SBAR();
            bool dead = false;
            if (MODE == 1) { if (t < nlat) { const int k0 = u.m0 + 64 * t, q0w = wid * 32; dead = (k0 - (q0w + 31) > 128) || (q0w - (k0 + 63) > 128); } }
            if (MODE == 2) { if (t < nlat) { const int kr = u.m1 + t, qrow = u.m0 + (wid >> 1); int rs = qrow - 4; rs = rs < 0 ? 0 : (rs > 120 ? 120 : rs); dead = (kr < rs || kr >= rs + 8); } }
            if (!dead) {
                QKT(pA0, pA1, kc);
                PART1(pA0, pA1, t); PART2(pA0, pA1); SBAR();
                pv_d0(o, vb0 + kc * V_BYTES, pa0, pa1, pa2, pa3);
            }
            STEP_SYNC((SK - 2) * G_); INC(kc, SK); INC(kl, SK);
        }
    }
    asm volatile("s_waitcnt vmcnt(0)" ::: "memory");
    const int lane_e = lane_id(), r32e = lane_e & 31, hie = lane_e >> 5;
    { auto rr = __builtin_amdgcn_permlane32_swap(__float_as_uint(l_part), __float_as_uint(l_part), false, false);
      l_part = __uint_as_float(rr[0]) + __uint_as_float(rr[1]); }
    l_part += fast_exp2(u.sinkL);
    if (hie == 0) li_l[r32e] = l_part;
    asm volatile("s_waitcnt lgkmcnt(0)" ::: "memory");
    float rli[16];
#pragma unroll
    for (int r = 0; r < 16; ++r) rli[r] = fast_rcp(li_l[crowc(r) + 4 * hie]);
    {
        int ldo = u.ldo; asm volatile("" : "+s"(ldo));
        const unsigned voff = (unsigned)(4 * hie * ldo + r32e);
        if (u.out_mode == 1) {
            float* Ow = (float*)u.out + (size_t)(wid * 32) * ldo;
#pragma unroll
            for (int r = 0; r < 16; ++r) { float* Or = Ow + (size_t)(crowc(r) * ldo);
#pragma unroll
                for (int d0 = 0; d0 < 4; ++d0) Or[voff + d0 * 32] = o[d0][r] * rli[r]; }
        } else if (u.out_mode == 0) {
            bf16_t* Ow = (bf16_t*)u.out + (size_t)(wid * 32) * ldo; const bf16_t* Gw = u.gate + (size_t)(wid * 32) * ldo;
#pragma unroll
            for (int rc = 0; rc < 16; rc += 4) {
                unsigned short gt[4][4];
#pragma unroll
                for (int r = 0; r < 4; ++r)
#pragma unroll
                    for (int d0 = 0; d0 < 4; ++d0) gt[r][d0] = (Gw + (size_t)(crowc(rc + r) * ldo))[voff + d0 * 32];
#pragma unroll
                for (int r = 0; r < 4; ++r)
#pragma unroll
                    for (int d0 = 0; d0 < 4; ++d0) (Ow + (size_t)(crowc(rc + r) * ldo))[voff + d0 * 32] = f2bf(o[d0][rc + r] * rli[rc + r] * bf2f(gt[r][d0]));
                asm volatile("" ::: "memory"); }
        } else {
            int ld0 = 2048; asm volatile("" : "+s"(ld0));
            const unsigned voff0 = (unsigned)(4 * hie * ld0 + r32e);
            const float* O0w = u.o0 + (size_t)(wid * 32) * ld0;
            float ssr[16];
#pragma unroll
            for (int rc = 0; rc < 16; rc += 4) {
                float ov[4][4];
#pragma unroll
                for (int r = 0; r < 4; ++r)
#pragma unroll
                    for (int d0 = 0; d0 < 4; ++d0) ov[r][d0] = (O0w + (size_t)(crowc(rc + r) * ld0))[voff0 + d0 * 32];
#pragma unroll
                for (int r = 0; r < 4; ++r) { float sacc = 0.f;
#pragma unroll
                    for (int d0 = 0; d0 < 4; ++d0) { const float dv = ov[r][d0] - u.lam * (o[d0][rc + r] * rli[rc + r]); o[d0][rc + r] = dv; sacc += dv * dv; }
                    ssr[rc + r] = sacc; }
                asm volatile("" ::: "memory"); }
#pragma unroll
            for (int r = 0; r < 16; ++r) ssr[r] = half_sum(ssr[r]);
            float sw[4];
#pragma unroll
            for (int d0 = 0; d0 < 4; ++d0) sw[d0] = u.subw[d0 * 32 + r32e] * u.om;
            bf16_t* Ow = (bf16_t*)u.out + (size_t)(wid * 32) * ldo; const bf16_t* Gw = u.gate + (size_t)(wid * 32) * ldo;
#pragma unroll
            for (int rc = 0; rc < 16; rc += 4) {
                unsigned short gt[4][4];
#pragma unroll
                for (int r = 0; r < 4; ++r)
#pragma unroll
                    for (int d0 = 0; d0 < 4; ++d0) gt[r][d0] = (Gw + (size_t)(crowc(rc + r) * ldo))[voff + d0 * 32];
#pragma unroll
                for (int r = 0; r < 4; ++r) { const float rsn = __builtin_amdgcn_rsqf(ssr[rc + r] * (1.0f / 128.f) + EPS);
#pragma unroll
                    for (int d0 = 0; d0 < 4; ++d0) (Ow + (size_t)(crowc(rc + r) * ldo))[voff + d0 * 32] = f2bf(o[d0][rc + r] * rsn * sw[d0] * bf2f(gt[r][d0])); }
                asm volatile("" ::: "memory"); }
        }
    }
#undef TILE_K
#undef TILE_V
#undef GLDS
#undef DMA_K
#undef DMA_V
#undef STEP_SYNC
#undef INC
#undef QKT
#undef PART1
#undef PART2
#undef PK4
}
}

struct Args { const float* in[31]; float* out; unsigned char* ws; int ph_lo, ph_hi; };
enum { I_X = 0, I_C, I_CTX, I_CCTX, I_WADA, I_BADA, I_GNORM, I_WIN, I_QNA, I_KNA, I_SINKA, I_QNB, I_KNB, I_RPB, I_GQA, I_GKVA, I_WQUP, I_WKVUP, I_QNNOPE, I_QNPE, I_KNNOPE, I_KNPE,
       I_QND, I_KND, I_LQ1, I_LK1, I_LQ2, I_LK2, I_SUBLN, I_WBR, I_WOUT };
constexpr int GRID = 256, NTHR = 512;
constexpr int LDS_BYTES = 144 * 1024;
constexpr int LDS_MISC = LDS_BYTES - 256;
static_assert(att::ATT_LDS_MAX <= LDS_MISC && pg8::STAGE_BYTES <= LDS_MISC, "LDS budget");

__device__ __forceinline__ void tr_tile_desc(const Args& a, int idx, const float*& src, int& lds_n, bf16_t*& dst, int& ldk, bool& zero, bool& q8, const unsigned*& cmx, float*& wscp, bool& firstk) {
    const int l = idx / 19240; int r = idx % 19240; zero = false; q8 = false; cmx = nullptr; wscp = nullptr; firstk = false;
    if (r < 14848) { const int tk = (r & 255) >> 3, tn = (r >> 8) * 8 + (r & 7); const int n0d = tn * 64; zero = (n0d == 8128); const int n0s = n0d < 8128 ? n0d : n0d - 64;
        src = a.in[I_WIN] + ((size_t)l * 4096 + tk * 128) * NIN + n0s; lds_n = NIN; ldk = 4096;
        const int pn = n0d >> 8, ro = n0d & 255;
        if (n0d >= 13312) {
            const int q = tn - 208, br = q >> 6, T = q & 63, pn2 = 52 + T; q8 = true; ldk = 4096 | ((br + 1) << 16);
            dst = (bf16_t*)(a.ws + WS_W8 + ((size_t)l * NT_F8 * 256 + G1_LOCAL[pn2] * 256) * 4096 + tk * 128);
            cmx = (const unsigned*)(a.ws + WS_CMAX) + (size_t)l * NIN + n0s; wscp = (float*)(a.ws + WS_WSC) + (size_t)l * NINP + n0d; firstk = (tk == 0); return; }
        if (!G1_ISF8[pn]) dst = (bf16_t*)(a.ws + WS_WIN) + ((size_t)l * NT_BF * 256 + G1_LOCAL[pn] * 256 + ro) * 4096 + tk * 128;
        else { q8 = true; dst = (bf16_t*)(a.ws + WS_W8 + ((size_t)l * NT_F8 * 256 + G1_LOCAL[pn] * 256 + ro) * 4096 + tk * 128);
            cmx = (const unsigned*)(a.ws + WS_CMAX) + (size_t)l * NIN + n0s; wscp = (float*)(a.ws + WS_WSC) + (size_t)l * NINP + n0d; firstk = (tk == 0); }
        return; }
    r -= 14848;
    if (r < 168) { const int tk = r / 24, tn = r % 24;
        src = a.in[I_WQUP] + ((size_t)l * 896 + tk * 128) * 1536 + tn * 64; lds_n = 1536; dst = (bf16_t*)(a.ws + WS_WQ) + ((size_t)l * 1536 + tn * 64) * 896 + tk * 128; ldk = 896; return; }
    r -= 168;
    if (r < 128) { const int tk = r / 32, tn = r % 32;
        src = a.in[I_WKVUP] + ((size_t)l * 512 + tk * 128) * 2048 + tn * 64; lds_n = 2048; dst = (bf16_t*)(a.ws + WS_WKV) + ((size_t)l * 2048 + tn * 64) * 512 + tk * 128; ldk = 512; return; }
    r -= 128;
    if (r < 2048) { const int br = r / 512, r2 = r % 512, tk = (r2 & 255) >> 5, tn = (r2 >> 8) * 32 + (r2 & 31);
        src = a.in[I_WBR] + (((size_t)l * 4 + br) * 1024 + tk * 128) * 4096 + tn * 64; lds_n = 4096; dst = (bf16_t*)(a.ws + WS_WB) + ((size_t)l * 4096 + tn * 64) * 4096 + br * 1024 + tk * 128; ldk = 4096; return; }
    r -= 2048;
    { const int tk = (r & 255) >> 3, tn = (r >> 8) * 8 + (r & 7);
        src = a.in[I_WOUT] + ((size_t)l * 4096 + tk * 128) * 4096 + tn * 64; lds_n = 4096; dst = (bf16_t*)(a.ws + WS_WO) + ((size_t)l * 4096 + tn * 64) * 4096 + tk * 128; ldk = 4096; }
}
__device__ __forceinline__ void phase_pre0(const Args& a, LAS unsigned char* lds, const int wv0) {
    const int tid = wv0 * 64 + lane_id(), bid = blockIdx.x;
    for (int un = bid; un < 4 * 58; un += GRID) {
        const int l = un / 58, cb = un % 58, c0 = cb * 512 + tid;
        if (c0 < NIN) {
            const float* wp = a.in[I_WIN] + (size_t)l * 4096 * NIN + c0;
            float m = 0.f, q = 0.f;
#pragma unroll 32
            for (int k = 0; k < CS_ROWS; ++k) { const float w = wp[(size_t)(k * 16) * NIN]; m = fmaxf(m, fabsf(w)); q = fmaf(w, w, q); }
            ((float*)(a.ws + WS_CMAX))[(size_t)l * NIN + c0] = m; ((float*)(a.ws + WS_CSQ))[(size_t)l * NIN + c0] = q;
        }
    }
    LAS float* sv = (LAS float*)lds;
    for (int un = bid; un < 4 * 6 * 32; un += GRID) {
        const int l = un / 192, cb = (un % 192) / 32, ksp = un % 32;
        __syncthreads();
        if (tid < 384) { const int j = tid >> 7, k = ksp * 128 + (tid & 127); const float cv = j < 2 ? a.in[I_C][j * 4096 + k] : a.in[I_CCTX][k]; sv[tid] = silu_f(cv); }
        __syncthreads();
        const float* wp = a.in[I_WADA] + ((size_t)l * 4096 + ksp * 128) * 12288 + cb * 2048 + tid * 4;
        f32x4 a0 = {0.f, 0.f, 0.f, 0.f}, a1 = a0, a2 = a0;
#pragma unroll 8
        for (int k = 0; k < 128; ++k) { const f32x4 w = *(const f32x4*)(wp + (size_t)k * 12288); a0 += w * sv[k]; a1 += w * sv[128 + k]; a2 += w * sv[256 + k]; }
        float* pp = (float*)(a.ws + WS_MODP) + ((size_t)(l * 32 + ksp) * 3) * 12288 + cb * 2048 + tid * 4;
        *(f32x4*)(pp) = a0; *(f32x4*)(pp + 12288) = a1; *(f32x4*)(pp + 2 * 12288) = a2;
    }
}
__device__ __forceinline__ void phase_prologue(const Args& a, LAS unsigned char* lds, const int wv0) {
    const int tid = wv0 * 64 + lane_id(), bid = blockIdx.x;
    LAS float* T = (LAS float*)lds;
    constexpr int NTILES = 4 * 19240;
    f32x4 rgA[4], rgB[4];
    bf16_t* dstA = nullptr; bf16_t* dstB = nullptr; int ldkA = 0, ldkB = 0; bool q8A = false, q8B = false, zA = false, zB = false, fkA = false, fkB = false;
    const unsigned* cmA = nullptr; const unsigned* cmB = nullptr; float* wsA = nullptr; float* wsB = nullptr;
#define TR_LOAD(RG, DST, LDK, Q8, ZZ, CM, WS, FK, tt) do { const float* src_; int ldn_; tr_tile_desc(a, (tt), src_, ldn_, DST, LDK, ZZ, Q8, CM, WS, FK); \
        _Pragma("unroll") for (int i = 0; i < 4; ++i) { const int idx = tid + 512 * i, kr = idx >> 4, c4 = (idx & 15) * 4; RG[i] = ZZ ? (f32x4){0.f, 0.f, 0.f, 0.f} : *(const f32x4*)(src_ + (size_t)kr * ldn_ + c4); } } while (0)
#define TR_TILE(RG, DST, LDK, Q8, ZZ, CM, WS, FK, tnext) do { \
        _Pragma("unroll") for (int i = 0; i < 4; ++i) { const int idx = tid + 512 * i, kr = idx >> 4, c4 = (idx & 15) * 4; \
            T[kr * 65 + c4 + 0] = RG[i][0]; T[kr * 65 + c4 + 1] = RG[i][1]; T[kr * 65 + c4 + 2] = RG[i][2]; T[kr * 65 + c4 + 3] = RG[i][3]; } \
        __syncthreads(); \
        bf16_t* dcur = DST; const int ldkc = (LDK) & 0xffff, pbr = ((LDK) >> 16) - 1; const bool q8c = Q8, zc = ZZ, fkc = FK; const unsigned* cmc = CM; float* wsc_ = WS; \
        if ((tnext) < NTILES) TR_LOAD(RG, DST, LDK, Q8, ZZ, CM, WS, FK, (tnext)); \
        _Pragma("unroll") for (int i = 0; i < 2; ++i) { const int idx = tid + 512 * i, n = idx >> 4, kc = (idx & 15) * 8; \
            float v[8]; \
            _Pragma("unroll") for (int q = 0; q < 8; ++q) v[q] = T[(kc + q) * 65 + n]; \
            if (q8c) { const float cm_ = zc ? 0.f : fmaxf(__uint_as_float(cmc[n]), 4.0f * sqrtf(((const float*)cmc)[(WS_CSQ - WS_CMAX) / 4 + n] * (1.0f / CS_ROWS))); const float sc_ = cm_ > 0.f ? 127.0f / cm_ : 0.f; \
                int qi[8]; \
                _Pragma("unroll") for (int q = 0; q < 8; ++q) qi[q] = (int)__builtin_rintf(__builtin_amdgcn_fmed3f(v[q] * sc_, -127.0f, 127.0f)) & 0xff; \
                u32x2 w8; w8.x = (unsigned)(qi[0] | (qi[1] << 8) | (qi[2] << 16) | (qi[3] << 24)); w8.y = (unsigned)(qi[4] | (qi[5] << 8) | (qi[6] << 16) | (qi[7] << 24)); \
                const int nn = pbr < 0 ? n : 128 * (pbr >> 1) + 32 * (n >> 4) + 8 * ((n >> 2) & 3) + 4 * (pbr & 1) + (n & 3); \
                *(u32x2*)((unsigned char*)dcur + (size_t)nn * ldkc + kc) = w8; \
                if (fkc && kc == 0) wsc_[n] = cm_ * (1.0f / 127.0f); } \
            else { u32x4 w; w.x = cvt_pk_bf16(v[0], v[1]); w.y = cvt_pk_bf16(v[2], v[3]); w.z = cvt_pk_bf16(v[4], v[5]); w.w = cvt_pk_bf16(v[6], v[7]); \
                *(u32x4*)(dcur + (size_t)n * ldkc + kc) = w; } } \
        __syncthreads(); } while (0)
    if (bid < NTILES) TR_LOAD(rgA, dstA, ldkA, q8A, zA, cmA, wsA, fkA, bid);
    if (bid + GRID < NTILES) TR_LOAD(rgB, dstB, ldkB, q8B, zB, cmB, wsB, fkB, bid + GRID);
    for (int t = bid; t < NTILES; t += 2 * GRID) {
        TR_TILE(rgA, dstA, ldkA, q8A, zA, cmA, wsA, fkA, t + 2 * GRID);
        if (t + GRID < NTILES) TR_TILE(rgB, dstB, ldkB, q8B, zB, cmB, wsB, fkB, t + 3 * GRID);
    }
#undef TR_LOAD
#undef TR_TILE
}

__device__ __forceinline__ void sincos_acc(float ang, float& c, float& s) {
    const double x = (double)ang;
    const double q = __builtin_rint(x * 0.6366197723675814);
    const double y = x - q * 1.5707963267948966 - q * 6.123233995736766e-17;
    const double y2 = y * y;
    const double sy = y * (1.0 + y2 * (-1.0 / 6 + y2 * (1.0 / 120 + y2 * (-1.0 / 5040 + y2 * (1.0 / 362880 + y2 * (-1.0 / 39916800 + y2 * (1.0 / 6227020800.0)))))));
    const double cy = 1.0 + y2 * (-0.5 + y2 * (1.0 / 24 + y2 * (-1.0 / 720 + y2 * (1.0 / 40320 + y2 * (-1.0 / 3628800 + y2 * (1.0 / 479001600.0))))));
    const int qi = ((int)q) & 3;
    const double sd = (qi == 0) ? sy : (qi == 1) ? cy : (qi == 2) ? -sy : -cy;
    const double cd = (qi == 0) ? cy : (qi == 1) ? -sy : (qi == 2) ? -cy : sy;
    c = (float)cd; s = (float)sd;
}
__device__ __forceinline__ float wave_maxabs(const float* p, int n, int lane) { float m = 0.f; for (int i = lane; i < n; i += 64) m = fmaxf(m, fabsf(p[i])); return wave_max(m); }
__device__ __forceinline__ float wave_dot(const float* p, const float* q, int n, int lane) { float s = 0.f; for (int i = lane; i < n; i += 64) s += p[i] * q[i]; return wave_sum(s); }
__device__ __forceinline__ void phase_mods(const Args& a, const int wv0) {
    const int tid = wv0 * 64 + lane_id(), bid = blockIdx.x, gid = bid * NTHR + tid;
    float* mods = (float*)(a.ws + WS_MODS); const float* mp = (const float*)(a.ws + WS_MODP);
    for (int i = gid; i < 4 * 3 * 12288; i += GRID * NTHR) { const int l = i / 36864, r = i % 36864, j = r / 12288, c = r % 12288;
        float s = a.in[I_BADA][l * 12288 + c];
        for (int ks = 0; ks < 32; ++ks) s += mp[((size_t)(l * 32 + ks) * 3 + j) * 12288 + c];
        mods[i] = s; }
    float* rope = (float*)(a.ws + WS_ROPE);
    if (gid < 4096) { const int pos = gid >> 5, j = gid & 31; double inv = 1.0; for (int q = 0; q < j; ++q) inv *= 0.7498942093324558;
        const float ang = (float)pos * (float)inv; float c, s; sincos_acc(ang, c, s); rope[gid] = c; rope[4096 + gid] = s; }
    else if (gid < 4096 + 2048) { const int g2 = gid - 4096, pos = g2 >> 4, j = g2 & 15; double inv = 1.0; for (int q = 0; q < j; ++q) inv *= 0.5623413251903491;
        const float ang = (float)pos * (float)inv; float c, s; sincos_acc(ang, c, s); rope[8192 + g2] = c; rope[8192 + 2048 + g2] = s; }
    if (bid >= 16 && bid < 20 && tid < 64) {
        const int l = bid - 16, lane = tid; float* bnd = (float*)(a.ws + WS_BND) + l * 32;
        const float SAFE = 1.03f;
        const float mqa = wave_maxabs(a.in[I_QNA] + l * 128, 128, lane), mka = wave_maxabs(a.in[I_KNA] + l * 128, 128, lane);
        const float mqb = wave_maxabs(a.in[I_QNB] + l * 128, 128, lane), mkb = wave_maxabs(a.in[I_KNB] + l * 128, 128, lane);
        const float mqn = wave_maxabs(a.in[I_QNNOPE] + l * 128, 128, lane), mkn = wave_maxabs(a.in[I_KNNOPE] + l * 128, 128, lane);
        const float mqp = wave_maxabs(a.in[I_QNPE] + l * 64, 64, lane), mkp = wave_maxabs(a.in[I_KNPE] + l * 64, 64, lane);
        const float mqd = wave_maxabs(a.in[I_QND] + l * 64, 64, lane), mkd = wave_maxabs(a.in[I_KND] + l * 64, 64, lane);
        const float bA = SAFE * 11.313708498984761f * mqa * mka;
        const float bB = SAFE * 11.313708498984761f * mqb * mkb;
        const float bC = SAFE * 0.07216878364870323f * (128.f * mqn * mkn + 64.f * mqp * mkp);
        const float bD = SAFE * 8.0f * mqd * mkd;
        const float li_[4] = {0.2f, 0.35550906759096934f, 0.4707130183435842f, 0.5560582041556406f};
        const float d1 = wave_dot(a.in[I_LQ1] + l * 64, a.in[I_LK1] + l * 64, 64, lane), d2 = wave_dot(a.in[I_LQ2] + l * 64, a.in[I_LK2] + l * 64, 64, lane);
        for (int h = 0; h < 8; ++h) {
            const float sk = a.in[I_SINKA][l * 8 + h]; const float MA = fmaxf(bA, sk);
            const float mr = wave_maxabs(a.in[I_RPB] + ((size_t)l * 8 + h) * 465, 465, lane);
            if (lane == 0) { bnd[h] = MA * LOG2E; bnd[8 + h] = (bB + mr) * LOG2E; bnd[19 + h] = (sk - MA) * LOG2E; }
        }
        if (lane == 0) { bnd[16] = bC * LOG2E; bnd[17] = bD * LOG2E; bnd[18] = expf(d1) - expf(d2) + li_[l]; }
    }
}

__device__ __forceinline__ void phase_xnorm(const Args& a, int l, const float* xin, const float* cin, float* cout, const int wv0) {
    int tid_ = wv0 * 64 + lane_id(); asm volatile("" : "+v"(tid_)); const int tid = tid_, lane = tid & 63, wv = blockIdx.x * 8 + (tid >> 6);
    const float* g = a.in[I_GNORM] + l * 4096; const float* mods = (const float*)(a.ws + WS_MODS) + l * 36864;
    bf16_t* H = (bf16_t*)(a.ws + WS_H);
    for (int row = wv; row < MTOT; row += GRID * 8) {
        const float* xr = row < MLAT ? xin + (size_t)row * 4096 : cin + (size_t)(row - MLAT) * 4096;
        const int j = row < SEQ ? 0 : (row < MLAT ? 1 : 2);
        const float* sh = mods + j * 12288; const float* sc = sh + 4096;
        f32x4 v[16]; float ss = 0.f;
#pragma unroll
        for (int i = 0; i < 16; ++i) v[i] = *(const f32x4*)(xr + (i * 64 + lane) * 4);
        if (row >= MLAT && l >= 1) {
            const float* gtp = (const float*)(a.ws + WS_MODS) + (l - 1) * 36864 + 2 * 12288 + 8192; const float* P4 = (const float*)(a.ws + WS_P4) + (size_t)(row - MLAT) * 4096;
#pragma unroll
            for (int i = 0; i < 16; ++i) { const int c = (i * 64 + lane) * 4; f32x4 sacc = *(const f32x4*)(P4 + c);
                for (int kc = 1; kc < 8; ++kc) sacc += *(const f32x4*)(P4 + (size_t)kc * MCTX * 4096 + c);
                v[i] += *(const f32x4*)(gtp + c) * sacc; *(f32x4*)(cout + (size_t)(row - MLAT) * 4096 + c) = v[i]; }
        }
#pragma unroll
        for (int i = 0; i < 16; ++i) ss += v[i][0] * v[i][0] + v[i][1] * v[i][1] + v[i][2] * v[i][2] + v[i][3] * v[i][3];
        ss = wave_sum(ss);
        const float rs = 1.0f / sqrtf(ss * (1.0f / 4096.f) + EPS);
        float amax = 0.f;
#pragma unroll
        for (int ib = 0; ib < 16; ib += 4) {
            f32x4 gv[4], scv[4], shv[4];
#pragma unroll
            for (int i = 0; i < 4; ++i) { const int c = ((ib + i) * 64 + lane) * 4; gld16f(gv[i], g + c); gld16f(scv[i], sc + c); gld16f(shv[i], sh + c); }
            GLD_WAIT();
#pragma unroll
            for (int i = 0; i < 4; ++i) { const f32x4 hv = v[ib + i] * rs * gv[i] * (1.0f + scv[i]) + shv[i]; v[ib + i] = hv;
                amax = fmaxf(amax, fmaxf(fmaxf(fabsf(hv[0]), fabsf(hv[1])), fmaxf(fabsf(hv[2]), fabsf(hv[3])))); }
        }
        amax = wave_max(amax);
        const float qs = amax > 0.f ? 127.0f / amax : 0.f;
        if (lane == 0) ((float*)(a.ws + WS_HS))[row] = amax * (1.0f / 127.0f);
#pragma unroll
        for (int i = 0; i < 16; ++i) { const int c = (i * 64 + lane) * 4; const f32x4 hv = v[i];
            u32x2 w; w.x = cvt_pk_bf16(hv[0], hv[1]); w.y = cvt_pk_bf16(hv[2], hv[3]);
            *(u32x2*)(H + (size_t)row * 4096 + c) = w;
            const int q0 = (int)__builtin_rintf(hv[0] * qs), q1 = (int)__builtin_rintf(hv[1] * qs), q2 = (int)__builtin_rintf(hv[2] * qs), q3 = (int)__builtin_rintf(hv[3] * qs);
            *(unsigned*)(a.ws + WS_H8 + (size_t)row * 4096 + c) = (unsigned)(q0 & 0xff) | ((unsigned)(q1 & 0xff) << 8) | ((unsigned)(q2 & 0xff) << 16) | ((unsigned)q3 << 24); }
    }
}

__device__ __forceinline__ void unpack8(const u32x4 v, float (&x)[8]) { x[0] = bflo(v.x); x[1] = bfhi(v.x); x[2] = bflo(v.y); x[3] = bfhi(v.y); x[4] = bflo(v.z); x[5] = bfhi(v.z); x[6] = bflo(v.w); x[7] = bfhi(v.w); }
__device__ __forceinline__ u32x4 pack8(const float (&x)[8]) { u32x4 w; w.x = cvt_pk_bf16(x[0], x[1]); w.y = cvt_pk_bf16(x[2], x[3]); w.z = cvt_pk_bf16(x[4], x[5]); w.w = cvt_pk_bf16(x[6], x[7]); return w; }
template <int GL> __device__ __forceinline__ u32x4 norm_group(const u32x4 v, const float* gain, bool rope, const float* ct, const float* st, int lane) {
    float x[8]; unpack8(v, x);
    float ss = 0.f;
#pragma unroll
    for (int q = 0; q < 8; ++q) ss += x[q] * x[q];
    if (GL == 16) ss += swz_xor<8>(ss);
    ss += swz_xor<4>(ss); ss += swz_xor<2>(ss); ss += swz_xor<1>(ss);
    const float rs = __builtin_amdgcn_rsqf(ss * (1.0f / (GL * 8)) + EPS);
    const f32x4 g0 = *(const f32x4*)gain, g1 = *(const f32x4*)(gain + 4);
#pragma unroll
    for (int q = 0; q < 4; ++q) { x[q] *= rs * g0[q]; x[4 + q] *= rs * g1[q]; }
    if (rope) {
        const f32x4 c0 = *(const f32x4*)ct, c1 = *(const f32x4*)(ct + 4), s0 = *(const f32x4*)st, s1 = *(const f32x4*)(st + 4);
        const bool first = (lane & (GL - 1)) < GL / 2;
#pragma unroll
        for (int q = 0; q < 8; ++q) { const float p = swz_xor<GL / 2>(x[q]); const float c = q < 4 ? c0[q & 3] : c1[q & 3], sn = q < 4 ? s0[q & 3] : s1[q & 3];
            x[q] = first ? (x[q] * c - p * sn) : (x[q] * c + p * sn); }
    }
    return pack8(x);
}
__device__ __forceinline__ void phase_post1(const Args& a, int l, const int wv0) {
    int tid_ = wv0 * 64 + lane_id(); asm volatile("" : "+v"(tid_)); const int tid = tid_, lane = tid & 63, wv = blockIdx.x * 8 + (tid >> 6);
    const float* rope = (const float*)(a.ws + WS_ROPE); const float* c128 = rope, *s128 = rope + 4096, *c64 = rope + 8192, *s64 = rope + 8192 + 2048;
    const int l16 = lane & 15, l8 = lane & 7;
    const float* gka = a.in[I_KNA] + l * 128 + l16 * 8; const float* gkb = a.in[I_KNB] + l * 128 + l16 * 8; const float* gkd = a.in[I_KND] + l * 64 + l8 * 8;
    const float* gq0 = a.in[I_GQA] + l * 896 + lane * 8; const float* gq1 = a.in[I_GQA] + l * 896 + 512 + (lane < 48 ? lane : 0) * 8; const float* gkv = a.in[I_GKVA] + l * 512 + lane * 8;
    const float* gpe = a.in[I_KNPE] + l * 64 + l8 * 8;
    for (int row = wv; row < MTOT; row += GRID * 8) {
        const bool lat = row < MLAT; const int tpos = row & (SEQ - 1), grow = tpos >> 6, gcol = tpos & 63;
        bf16_t* ka = (bf16_t*)(a.ws + WS_KA) + (size_t)row * 256; bf16_t* kb = (bf16_t*)(a.ws + WS_KB) + (size_t)row * 1024; bf16_t* kd = (bf16_t*)(a.ws + WS_KD) + (size_t)row * 1024;
        bf16_t* cc = (bf16_t*)(a.ws + WS_CC) + (size_t)row * 1536;
        const u32x4 z = {0u, 0u, 0u, 0u};
        const u32x4 rKA = lane < 32 ? *(const u32x4*)(ka + lane * 8) : z;
        const u32x4 rKB0 = *(const u32x4*)(kb + lane * 8), rKB1 = *(const u32x4*)(kb + 512 + lane * 8);
        const u32x4 rKD0 = *(const u32x4*)(kd + lane * 8), rKD1 = *(const u32x4*)(kd + 512 + lane * 8);
        const u32x4 rCQ0 = *(const u32x4*)(cc + lane * 8), rCQ1 = lane < 48 ? *(const u32x4*)(cc + 512 + lane * 8) : z, rCKV = *(const u32x4*)(cc + 896 + lane * 8);
        const u32x4 rPE = lane < 8 ? *(const u32x4*)(cc + 1408 + lane * 8) : z;
        const int p128 = (lane & 7) * 8, p64 = (lane & 3) * 8;
        const float* ct128 = c128 + (p128 < 32 ? grow : gcol) * 32 + (p128 & 31); const float* st128 = ct128 + 4096;
        const float* ct64 = c64 + (p64 < 16 ? grow : gcol) * 16 + (p64 & 15); const float* st64 = ct64 + 2048;
        const u32x4 oKA = norm_group<16>(rKA, gka, lat, ct128, st128, lane);
        const u32x4 oKB0 = norm_group<16>(rKB0, gkb, false, ct128, st128, lane), oKB1 = norm_group<16>(rKB1, gkb, false, ct128, st128, lane);
        const u32x4 oKD0 = norm_group<8>(rKD0, gkd, lat, ct64, st64, lane), oKD1 = norm_group<8>(rKD1, gkd, lat, ct64, st64, lane);
        const u32x4 oPE = norm_group<8>(rPE, gpe, lat, ct64, st64, lane);
        if (lane < 32) *(u32x4*)(ka + lane * 8) = oKA;
        *(u32x4*)(kb + lane * 8) = oKB0; *(u32x4*)(kb + 512 + lane * 8) = oKB1;
        *(u32x4*)(kd + lane * 8) = oKD0; *(u32x4*)(kd + 512 + lane * 8) = oKD1;
        if (lane < 8) *(u32x4*)(cc + 1408 + lane * 8) = oPE;
        {
            float x0[8], x1[8], xk[8]; unpack8(rCQ0, x0); unpack8(rCQ1, x1); unpack8(rCKV, xk);
            float s0 = 0.f, sk = 0.f;
#pragma unroll
            for (int q = 0; q < 8; ++q) { s0 += x0[q] * x0[q] + x1[q] * x1[q]; sk += xk[q] * xk[q]; }
            s0 = wave_sum(s0); sk = wave_sum(sk);
            const float r0 = __builtin_amdgcn_rsqf(s0 * (1.0f / 896.f) + EPS), rk = __builtin_amdgcn_rsqf(sk * (1.0f / 512.f) + EPS);
            const f32x4 ga = *(const f32x4*)gq0, gb = *(const f32x4*)(gq0 + 4), gc = *(const f32x4*)gq1, gd = *(const f32x4*)(gq1 + 4), ge = *(const f32x4*)gkv, gf = *(const f32x4*)(gkv + 4);
#pragma unroll
            for (int q = 0; q < 4; ++q) { x0[q] *= r0 * ga[q]; x0[4 + q] *= r0 * gb[q]; x1[q] *= r0 * gc[q]; x1[4 + q] *= r0 * gd[q]; xk[q] *= rk * ge[q]; xk[4 + q] *= rk * gf[q]; }
            *(u32x4*)(cc + lane * 8) = pack8(x0); if (lane < 48) *(u32x4*)(cc + 512 + lane * 8) = pack8(x1); *(u32x4*)(cc + 896 + lane * 8) = pack8(xk);
        }
    }
}

__device__ __forceinline__ void phase_post2(const Args& a, int l, const int wv0) {
    int tid_ = wv0 * 64 + lane_id(); asm volatile("" : "+v"(tid_)); const int tid = tid_, lane = tid & 63, wv = blockIdx.x * 8 + (tid >> 6);
    const float* gkn = a.in[I_KNNOPE] + l * 128 + (lane & 15) * 8;
    for (int row = wv; row < MTOT; row += GRID * 8) {
        const bf16_t* kv = (const bf16_t*)(a.ws + WS_KVUP) + (size_t)row * 2048 + (lane >> 4) * 256 + (lane & 15) * 8;
        bf16_t* kc = (bf16_t*)(a.ws + WS_KC) + (size_t)row * 1536;
        const u32x4 r0 = *(const u32x4*)kv, r1 = *(const u32x4*)(kv + 1024);
        const u32x4 pe = *(const u32x4*)((const bf16_t*)(a.ws + WS_CC) + (size_t)row * 1536 + 1408 + (lane & 7) * 8);
        const u32x4 o0 = norm_group<16>(r0, gkn, false, gkn, gkn, lane), o1 = norm_group<16>(r1, gkn, false, gkn, gkn, lane);
        *(u32x4*)(kc + (lane >> 4) * 192 + (lane & 15) * 8) = o0; *(u32x4*)(kc + (4 + (lane >> 4)) * 192 + (lane & 15) * 8) = o1;
        *(u32x4*)(kc + (lane >> 3) * 192 + 128 + (lane & 7) * 8) = pe;
    }
}

__device__ __forceinline__ void phase_attn(const Args& a, int l, LAS unsigned char* lds, bool ctx_out, const int wv0) {
    const int c = blockIdx.x, xcd = c & 7, rank = c >> 3;
    const float* bnd = (const float*)(a.ws + WS_BND) + l * 32;
    const float* rope = (const float*)(a.ws + WS_ROPE);
    const bf16_t* QA = (const bf16_t*)(a.ws + WS_QA); const bf16_t* KA = (const bf16_t*)(a.ws + WS_KA); const bf16_t* VA = (const bf16_t*)(a.ws + WS_VA);
    const bf16_t* QB = (const bf16_t*)(a.ws + WS_QB); const bf16_t* KB = (const bf16_t*)(a.ws + WS_KB); const bf16_t* VB = (const bf16_t*)(a.ws + WS_VB);
    const bf16_t* QD = (const bf16_t*)(a.ws + WS_QD); const bf16_t* KD = (const bf16_t*)(a.ws + WS_KD); const bf16_t* VD = (const bf16_t*)(a.ws + WS_VD);
    const bf16_t* QC = (const bf16_t*)(a.ws + WS_QUP); const bf16_t* KC = (const bf16_t*)(a.ws + WS_KC); const bf16_t* VC = (const bf16_t*)(a.ws + WS_KVUP);
    const bf16_t* G4 = (const bf16_t*)(a.ws + WS_G4); bf16_t* Y = (bf16_t*)(a.ws + WS_Y); float* OD = (float*)(a.ws + WS_OD);
    const float li_[4] = {0.2f, 0.35550906759096934f, 0.4707130183435842f, 0.5560582041556406f};
#ifndef ATTK
#define ATTK -1
#endif
    if (ATTK < 0 || ATTK == 0)
    for (int pass = 0; pass < 6; ++pass) {
        const int rnd = pass >> 1, i = pass & 1;
        att::AU u; int b, h; size_t row0;
        if (rnd < 2) { const int bh = xcd + 8 * rnd; b = bh >> 3; h = bh & 7; row0 = (size_t)b * SEQ + rank * 256; u.nlat = 128; u.nt = 132; u.qrope = 1; u.tpos0 = rank * 256; }
        else { if (!ctx_out || c < 48 || c >= 64) break; const int bh = c - 48; b = bh >> 3; h = bh & 7; row0 = (size_t)MLAT + b * CTXL; u.nlat = 0; u.nt = 4; u.qrope = 0; u.tpos0 = 0; }
        const int col = h * 128 + i * 64;
        u.Q = QD + row0 * 1024 + col; u.ldq = 1024;
        u.Kl = KD + (size_t)b * SEQ * 1024 + col; u.Vl = VD + (size_t)b * SEQ * 1024 + h * 128;
        u.Kc = KD + ((size_t)MLAT + b * CTXL) * 1024 + col; u.Vc = VD + ((size_t)MLAT + b * CTXL) * 1024 + h * 128;
        u.ldk = 1024; u.ldv = 1024; u.C = 0.125f * LOG2E; u.MC = bnd[17]; u.sinkL = -1e30f; u.m0 = 0; u.m1 = 0; u.rpb = nullptr;
        u.gq = a.in[I_QND] + l * 64; u.gq2 = nullptr; u.rope = rope;
        u.o0 = OD + row0 * 2048 + h * 256; u.subw = a.in[I_SUBLN] + l * 128; u.lam = bnd[18]; u.om = 1.0f - li_[l];
        if (i == 0) { u.out_mode = 1; u.out = OD + row0 * 2048 + h * 256; u.gate = nullptr; u.ldo = 2048; }
        else { u.out_mode = 2; u.out = Y + row0 * 4096 + 3072 + h * 128; u.gate = G4 + row0 * 4096 + 3072 + h * 128; u.ldo = 4096; }
        att::attn_unit<64, 0>(u, lds, wv0);
    }
    if (ATTK < 0 || ATTK == 1)
    for (int rnd = 0; rnd < 3; ++rnd) {
        att::AU u; int b, h; size_t row0;
        if (rnd < 2) { const int bh = xcd + 8 * rnd; b = bh >> 3; h = bh & 7; row0 = (size_t)b * SEQ + rank * 256; u.nlat = 128; u.nt = 132; u.qrope = 1; u.tpos0 = rank * 256; }
        else { if (!ctx_out || c < 32 || c >= 48) break; const int bh = c - 32; b = bh >> 3; h = bh & 7; row0 = (size_t)MLAT + b * CTXL; u.nlat = 0; u.nt = 4; u.qrope = 0; u.tpos0 = 0; }
        u.Q = QC + row0 * 1536 + h * 192; u.ldq = 1536;
        u.Kl = KC + (size_t)b * SEQ * 1536 + h * 192; u.Vl = VC + (size_t)b * SEQ * 2048 + h * 256 + 128;
        u.Kc = KC + ((size_t)MLAT + b * CTXL) * 1536 + h * 192; u.Vc = VC + ((size_t)MLAT + b * CTXL) * 2048 + h * 256 + 128;
        u.ldk = 1536; u.ldv = 2048; u.C = 0.07216878364870323f * LOG2E; u.MC = bnd[16]; u.sinkL = -1e30f; u.m0 = 0; u.m1 = 0; u.rpb = nullptr;
        u.gq = a.in[I_QNNOPE] + l * 128; u.gq2 = a.in[I_QNPE] + l * 64; u.rope = rope;
        u.o0 = nullptr; u.subw = nullptr; u.lam = 0.f; u.om = 0.f;
        u.out_mode = 0; u.out = Y + row0 * 4096 + 2048 + h * 128; u.gate = G4 + row0 * 4096 + 2048 + h * 128; u.ldo = 4096;
        att::attn_unit<192, 0>(u, lds, wv0);
    }
    if (ATTK < 0 || ATTK >= 2) {
        unsigned* qc = (unsigned*)(a.ws + WS_CTL) + 8192 + l * 128;
        volatile LAS unsigned* misc = (volatile LAS unsigned*)(lds + LDS_MISC);
        const unsigned qlen = ctx_out ? 132u : 128u;
        for (;;) {
            if (wv0 == 0 && lane_id() == 0) {
                unsigned pk = 0xFFFFFFFFu;
                for (int k = 0; k < 8; ++k) { const int x = (xcd + k) & 7; const unsigned v = xb_add(qc + x * 16, 1u); if (v < qlen) { pk = (unsigned)x * 256u + v; break; } }
                misc[8] = pk;
            }
            __syncthreads();
            const unsigned pk = (unsigned)__builtin_amdgcn_readfirstlane((int)misc[8]);
            if (pk == 0xFFFFFFFFu) break;
            const int h = (int)(pk >> 8), id = (int)(pk & 255u);
            att::AU u; size_t row0;
            if (id < 64 || id == 128 || id == 129) {
                int b, kstart = 0, q0 = 0;
                if (id < 64) { b = id >> 5; q0 = (id & 31) * 256; row0 = (size_t)b * SEQ + q0;
                    kstart = q0 - 128 < 0 ? 0 : q0 - 128; const int kend = q0 + 384 > SEQ ? SEQ : q0 + 384; u.nlat = (kend - kstart) >> 6; u.nt = u.nlat + 4; u.qrope = 1; u.tpos0 = q0; }
                else { b = id & 1; row0 = (size_t)MLAT + b * CTXL; u.nlat = 0; u.nt = 4; u.qrope = 0; u.tpos0 = 0; }
                const int kvh = h >> 2;
                u.Q = QA + row0 * 1024 + h * 128; u.ldq = 1024;
                u.Kl = KA + ((size_t)b * SEQ + kstart) * 256 + kvh * 128; u.Vl = VA + ((size_t)b * SEQ + kstart) * 256 + kvh * 128;
                u.Kc = KA + ((size_t)MLAT + b * CTXL) * 256 + kvh * 128; u.Vc = VA + ((size_t)MLAT + b * CTXL) * 256 + kvh * 128;
                u.ldk = 256; u.ldv = 256; u.C = 0.08838834764831845f * LOG2E; u.MC = bnd[h]; u.sinkL = bnd[19 + h]; u.m0 = kstart - q0; u.m1 = 0; u.rpb = nullptr;
                u.gq = a.in[I_QNA] + l * 128; u.gq2 = nullptr; u.rope = rope;
                u.o0 = nullptr; u.subw = nullptr; u.lam = 0.f; u.om = 0.f;
                u.out_mode = 0; u.out = Y + row0 * 4096 + h * 128; u.gate = G4 + row0 * 4096 + h * 128; u.ldo = 4096;
                att::attn_unit<128, 1>(u, lds, wv0);
            } else {
                int b, krow0 = 0, rg = 0;
                if (id < 128) { b = (id - 64) >> 5; rg = id & 31; row0 = (size_t)b * SEQ + rg * 256;
                    krow0 = 4 * rg - 4 < 0 ? 0 : 4 * rg - 4; u.nlat = (rg == 0 || rg == 31) ? 8 : 12; u.nt = u.nlat + 4; }
                else { b = id & 1; row0 = (size_t)MLAT + b * CTXL; u.nlat = 0; u.nt = 4; }
                u.Q = QB + row0 * 1024 + h * 128; u.ldq = 1024;
                u.Kl = KB + ((size_t)b * SEQ + krow0 * 64) * 1024 + h * 128; u.Vl = VB + ((size_t)b * SEQ + krow0 * 64) * 1024 + h * 128;
                u.Kc = KB + ((size_t)MLAT + b * CTXL) * 1024 + h * 128; u.Vc = VB + ((size_t)MLAT + b * CTXL) * 1024 + h * 128;
                u.ldk = 1024; u.ldv = 1024; u.C = 0.08838834764831845f * LOG2E; u.MC = bnd[8 + h]; u.sinkL = -1e30f; u.m0 = 4 * rg; u.m1 = krow0;
                u.rpb = a.in[I_RPB] + ((size_t)l * 8 + h) * 465;
                u.gq = a.in[I_QNB] + l * 128; u.gq2 = nullptr; u.rope = rope; u.qrope = 0; u.tpos0 = 0;
                u.o0 = nullptr; u.subw = nullptr; u.lam = 0.f; u.om = 0.f;
                u.out_mode = 0; u.out = Y + row0 * 4096 + 1024 + h * 128; u.gate = G4 + row0 * 4096 + 1024 + h * 128; u.ldo = 4096;
                att::attn_unit<128, 2>(u, lds, wv0);
            }
        }
    }
}

__device__ __forceinline__ Args load_args(const Args& a) {
#if defined(__HIP_DEVICE_COMPILE__)
    typedef const Args __attribute__((address_space(4)))* KArgsP;
    KArgsP p = (KArgsP)__builtin_amdgcn_kernarg_segment_ptr();
    asm volatile("" : "+s"(p));
    Args b;
#pragma unroll
    for (int i = 0; i < 31; ++i) b.in[i] = p->in[i];
    b.out = p->out; b.ws = p->ws; b.ph_lo = p->ph_lo; b.ph_hi = p->ph_hi;
    return b;
#else
    return a;
#endif
}

constexpr int N_PHASES = 2 + 9 * DEPTH;
__global__ void __launch_bounds__(NTHR, 2) mega_fwd(Args a) {
    extern __shared__ __attribute__((aligned(16))) unsigned char lds_raw[];
    LAS unsigned char* lds = (LAS unsigned char*)lds_raw;
    volatile LAS unsigned* misc = (volatile LAS unsigned*)(lds + LDS_MISC);
    const int wv0 = __builtin_amdgcn_readfirstlane((int)threadIdx.x >> 6);
    if (threadIdx.x < 4) misc[threadIdx.x] = 0u;
    __syncthreads();
    const int lo = a.ph_lo, hi = a.ph_hi;
    XcdBarrier bar; bar.bar = (unsigned*)(a.ws + WS_CTL); bar.x = 0; bar.st = misc;
    if (hi - lo > 1) bar = xcd_barrier_post((unsigned*)(a.ws + WS_CTL), misc, wv0);
#ifndef TESTKIND
#define TESTKIND -1
#endif
#define KIND_OK(kind) (TESTKIND < 0 || TESTKIND == (kind))
#define IN(k) (lo <= (k) && (k) < hi)
#define SEAM(k) do { if (IN((k) + 1)) xcd_barrier(bar, wv0); } while (0)
#ifndef PROBE_K1
#define PROBE_K1 -1
#endif
#ifndef PROBE_K2
#define PROBE_K2 -1
#endif
    unsigned long long pt0 = 0, pacc1 = 0;
#ifndef PROBE_MASK
#define PROBE_MASK 0
#endif
#define PT_BEGIN(kind) do { if ((PROBE_MASK >> (kind)) & 1) pt0 = __builtin_amdgcn_s_memrealtime(); } while (0)
#define PT_END(kind) do { if ((PROBE_MASK >> (kind)) & 1) pacc1 += __builtin_amdgcn_s_memrealtime() - pt0; } while (0)
#define PA() load_args(a)
    if (KIND_OK(0) && IN(0)) { PT_BEGIN(0); phase_pre0(PA(), lds, wv0); SEAM(0); PT_END(0); }
    if (KIND_OK(1) && IN(1)) { PT_BEGIN(1); phase_prologue(PA(), lds, wv0); phase_mods(PA(), wv0); SEAM(1); PT_END(1); }
    for (int l = 0; l < DEPTH; ++l) {
        const Args al = PA(); float* XB = (float*)(al.ws + WS_XBUF);
        const int pb = 2 + 9 * l;
        const bool ctx_out = l < DEPTH - 1;
        const float* xin = l == 0 ? al.in[I_X] : XB;
        const float* cin = l <= 1 ? al.in[I_CTX] : XB + (size_t)MLAT * 4096;
        float* xout = l == DEPTH - 1 ? al.out : XB; float* cout = XB + (size_t)MLAT * 4096;
        if (KIND_OK(2) && IN(pb + 0)) { PT_BEGIN(2); phase_xnorm(PA(), l, xin, cin, cout, wv0); SEAM(pb + 0); PT_END(2); }
        if (KIND_OK(3) && IN(pb + 1)) { PT_BEGIN(3); const Args b = PA();
            { pg8::Gemm g{b.ws + WS_H, (const bf16_t*)(b.ws + WS_WIN) + (size_t)l * NT_BF * 256 * 4096, MTOT, NT_BF * 256, 4096, 8192, 8192};
              pg8::StaticOrder S; S.init(MTOT, NT_BF * 256, (int)gridDim.x, (int)blockIdx.x);
              EpiG1 E{b.ws, 0, nullptr, nullptr}; pg8::NoHook nh;
              pg8::gemm_phase<false>(lds, g, S, E, nh, wv0); }
            { pg8::Gemm g{b.ws + WS_H8, b.ws + WS_W8 + (size_t)l * NT_F8 * 256 * 4096, MTOT, NT_F8 * 256, 4096, 4096, 4096};
              pg8::DynTailOrder S; S.S.init(MTOT, NT_F8 * 256, (int)gridDim.x, (int)blockIdx.x); S.R = 26; S.ctr = (unsigned*)(b.ws + WS_CTL) + 8192 + 512 + l * 128;
              EpiG1 E{b.ws, 1, (const float*)(b.ws + WS_HS), (const float*)(b.ws + WS_WSC) + (size_t)l * NINP}; pg8::NoHook nh;
              pg8::gemm_phase<true>(lds, g, S, E, nh, wv0); }
            SEAM(pb + 1); PT_END(3); }
        if (KIND_OK(4) && IN(pb + 2)) { PT_BEGIN(4); phase_post1(PA(), l, wv0); SEAM(pb + 2); PT_END(4); }
        if (KIND_OK(5) && IN(pb + 3)) { PT_BEGIN(5); const Args b = PA();
            { pg8::Gemm g{(const bf16_t*)(b.ws + WS_CC), (const bf16_t*)(b.ws + WS_WQ) + (size_t)l * 1536 * 896, MTOT, 1536, 896, 1536 * 2, 896 * 2};
              pg8::StaticOrder S; S.init(MTOT, 1536, (int)gridDim.x, (int)blockIdx.x);
              EpiPlain E{(bf16_t*)(b.ws + WS_QUP), 1536}; pg8::NoHook nh;
              pg8::gemm_phase<false>(lds, g, S, E, nh, wv0); }
            { pg8::Gemm g{(const bf16_t*)(b.ws + WS_CC) + 896, (const bf16_t*)(b.ws + WS_WKV) + (size_t)l * 2048 * 512, MTOT, 2048, 512, 1536 * 2, 512 * 2};
              pg8::StaticOrder S; S.init(MTOT, 2048, (int)gridDim.x, (int)((blockIdx.x + 112u) & 255u));
              EpiPlain E{(bf16_t*)(b.ws + WS_KVUP), 2048}; pg8::NoHook nh;
              pg8::gemm_phase<false>(lds, g, S, E, nh, wv0); }
            SEAM(pb + 3); PT_END(5); }
        if (KIND_OK(6) && IN(pb + 4)) { PT_BEGIN(6); phase_post2(PA(), l, wv0); SEAM(pb + 4); PT_END(6); }
        if (KIND_OK(7) && IN(pb + 5)) { PT_BEGIN(7); phase_attn(PA(), l, lds, ctx_out, wv0); SEAM(pb + 5); PT_END(7); }
        if (KIND_OK(9) && IN(pb + 6)) { PT_BEGIN(9); const Args b = PA();
            { pg8::Gemm g{(const bf16_t*)(b.ws + WS_Y), (const bf16_t*)(b.ws + WS_WB) + (size_t)l * 4096 * 4096, MLAT, 4096, 4096, 8192, 8192};
              pg8::StaticOrder S; S.init(MLAT, 4096, (int)gridDim.x, (int)blockIdx.x);
              EpiMerge E{(const bf16_t*)(b.ws + WS_MG), (bf16_t*)(b.ws + WS_MERGED)}; HookMerge hk{(const bf16_t*)(b.ws + WS_MG)};
              pg8::gemm_phase<false>(lds, g, S, E, hk, wv0); }
            if (ctx_out) { pg8::Gemm g{(const bf16_t*)(b.ws + WS_Y), (const bf16_t*)(b.ws + WS_WB) + (size_t)l * 4096 * 4096, MTOT, 4096, 512, 8192, 8192};
              pg8::CtxSplitOrder S{(int)blockIdx.x};
              EpiCtxPart3 E{(const bf16_t*)(b.ws + WS_MG), (float*)(b.ws + WS_P3)}; pg8::NoHook nh;
              pg8::gemm_phase<false>(lds, g, S, E, nh, wv0); }
            SEAM(pb + 6); PT_END(9); }
        if (KIND_OK(10) && IN(pb + 7)) { PT_BEGIN(10); const Args b = PA();
            if (ctx_out) {
                const int tid = wv0 * 64 + lane_id(); const int r = blockIdx.x * 2 + (tid >> 8), c0 = (tid & 255) * 16;
                const float* P3 = (const float*)(b.ws + WS_P3) + (size_t)r * 4096 + c0;
                f32x4 sacc[4];
#pragma unroll
                for (int q = 0; q < 4; ++q) sacc[q] = *(const f32x4*)(P3 + q * 4);
                for (int kc = 1; kc < 8; ++kc)
#pragma unroll
                    for (int q = 0; q < 4; ++q) sacc[q] += *(const f32x4*)(P3 + (size_t)kc * MCTX * 4096 + q * 4);
                u32x4 w0, w1; w0.x = cvt_pk_bf16(sacc[0][0], sacc[0][1]); w0.y = cvt_pk_bf16(sacc[0][2], sacc[0][3]); w0.z = cvt_pk_bf16(sacc[1][0], sacc[1][1]); w0.w = cvt_pk_bf16(sacc[1][2], sacc[1][3]);
                w1.x = cvt_pk_bf16(sacc[2][0], sacc[2][1]); w1.y = cvt_pk_bf16(sacc[2][2], sacc[2][3]); w1.z = cvt_pk_bf16(sacc[3][0], sacc[3][1]); w1.w = cvt_pk_bf16(sacc[3][2], sacc[3][3]);
                bf16_t* mo = (bf16_t*)(b.ws + WS_MERGED) + (size_t)(MLAT + r) * 4096 + c0; *(u32x4*)mo = w0; *(u32x4*)(mo + 8) = w1;
            }
            pg8::Gemm g{(const bf16_t*)(b.ws + WS_MERGED), (const bf16_t*)(b.ws + WS_WO) + (size_t)l * 4096 * 4096, MLAT, 4096, 4096, 8192, 8192};
            pg8::StaticOrder S; S.init(MLAT, 4096, (int)gridDim.x, (int)blockIdx.x);
            EpiResid E{xin, cin, xout, cout, (const float*)(b.ws + WS_MODS) + l * 36864}; pg8::NoHook nh;
            pg8::gemm_phase<false>(lds, g, S, E, nh, wv0);
            if (ctx_out || l + 1 < DEPTH) SEAM(pb + 7); PT_END(10); }
        if (KIND_OK(8) && ctx_out && IN(pb + 8)) { PT_BEGIN(8); const Args b = PA();
            pg8::Gemm g{(const bf16_t*)(b.ws + WS_MERGED), (const bf16_t*)(b.ws + WS_WO) + (size_t)l * 4096 * 4096, MTOT, 4096, 512, 8192, 8192};
            pg8::CtxSplitOrder S{(int)blockIdx.x};
            EpiCtxPart4 E{(float*)(b.ws + WS_P4)}; pg8::NoHook nh;
            pg8::gemm_phase<false>(lds, g, S, E, nh, wv0); SEAM(pb + 8); PT_END(8); }
    }
    if (PROBE_MASK != 0 && blockIdx.x == 0) {
        const unsigned long long t0 = __builtin_amdgcn_s_memrealtime();
        while (__builtin_amdgcn_s_memrealtime() - t0 < pacc1) __builtin_amdgcn_s_sleep(8);
    }
#undef IN
#undef SEAM
#undef PA
}

extern "C" void kernel_launch(void* const* d_in, const int* in_sizes, int n_in, void* d_out, int out_size, void* d_ws, size_t ws_size, hipStream_t stream) {
    static int ready = 0;
    if (ready == 0) {
        if (n_in != 31 || in_sizes[0] != MLAT * DM || out_size != MLAT * DM || ws_size < WS_END) {
            fprintf(stderr, "kernel_launch: shape mismatch: n_in %d in0 %d out %d ws %zu (need >= %zu)\n", n_in, n_in > 0 ? in_sizes[0] : -1, out_size, ws_size, (size_t)WS_END); ready = -1; return; }
        if (hipFuncSetAttribute((const void*)mega_fwd, hipFuncAttributeMaxDynamicSharedMemorySize, LDS_BYTES) != hipSuccess) { fprintf(stderr, "kernel_launch: hipFuncSetAttribute failed\n"); ready = -1; return; }
        int per_cu = 0, dev = 0, cus = 0;
        (void)hipGetDevice(&dev); (void)hipDeviceGetAttribute(&cus, hipDeviceAttributeMultiprocessorCount, dev);
        if (hipOccupancyMaxActiveBlocksPerMultiprocessor(&per_cu, (const void*)mega_fwd, NTHR, LDS_BYTES) != hipSuccess || per_cu < 1 || cus < GRID)
            fprintf(stderr, "kernel_launch: note: occupancy query %d blocks/CU, %d CUs (grid %d needs one resident block per CU)\n", per_cu, cus, GRID);
        (void)hipGetLastError();
        ready = 1;
    }
    if (ready < 0) return;
    (void)hipMemsetAsync((char*)d_ws + WS_CTL, 0, CTL_ZERO_BYTES, stream);
    Args a{};
    for (int i = 0; i < 31; ++i) a.in[i] = (const float*)d_in[i];
    a.out = (float*)d_out; a.ws = (unsigned char*)d_ws;
#if MK_LAUNCH_PER_PHASE
    for (int p = 0; p < N_PHASES; ++p) { a.ph_lo = p; a.ph_hi = p + 1; hipLaunchKernelGGL(mega_fwd, dim3(GRID), dim3(NTHR), LDS_BYTES, stream, a); }
#else
    a.ph_lo = 0; a.ph_hi = N_PHASES;
    hipLaunchKernelGGL(mega_fwd, dim3(GRID), dim3(NTHR), LDS_BYTES, stream, a);
#endif
    const hipError_t le = hipPeekAtLastError();
    if (le != hipSuccess) fprintf(stderr, "kernel_launch: launch failed: %s\n", hipGetErrorName(le));
}
```

```cpp
#include <hip/hip_runtime.h>
#include <cstdio>
#include <cstdint>

#define LAS __attribute__((address_space(3)))
typedef unsigned short bf16_t;
typedef short bf16x8 __attribute__((ext_vector_type(8)));
typedef short s16x4 __attribute__((ext_vector_type(4)));
typedef float f32x2 __attribute__((ext_vector_type(2)));
typedef float f32x4 __attribute__((ext_vector_type(4)));
typedef float f32x16 __attribute__((ext_vector_type(16)));
typedef unsigned u32x2 __attribute__((ext_vector_type(2)));
typedef unsigned u32x4 __attribute__((ext_vector_type(4)));
typedef int i32x4_t __attribute__((ext_vector_type(4)));
typedef int i32x8_t __attribute__((ext_vector_type(8)));

#ifndef MK_LAUNCH_PER_PHASE
#define MK_LAUNCH_PER_PHASE 0
#endif

constexpr int DM = 4096, NBATCH = 2, SEQ = 8192, DEPTH = 4, CTXL = 256, GRIDW = 64;
constexpr int MLAT = NBATCH * SEQ, MCTX = NBATCH * CTXL, MTOT = MLAT + MCTX;
constexpr int NIN = 29632, NINP = 29696;
constexpr float LOG2E = 1.4426950408889634f;
constexpr float EPS = 1e-6f;

constexpr size_t al256(size_t x) { return (x + 255) / 256 * 256; }
constexpr size_t WS_CTL = 0;
constexpr size_t WS_MODS = 65536 + 2 * (((size_t)4 * 29632 * 4 + 255) / 256 * 256);
constexpr size_t WS_MODP = WS_MODS + al256((size_t)4 * 3 * 12288 * 4);
constexpr size_t WS_ROPE = WS_MODP + al256((size_t)4 * 32 * 3 * 12288 * 4);
constexpr size_t WS_BND = WS_ROPE + al256((size_t)(4096 * 2 + 2048 * 2) * 4);
constexpr size_t WS_WIN = WS_BND + 4096;
constexpr int NT_BF = 4, NT_F8 = 112;
constexpr size_t WS_WQ = WS_WIN + (size_t)4 * NT_BF * 256 * 4096 * 2;
constexpr size_t WS_WKV = WS_WQ + (size_t)4 * 1536 * 896 * 2;
constexpr size_t WS_WB = WS_WKV + (size_t)4 * 2048 * 512 * 2;
constexpr size_t WS_WO = WS_WB + (size_t)4 * 4096 * 4096 * 2;
constexpr size_t WS_H = WS_WO + (size_t)4 * 4096 * 4096 * 2;
constexpr size_t WS_QA = WS_H + (size_t)MTOT * 4096 * 2;
constexpr size_t WS_KA = WS_QA + (size_t)MTOT * 1024 * 2;
constexpr size_t WS_VA = WS_KA + (size_t)MTOT * 256 * 2;
constexpr size_t WS_QB = WS_VA + (size_t)MTOT * 256 * 2;
constexpr size_t WS_KB = WS_QB + (size_t)MTOT * 1024 * 2;
constexpr size_t WS_VB = WS_KB + (size_t)MTOT * 1024 * 2;
constexpr size_t WS_CC = WS_VB + (size_t)MTOT * 1024 * 2;
constexpr size_t WS_QD = WS_CC + (size_t)MTOT * 1536 * 2;
constexpr size_t WS_KD = WS_QD + (size_t)MTOT * 1024 * 2;
constexpr size_t WS_VD = WS_KD + (size_t)MTOT * 1024 * 2;
constexpr size_t WS_G4 = WS_VD + (size_t)MTOT * 1024 * 2;
constexpr size_t WS_MG = WS_G4 + (size_t)MTOT * 4096 * 2;
constexpr size_t WS_QUP = WS_MG + (size_t)MTOT * 16384 * 2;
constexpr size_t WS_KVUP = WS_QUP + (size_t)MTOT * 1536 * 2;
constexpr size_t WS_KC = WS_KVUP + (size_t)MTOT * 2048 * 2;
constexpr size_t WS_OD = WS_KC + (size_t)MTOT * 1536 * 2;
constexpr size_t WS_Y = WS_OD + (size_t)MTOT * 2048 * 4;
constexpr size_t WS_MERGED = WS_Y + (size_t)MTOT * 4096 * 2;
constexpr size_t WS_XBUF = WS_MERGED + (size_t)MTOT * 4096 * 2;
constexpr size_t WS_P3 = WS_XBUF + (size_t)MTOT * 4096 * 4;
constexpr size_t WS_P4 = WS_P3 + (size_t)8 * MCTX * 4096 * 4;
constexpr size_t WS_H8 = WS_P4 + (size_t)8 * MCTX * 4096 * 4;
constexpr size_t WS_W8 = WS_H8 + (size_t)MTOT * 4096;
constexpr size_t WS_HS = WS_W8 + (size_t)4 * NT_F8 * 256 * 4096;
constexpr size_t WS_WSC = WS_HS + al256((size_t)MTOT * 4);
constexpr size_t WS_END = WS_WSC + al256((size_t)4 * NINP * 4);
constexpr size_t WS_CMAX = 65536;
constexpr size_t WS_CSQ = WS_CMAX + al256((size_t)4 * NIN * 4);
constexpr int CS_ROWS = 256;
constexpr size_t CTL_ZERO_BYTES = 65536;

__device__ __forceinline__ unsigned cvt_pk_bf16(float lo, float hi) { unsigned r; asm volatile("v_cvt_pk_bf16_f32 %0, %1, %2" : "=v"(r) : "v"(lo), "v"(hi)); return r; }
__device__ __forceinline__ float bf2f(unsigned short b) { return __uint_as_float(((unsigned)b) << 16); }
__device__ __forceinline__ float bflo(unsigned w) { return __uint_as_float(w << 16); }
__device__ __forceinline__ float bfhi(unsigned w) { return __uint_as_float(w & 0xffff0000u); }
__device__ __forceinline__ bf16_t f2bf(float f) { return (bf16_t)(cvt_pk_bf16(f, f) & 0xffffu); }
__device__ __forceinline__ float fast_exp2(float x) { return __builtin_amdgcn_exp2f(x); }
__device__ __forceinline__ float fast_rcp(float x) { return __builtin_amdgcn_rcpf(x); }
__device__ __forceinline__ float silu_f(float v) { return v * fast_rcp(1.0f + fast_exp2(-v * LOG2E)); }
__device__ __forceinline__ float sigm_f(float v) { const float c = fminf(fmaxf(v, -30.f), 30.f); return fast_rcp(1.0f + fast_exp2(-c * LOG2E)); }
__device__ __forceinline__ int lane_id() { int v; asm volatile("v_mbcnt_lo_u32_b32 %0, -1, 0\n\tv_mbcnt_hi_u32_b32 %0, -1, %0" : "=v"(v)); return v; }
template <int M> __device__ __forceinline__ float swz_xor(float v) {
    return __int_as_float(__builtin_amdgcn_ds_swizzle(__float_as_int(v), (M << 10) | 0x1f));
}
__device__ __forceinline__ float half_swap_sum(float v) {
    auto rr = __builtin_amdgcn_permlane32_swap(__float_as_uint(v), __float_as_uint(v), false, false); return __uint_as_float(rr[0]) + __uint_as_float(rr[1]);
}
__device__ __forceinline__ float half_swap_max(float v) {
    auto rr = __builtin_amdgcn_permlane32_swap(__float_as_uint(v), __float_as_uint(v), false, false); return fmaxf(__uint_as_float(rr[0]), __uint_as_float(rr[1]));
}
__device__ __forceinline__ float half_sum(float v) {
    v += swz_xor<16>(v); v += swz_xor<8>(v); v += swz_xor<4>(v); v += swz_xor<2>(v); v += swz_xor<1>(v); return v;
}
__device__ __forceinline__ float wave_sum(float v) { return half_sum(half_swap_sum(v)); }
__device__ __forceinline__ float wave_max(float v) {
    v = half_swap_max(v); v = fmaxf(v, swz_xor<16>(v)); v = fmaxf(v, swz_xor<8>(v)); v = fmaxf(v, swz_xor<4>(v)); v = fmaxf(v, swz_xor<2>(v)); v = fmaxf(v, swz_xor<1>(v)); return v;
}

__device__ __forceinline__ void gld16(u32x4& d, const void* p) { asm volatile("global_load_dwordx4 %0, %1, off" : "=&v"(d) : "v"(p) : "memory"); }
__device__ __forceinline__ void gld16f(f32x4& d, const void* p) { asm volatile("global_load_dwordx4 %0, %1, off" : "=&v"(d) : "v"(p) : "memory"); }
#define GLD_WAIT() do { asm volatile("s_waitcnt vmcnt(0)" ::: "memory"); __builtin_amdgcn_sched_barrier(0); } while (0)

#define XB_TMO      128
#define XB_XCNT(j)  (256  + 64 * (j))
#define XB_XSUB(j)  (1280 + 64 * (j))
#define XB_XGEN(j)  (2304 + 64 * (j))
#define XB_TOP      3328
#define XB_TOPGEN   3392
#define XCD_BAR_WORDS 3456
#define XB_SPIN_CAP (1u << 22)

__device__ __forceinline__ unsigned xb_ld(unsigned* p)              { asm volatile("" : "+v"(p)); return __hip_atomic_load(p, __ATOMIC_RELAXED, __HIP_MEMORY_SCOPE_AGENT); }
__device__ __forceinline__ unsigned xb_add(unsigned* p, unsigned v) { asm volatile("" : "+v"(p), "+v"(v)); return __hip_atomic_fetch_add(p, v, __ATOMIC_RELAXED, __HIP_MEMORY_SCOPE_AGENT); }
__device__ __forceinline__ unsigned xb_xcc_id() { return (unsigned)__builtin_amdgcn_s_getreg((3 << 11) | 20) & 0xFu; }
#define XB_SPIN(cond, bar) do { unsigned _sp = 0; while (cond) { __builtin_amdgcn_s_sleep(1); \
    if ((++_sp & 255u) == 0u) { if (xb_ld(&(bar)[XB_TMO])) break; if (_sp > XB_SPIN_CAP) { (void)xb_add(&(bar)[XB_TMO], 1u); break; } } } } while (0)

struct XcdBarrier { unsigned* bar; unsigned x; volatile LAS unsigned* st; };

__device__ __forceinline__ XcdBarrier xcd_barrier_post(unsigned* bar, volatile LAS unsigned* st, const int wv0) {
    XcdBarrier b; b.bar = bar; b.x = xb_xcc_id(); b.st = st;
    if (wv0 == 0 && lane_id() == 0) (void)xb_add(&bar[XB_XCNT(b.x)], 1u);
    return b;
}
__device__ __forceinline__ void xcd_barrier_complete(unsigned* bar, unsigned x, unsigned& nloc, unsigned& nx) {
    const unsigned G = gridDim.x * gridDim.y * gridDim.z;
    unsigned sum, cnt, mine, sp = 0u;
    for (;;) {
        sum = 0u; cnt = 0u; mine = 0u;
#pragma unroll
        for (unsigned j = 0; j < 16; ++j) { const unsigned c = xb_ld(&bar[XB_XCNT(j)]); sum += c; cnt += (c > 0u) ? 1u : 0u; mine = (j == x) ? c : mine; }
        if (sum == G) break;
        __builtin_amdgcn_s_sleep(1);
        if ((++sp & 255u) == 0u) { if (xb_ld(&bar[XB_TMO])) break; if (sp > XB_SPIN_CAP) { (void)xb_add(&bar[XB_TMO], 1u); break; } }
    }
    nloc = mine > 0u ? mine : 1u; nx = cnt > 0u ? cnt : 1u;
}
__device__ __forceinline__ void xcd_barrier(const XcdBarrier& b, const int wv0) {
    asm volatile("s_waitcnt vmcnt(0)" ::: "memory");
    __syncthreads();
    if (wv0 == 0 && lane_id() == 0) {
        unsigned* bar = b.bar;
        __builtin_amdgcn_s_waitcnt(0);
        unsigned nloc = b.st[0], nx = b.st[1];
        if (nloc == 0u) { xcd_barrier_complete(bar, b.x, nloc, nx); b.st[0] = nloc; b.st[1] = nx; }
        const unsigned old = xb_add(&bar[XB_XSUB(b.x)], 1u);
        const unsigned gen = old / nloc;
        if (old + 1u == (gen + 1u) * nloc) {
            __builtin_amdgcn_fence(__ATOMIC_RELEASE, "agent");
            asm volatile("s_waitcnt vmcnt(0)" ::: "memory");
            const unsigned og = xb_add(&bar[XB_TOP], 1u);
            const unsigned tg = og / nx;
            if (og + 1u == (tg + 1u) * nx) xb_add(&bar[XB_TOPGEN], 1u);
            else XB_SPIN(xb_ld(&bar[XB_TOPGEN]) == tg, bar);
            __builtin_amdgcn_fence(__ATOMIC_ACQUIRE, "agent");
            xb_add(&bar[XB_XGEN(b.x)], 1u);
            asm volatile("s_waitcnt vmcnt(0)" ::: "memory");
        } else {
            XB_SPIN(xb_ld(&bar[XB_XGEN(b.x)]) == gen, bar);
            __builtin_amdgcn_fence(__ATOMIC_ACQUIRE, "agent");
            asm volatile("s_waitcnt vmcnt(0)" ::: "memory");
        }
    }
    __syncthreads();
}

namespace pg8 {
constexpr int BM = 256, BK = 64, HALF = 128, HTB = HALF * BK * 2, STAGE_BYTES = 8 * HTB, NXCD = 8, WGM = 8;
__host__ __device__ __forceinline__ int lds_byte(int r, int c) { const int st = (r >> 4) * 2 + (c >> 5), rr = r & 15, cc = c & 31, ob = rr * 64 + cc * 2; return st * 1024 + (ob ^ (((ob >> 9) & 1) << 5)); }
__host__ __device__ __forceinline__ void stage_rc(int b, int& R, int& C) { const int st = b / 1024, sb = b % 1024, swz = sb ^ (((sb >> 9) & 1) << 5); R = (st >> 1) * 16 + swz / 64; C = (st & 1) * 32 + (swz % 64) / 2; }
__host__ __device__ __forceinline__ int perm32(int rho) { const int n = rho >> 4, i = rho & 15; return 8 * (i >> 2) + 4 * n + (i & 3); }

struct Unit { int pm, pn, kb; };
struct Gemm { const void* A; const void* Bt; int M, N, K, ldaB, ldbB; };

struct StaticOrder {
    static constexpr bool DYN = false;
    int nM, nN, nwg, G, c;
    __device__ void init(int M, int N, int G_, int c_) { nM = M / BM; nN = N / BM; nwg = nM * nN; G = G_; c = c_; }
    __device__ void map(int L, Unit& u) const {
        int wgid = L; { const int q = nwg / NXCD, r = nwg % NXCD, xcd = wgid % NXCD, off = wgid / NXCD; wgid = (xcd < r ? xcd * (q + 1) : r * (q + 1) + (xcd - r) * q) + off; }
        const int nig = WGM * nN, gid = wgid / nig, fm = gid * WGM, gsz = (nM - fm) < WGM ? (nM - fm) : WGM;
        u.pm = fm + ((wgid % nig) % gsz); u.pn = (wgid % nig) / gsz; u.kb = 0;
    }
    __device__ bool next(int i, Unit& u) const { const long L = (long)i * G + c; if (L >= nwg) return false; map((int)L, u); return true; }
};
struct DynTailOrder {
    static constexpr bool DYN = true;
    StaticOrder S; int R; unsigned* ctr;
    __device__ bool next(int i, Unit& u) const { return S.next(i, u); }
    __device__ int claim() const {
        const int x0 = S.c & 7, base = R * S.G;
        for (int k = 0; k < 8; ++k) { const int x = (x0 + k) & 7; const int L = base + 8 * (int)xb_add(ctr + x * 16, 1u) + x; if (L < S.nwg) return L; }
        return -1;
    }
};
struct G1Int8Order {
    static constexpr bool DYN = false;
    StaticOrder S;
    __device__ bool next(int i, Unit& u) const {
        const int c = S.c;
        if (c >= 248 && i >= 27) return false;
        if (i == 28 && c >= 224 && c < 232) { StaticOrder T = S; T.c = c + 24; return T.next(27, u); }
        return S.next(i, u);
    }
};
struct CtxSplitOrder {
    static constexpr bool DYN = false;
    int c;
    __device__ bool next(int i, Unit& u) const { if (i > 0 || c >= 256) return false; u.pm = 64 + (c >> 7); u.pn = (c >> 3) & 15; u.kb = (c & 7) * 512 * 2; return true; }
};
struct NoHook { static constexpr bool ON = false; __device__ __forceinline__ void operator()(f32x4 (&)[2][2][4][2], const Unit&, int, int, int, int, int) const {} };

template <bool F8, class Epi, class Sched, class Hook>
__device__ __forceinline__ void gemm_phase(LAS unsigned char* lds, const Gemm g, const Sched& S, const Epi& E, const Hook& HK, const int wv0) {
    int tid_ = wv0 * 64 + lane_id(); asm volatile("" : "+v"(tid_));
    const int tid = tid_, wid = __builtin_amdgcn_readfirstlane(tid >> 6), lane = tid & 63, wr = wid >> 2, wc = wid & 3, fr = lane & 15, fq = lane >> 4;
    const int K = g.K, nt = F8 ? K / 128 : K / BK;
    unsigned voffA, voffB;
    { int R, C; stage_rc(tid * 16, R, C); const int Rb = Epi::PERM ? ((R & ~31) + perm32(R & 31)) : R;
      voffA = (unsigned)(R * g.ldaB + C * 2); voffB = (unsigned)(Rb * g.ldbB + C * 2); }
    const size_t p1A = (size_t)64 * g.ldaB, p1B = (size_t)64 * g.ldbB;
    const size_t kstep = (size_t)(BK * 2);
    const size_t hstepA = (size_t)HALF * g.ldaB, hstepB = (size_t)HALF * g.ldbB;
    const size_t tstepA = 2 * hstepA, tstepB = 2 * hstepB;
    const unsigned ldsw = (unsigned)wid * 1024u;
    const unsigned ldsbase = (unsigned)(uintptr_t)lds;
    const int aoff = lds_byte(wr * 64 + fr, fq * 8), boff = lds_byte(wc * 32 + fr, fq * 8);
#define PG8_SA(b, h) (((b) * 2 + (h)) * HTB)
#define PG8_SB(b, h) ((4 + (b) * 2 + (h)) * HTB)
#define PG8_STAGE(bufoff, gbase, voff) do { const char* sb_ = (const char*)(gbase); const unsigned ld_ = ldsbase + (unsigned)(bufoff) + ldsw; \
        _Pragma("unroll") for (int _i = 0; _i < 2; ++_i) { unsigned keep_; const char* sbi_ = sb_ + (_i ? voff##_p1 : 0); \
            asm volatile("s_mov_b32 %0, m0\n\ts_mov_b32 m0, %3\n\ts_nop 0\n\tglobal_load_lds_dwordx4 %1, %2\n\ts_mov_b32 m0, %0" : "=&s"(keep_) : "v"(voff), "s"(sbi_), "s"(ld_ + _i * 8192) : "memory"); } } while (0)
#define voffA_p1 p1A
#define voffB_p1 p1B
#define PG8_LDA(dst, b, h) do { _Pragma("unroll") for (int m = 0; m < 4; ++m) _Pragma("unroll") for (int k = 0; k < 2; ++k) dst[m][k] = *(const LAS bf16x8*)(lds + PG8_SA(b, h) + aoff + m * 2048 + k * 1024); } while (0)
#define PG8_LDB(dst, b, h) do { _Pragma("unroll") for (int n = 0; n < 2; ++n) _Pragma("unroll") for (int k = 0; k < 2; ++k) dst[n][k] = *(const LAS bf16x8*)(lds + PG8_SB(b, h) + boff + n * 2048 + k * 1024); } while (0)
#define PG8_MMA(ai, bj, At, Bt) do { __builtin_amdgcn_s_setprio(1); \
        if constexpr (F8) { _Pragma("unroll") for (int m = 0; m < 4; ++m) _Pragma("unroll") for (int n = 0; n < 2; ++n) _Pragma("unroll") for (int k = 0; k < 2; ++k) \
            acc[ai][bj][m][n] = __builtin_bit_cast(f32x4, __builtin_amdgcn_mfma_i32_16x16x64_i8(__builtin_bit_cast(i32x4_t, Bt[n][k]), __builtin_bit_cast(i32x4_t, At[m][k]), __builtin_bit_cast(i32x4_t, acc[ai][bj][m][n]), 0, 0, 0)); } \
        else { _Pragma("unroll") for (int m = 0; m < 4; ++m) _Pragma("unroll") for (int n = 0; n < 2; ++n) _Pragma("unroll") for (int k = 0; k < 2; ++k) \
            acc[ai][bj][m][n] = __builtin_amdgcn_mfma_f32_16x16x32_bf16(Bt[n][k], At[m][k], acc[ai][bj][m][n], 0, 0, 0); } \
        __builtin_amdgcn_s_setprio(0); } while (0)
#define PG8_WAIT_V(n) asm volatile("s_waitcnt vmcnt(" #n ")" ::: "memory")
#define PG8_WAIT_L(n) asm volatile("s_waitcnt lgkmcnt(" #n ")" ::: "memory")
#define PG8_BAR __builtin_amdgcn_s_barrier()
#define PG8_SCHED __builtin_amdgcn_sched_barrier(0)
    Unit cur, nxt; int ui = 0;
    if (!S.next(0, cur)) return;
    f32x4 acc[2][2][4][2];
#pragma unroll
    for (int a = 0; a < 2; ++a)
#pragma unroll
        for (int b = 0; b < 2; ++b)
#pragma unroll
            for (int m = 0; m < 4; ++m)
#pragma unroll
                for (int n = 0; n < 2; ++n) acc[a][b][m][n] = (f32x4){0.f, 0.f, 0.f, 0.f};
    bf16x8 At[4][2], B0[2][2], B1[2][2];
    const char* cA = (const char*)g.A + (size_t)cur.pm * tstepA + cur.kb; const char* cB = (const char*)g.Bt + (size_t)cur.pn * tstepB + cur.kb;
    PG8_STAGE(PG8_SB(0, 0), cB, voffB); PG8_STAGE(PG8_SA(0, 0), cA, voffA); PG8_STAGE(PG8_SB(0, 1), cB + hstepB, voffB); PG8_STAGE(PG8_SA(0, 1), cA + hstepA, voffA);
    if (wr == 1) PG8_BAR;
    PG8_WAIT_V(4); PG8_BAR;
    PG8_STAGE(PG8_SB(1, 0), cB + kstep, voffB); PG8_STAGE(PG8_SA(1, 0), cA + kstep, voffA); PG8_STAGE(PG8_SB(1, 1), cB + hstepB + kstep, voffB);
    PG8_WAIT_V(6); PG8_BAR;
    for (;;) {
        bool has_next = false, dyn_next = false;
        if constexpr (Sched::DYN) { dyn_next = (ui + 1 >= S.R); }
        if (dyn_next) { if constexpr (Sched::DYN) { if (wid == 0 && lane == 0) { *(volatile LAS int*)(lds + (144 * 1024 - 256) + 36) = S.claim(); } } }
        else has_next = S.next(ui + 1, nxt);
        const char* nA = has_next ? (const char*)g.A + (size_t)nxt.pm * tstepA + nxt.kb : cA; const char* nB = has_next ? (const char*)g.Bt + (size_t)nxt.pn * tstepB + nxt.kb : cB;
        for (int t = 0; t < nt; t += 2) {
            const bool last = (t == nt - 2);
            const char* a1 = cA + (size_t)(t + 1) * kstep;
            const char* a2 = last ? nA : cA + (size_t)(t + 2) * kstep; const char* b2 = last ? nB : cB + (size_t)(t + 2) * kstep;
            const char* a3 = a2 + kstep; const char* b3 = b2 + kstep;
            if constexpr (Sched::DYN) { if (dyn_next && t == 2) { const int L_ = __builtin_amdgcn_readfirstlane(*(volatile LAS int*)(lds + (144 * 1024 - 256) + 36));
                has_next = (L_ >= 0); if (has_next) { S.S.map(L_, nxt); nA = (const char*)g.A + (size_t)nxt.pm * tstepA + nxt.kb; nB = (const char*)g.Bt + (size_t)nxt.pn * tstepB + nxt.kb; } } }
            if (Hook::ON) { if (t > 0 && (t & 15) == 0) HK(acc, cur, t >> 4, wr, wc, fr, fq); }
            PG8_LDB(B0, 0, 0); PG8_SCHED; PG8_LDA(At, 0, 0); PG8_STAGE(PG8_SA(1, 1), a1 + hstepA, voffA);
            PG8_WAIT_L(8); PG8_BAR; PG8_WAIT_L(0); PG8_MMA(0, 0, At, B0); PG8_BAR; PG8_SCHED;
            PG8_LDB(B1, 0, 1); PG8_STAGE(PG8_SB(0, 0), b2, voffB);
            PG8_BAR; PG8_WAIT_L(0); PG8_MMA(0, 1, At, B1); PG8_BAR;
            PG8_LDA(At, 0, 1); PG8_STAGE(PG8_SA(0, 0), a2, voffA);
            PG8_BAR; PG8_WAIT_L(0); PG8_MMA(1, 0, At, B0); PG8_BAR; PG8_SCHED;
            PG8_STAGE(PG8_SB(0, 1), b2 + hstepB, voffB);
            PG8_WAIT_V(6); PG8_BAR; PG8_MMA(1, 1, At, B1); PG8_BAR;
            PG8_LDB(B0, 1, 0); PG8_SCHED; PG8_LDA(At, 1, 0); PG8_STAGE(PG8_SA(0, 1), a2 + hstepA, voffA);
            PG8_WAIT_L(8); PG8_BAR; PG8_WAIT_L(0); PG8_MMA(0, 0, At, B0); PG8_BAR; PG8_SCHED;
            PG8_LDB(B1, 1, 1); PG8_STAGE(PG8_SB(1, 0), b3, voffB);
            PG8_BAR; PG8_WAIT_L(0); PG8_MMA(0, 1, At, B1); PG8_BAR;
            PG8_LDA(At, 1, 1); PG8_STAGE(PG8_SA(1, 0), a3, voffA);
            PG8_BAR; PG8_WAIT_L(0); PG8_MMA(1, 0, At, B0); PG8_BAR; PG8_SCHED;
            PG8_STAGE(PG8_SB(1, 1), b3 + hstepB, voffB);
            PG8_WAIT_V(6); PG8_BAR; PG8_MMA(1, 1, At, B1); PG8_BAR;
        }
        E(acc, cur, wr, wc, fr, fq);
        if (!has_next) break;
#pragma unroll
        for (int a = 0; a < 2; ++a)
#pragma unroll
            for (int b = 0; b < 2; ++b)
#pragma unroll
                for (int m = 0; m < 4; ++m)
#pragma unroll
                    for (int n = 0; n < 2; ++n) acc[a][b][m][n] = (f32x4){0.f, 0.f, 0.f, 0.f};
        cur = nxt; cA = nA; cB = nB; ++ui;
    }
    PG8_WAIT_V(0);
    if (wr == 0) PG8_BAR;
    PG8_BAR;
#undef PG8_SA
#undef PG8_SB
#undef PG8_STAGE
#undef voffA_p1
#undef voffB_p1
#undef PG8_LDA
#undef PG8_LDB
#undef PG8_MMA
#undef PG8_WAIT_V
#undef PG8_WAIT_L
#undef PG8_BAR
#undef PG8_SCHED
}
}

__device__ static const unsigned char G1_ISF8[116] = {1,1,1,1,1,1,1,1,1,1,1,1,1,1,1,1,1,1,1,1,1,1,1,1,1,1,1,1,1,1,1,1,1,1,1,1,1,1,1,1,1,1,1,1,1,1,1,1,0,0,0,0,1,1,1,1,1,1,1,1,1,1,1,1,1,1,1,1,1,1,1,1,1,1,1,1,1,1,1,1,1,1,1,1,1,1,1,1,1,1,1,1,1,1,1,1,1,1,1,1,1,1,1,1,1,1,1,1,1,1,1,1,1,1,1,1};
__device__ static const unsigned char G1_LOCAL[116] = {0,1,2,3,4,5,6,7,8,9,10,11,12,13,14,15,16,17,18,19,20,21,22,23,24,25,26,27,28,29,30,31,32,33,34,35,36,37,38,39,40,41,42,43,44,45,46,47,0,1,2,3,48,49,50,51,52,53,54,55,56,57,58,59,60,61,62,63,64,65,66,67,68,69,70,71,72,73,74,75,76,77,78,79,80,81,82,83,84,85,86,87,88,89,90,91,92,93,94,95,96,97,98,99,100,101,102,103,104,105,106,107,108,109,110,111};
__device__ static const unsigned char G1_BF_LIST[4] = {48,49,50,51};
__device__ static const unsigned char G1_F8_LIST[112] = {0,1,2,3,4,5,6,7,8,9,10,11,12,13,14,15,16,17,18,19,20,21,22,23,24,25,26,27,28,29,30,31,32,33,34,35,36,37,38,39,40,41,42,43,44,45,46,47,52,53,54,55,56,57,58,59,60,61,62,63,64,65,66,67,68,69,70,71,72,73,74,75,76,77,78,79,80,81,82,83,84,85,86,87,88,89,90,91,92,93,94,95,96,97,98,99,100,101,102,103,104,105,106,107,108,109,110,111,112,113,114,115};
__device__ __forceinline__ int g1_global_bf(int lp) { return G1_BF_LIST[lp]; }
__device__ __forceinline__ int g1_global_f8(int lp) { return G1_F8_LIST[lp]; }
__device__ __forceinline__ void g1_dest(unsigned char* ws, int pn, bf16_t*& base, int& ld, int& col, int& act) {
    act = 0;
    if (pn < 4)        { base = (bf16_t*)(ws + WS_QA); ld = 1024; col = pn * 256; }
    else if (pn == 4)  { base = (bf16_t*)(ws + WS_KA); ld = 256;  col = 0; }
    else if (pn == 5)  { base = (bf16_t*)(ws + WS_VA); ld = 256;  col = 0; }
    else if (pn < 10)  { base = (bf16_t*)(ws + WS_G4); ld = 4096; col = (pn - 6) * 256; act = 1; }
    else if (pn < 14)  { base = (bf16_t*)(ws + WS_QB); ld = 1024; col = (pn - 10) * 256; }
    else if (pn < 18)  { base = (bf16_t*)(ws + WS_KB); ld = 1024; col = (pn - 14) * 256; }
    else if (pn < 22)  { base = (bf16_t*)(ws + WS_VB); ld = 1024; col = (pn - 18) * 256; }
    else if (pn < 26)  { base = (bf16_t*)(ws + WS_G4); ld = 4096; col = 1024 + (pn - 22) * 256; act = 1; }
    else if (pn < 32)  { base = (bf16_t*)(ws + WS_CC); ld = 1536; col = (pn - 26) * 256; }
    else if (pn < 36)  { base = (bf16_t*)(ws + WS_G4); ld = 4096; col = 2048 + (pn - 32) * 256; act = 1; }
    else if (pn < 40)  { base = (bf16_t*)(ws + WS_QD); ld = 1024; col = (pn - 36) * 256; }
    else if (pn < 44)  { base = (bf16_t*)(ws + WS_KD); ld = 1024; col = (pn - 40) * 256; }
    else if (pn < 48)  { base = (bf16_t*)(ws + WS_VD); ld = 1024; col = (pn - 44) * 256; }
    else if (pn < 52)  { base = (bf16_t*)(ws + WS_G4); ld = 4096; col = 3072 + (pn - 48) * 256; act = 1; }
    else               { base = (bf16_t*)(ws + WS_MG); ld = 16384; col = (pn - 52) * 256; act = 2; }
}
struct EpiG1 {
    static constexpr bool PERM = true;
    unsigned char* ws; int f8; const float* hs; const float* wsc;
    __device__ __forceinline__ void operator()(const f32x4 (&acc)[2][2][4][2], const pg8::Unit& u, int wr, int wc, int fr, int fq) const {
        unsigned char* wsl = ws; asm volatile("" : "+s"(wsl));
        const int gpn = f8 ? (u.pn < 48 ? u.pn : u.pn + 4) : 48 + u.pn;
        bf16_t* base; int ld, col, act; g1_dest(wsl, gpn, base, ld, col, act);
        const int row0 = u.pm * 256 + wr * 64 + fr, col0 = col + wc * 32 + 8 * fq;
        f32x4 cs[2][2];
        float rs8[2][4];
        if (f8) {
#pragma unroll
            for (int bj = 0; bj < 2; ++bj) { const float* wp = wsc + gpn * 256 + bj * 128 + wc * 32 + 8 * fq; gld16f(cs[bj][0], wp); gld16f(cs[bj][1], wp + 4); }
#pragma unroll
            for (int ai = 0; ai < 2; ++ai)
#pragma unroll
                for (int m = 0; m < 4; ++m) asm volatile("global_load_dword %0, %1, off" : "=&v"(rs8[ai][m]) : "v"(hs + row0 + ai * 128 + m * 16) : "memory");
            GLD_WAIT();
            if (act == 2) {
#pragma unroll
                for (int bj = 0; bj < 2; ++bj) { cs[bj][0] *= -LOG2E; cs[bj][1] *= -LOG2E; } }
        } else {
#pragma unroll
            for (int ai = 0; ai < 2; ++ai)
#pragma unroll
                for (int m = 0; m < 4; ++m) rs8[ai][m] = 1.0f;
        }
#pragma unroll
        for (int ai = 0; ai < 2; ++ai)
#pragma unroll
            for (int m = 0; m < 4; ++m) { const int row = row0 + ai * 128 + m * 16; bf16_t* rowp = base + (size_t)row * ld + col0;
                const float rsc = rs8[ai][m];
#pragma unroll
                for (int bj = 0; bj < 2; ++bj) { f32x4 v0 = acc[ai][bj][m][0], v1 = acc[ai][bj][m][1];
                    if (f8 && act == 2) {
#pragma unroll
                        for (int j = 0; j < 4; ++j) { v0[j] = fast_rcp(1.0f + fast_exp2((float)__float_as_int(v0[j]) * (rsc * cs[bj][0][j]))); v1[j] = fast_rcp(1.0f + fast_exp2((float)__float_as_int(v1[j]) * (rsc * cs[bj][1][j]))); } }
                    else {
                    if (f8) {
#pragma unroll
                        for (int j = 0; j < 4; ++j) { v0[j] = (float)__float_as_int(v0[j]) * (rsc * cs[bj][0][j]); v1[j] = (float)__float_as_int(v1[j]) * (rsc * cs[bj][1][j]); } }
                    if (act == 1) {
#pragma unroll
                        for (int j = 0; j < 4; ++j) { v0[j] = silu_f(v0[j]); v1[j] = silu_f(v1[j]); } }
                    else if (act == 2) {
#pragma unroll
                        for (int j = 0; j < 4; ++j) { v0[j] = sigm_f(v0[j]); v1[j] = sigm_f(v1[j]); } }
                    }
                    u32x4 w; w.x = cvt_pk_bf16(v0[0], v0[1]); w.y = cvt_pk_bf16(v0[2], v0[3]); w.z = cvt_pk_bf16(v1[0], v1[1]); w.w = cvt_pk_bf16(v1[2], v1[3]);
                    *(u32x4*)(rowp + bj * 128) = w; }
                asm volatile("" ::: "memory"); }
    }
};
struct EpiPlain {
    static constexpr bool PERM = true;
    bf16_t* O; int ld;
    __device__ __forceinline__ void operator()(const f32x4 (&acc)[2][2][4][2], const pg8::Unit& u, int wr, int wc, int fr, int fq) const {
        const int row0 = u.pm * 256 + wr * 64 + fr, col0 = u.pn * 256 + wc * 32 + 8 * fq;
#pragma unroll
        for (int ai = 0; ai < 2; ++ai)
#pragma unroll
            for (int m = 0; m < 4; ++m) { bf16_t* rowp = O + (size_t)(row0 + ai * 128 + m * 16) * ld + col0;
#pragma unroll
                for (int bj = 0; bj < 2; ++bj) { const f32x4 v0 = acc[ai][bj][m][0], v1 = acc[ai][bj][m][1];
                    u32x4 w; w.x = cvt_pk_bf16(v0[0], v0[1]); w.y = cvt_pk_bf16(v0[2], v0[3]); w.z = cvt_pk_bf16(v1[0], v1[1]); w.w = cvt_pk_bf16(v1[2], v1[3]);
                    *(u32x4*)(rowp + bj * 128) = w; } }
    }
};
struct HookMerge {
    static constexpr bool ON = true;
    const bf16_t* MG;
    __device__ __forceinline__ void operator()(f32x4 (&acc)[2][2][4][2], const pg8::Unit& u, int seg, int wr, int wc, int fr, int fq) const {
        const int row0 = u.pm * 256 + wr * 64 + fr, col0 = u.pn * 256 + wc * 32 + 8 * fq;
        u32x4 spA[2][2], snA[2][2], spB[2][2], snB[2][2];
#define HK_LOAD(SP, SN, AI, M0) do { _Pragma("unroll") for (int mm = 0; mm < 2; ++mm) { const bf16_t* rowp = MG + (size_t)(row0 + (AI) * 128 + ((M0) + mm) * 16) * 16384 + col0; \
            _Pragma("unroll") for (int bj = 0; bj < 2; ++bj) { gld16(SP[mm][bj], rowp + (seg - 1) * 4096 + bj * 128); gld16(SN[mm][bj], rowp + seg * 4096 + bj * 128); } } } while (0)
#define HK_COMP(SP, SN, AI, M0) do { _Pragma("unroll") for (int mm = 0; mm < 2; ++mm) _Pragma("unroll") for (int bj = 0; bj < 2; ++bj) { const u32x4 p = SP[mm][bj], n = SN[mm][bj]; \
            f32x4 r0, r1; \
            r0[0] = bflo(p.x) * fast_rcp(bflo(n.x)); r0[1] = bfhi(p.x) * fast_rcp(bfhi(n.x)); \
            r0[2] = bflo(p.y) * fast_rcp(bflo(n.y)); r0[3] = bfhi(p.y) * fast_rcp(bfhi(n.y)); \
            r1[0] = bflo(p.z) * fast_rcp(bflo(n.z)); r1[1] = bfhi(p.z) * fast_rcp(bfhi(n.z)); \
            r1[2] = bflo(p.w) * fast_rcp(bflo(n.w)); r1[3] = bfhi(p.w) * fast_rcp(bfhi(n.w)); \
            acc[AI][bj][(M0) + mm][0] *= r0; acc[AI][bj][(M0) + mm][1] *= r1; } } while (0)
#define HK_WAIT(N) do { asm volatile("s_waitcnt vmcnt(" #N ")" ::: "memory"); __builtin_amdgcn_sched_barrier(0); } while (0)
        HK_LOAD(spA, snA, 0, 0); HK_LOAD(spB, snB, 0, 2);
        HK_WAIT(8); HK_COMP(spA, snA, 0, 0); __builtin_amdgcn_sched_barrier(0); HK_LOAD(spA, snA, 1, 0);
        HK_WAIT(8); HK_COMP(spB, snB, 0, 2); __builtin_amdgcn_sched_barrier(0); HK_LOAD(spB, snB, 1, 2);
        HK_WAIT(8); HK_COMP(spA, snA, 1, 0);
        HK_WAIT(0); HK_COMP(spB, snB, 1, 2);
#undef HK_LOAD
#undef HK_COMP
#undef HK_WAIT
    }
};
struct EpiMerge {
    static constexpr bool PERM = true;
    const bf16_t* MG; bf16_t* O;
    __device__ __forceinline__ void operator()(const f32x4 (&acc)[2][2][4][2], const pg8::Unit& u, int wr, int wc, int fr, int fq) const {
        const int row0 = u.pm * 256 + wr * 64 + fr, col0 = u.pn * 256 + wc * 32 + 8 * fq;
        u32x4 sg[2][4][2];
#pragma unroll
        for (int ai = 0; ai < 2; ++ai)
#pragma unroll
            for (int m = 0; m < 4; ++m)
#pragma unroll
                for (int bj = 0; bj < 2; ++bj) sg[ai][m][bj] = *(const u32x4*)(MG + (size_t)(row0 + ai * 128 + m * 16) * 16384 + 3 * 4096 + col0 + bj * 128);
#pragma unroll
        for (int ai = 0; ai < 2; ++ai)
#pragma unroll
            for (int m = 0; m < 4; ++m) { const size_t row = (size_t)(row0 + ai * 128 + m * 16);
#pragma unroll
                for (int bj = 0; bj < 2; ++bj) { const u32x4 sv = sg[ai][m][bj];
                    const f32x4 v0 = acc[ai][bj][m][0], v1 = acc[ai][bj][m][1];
                    u32x4 w; w.x = cvt_pk_bf16(v0[0] * bflo(sv.x), v0[1] * bfhi(sv.x)); w.y = cvt_pk_bf16(v0[2] * bflo(sv.y), v0[3] * bfhi(sv.y));
                    w.z = cvt_pk_bf16(v1[0] * bflo(sv.z), v1[1] * bfhi(sv.z)); w.w = cvt_pk_bf16(v1[2] * bflo(sv.w), v1[3] * bfhi(sv.w));
                    *(u32x4*)(O + row * 4096 + col0 + bj * 128) = w; } }
    }
};
struct EpiCtxPart3 {
    static constexpr bool PERM = true;
    const bf16_t* MG; float* P;
    __device__ __forceinline__ void operator()(const f32x4 (&acc)[2][2][4][2], const pg8::Unit& u, int wr, int wc, int fr, int fq) const {
        const int kc = u.kb >> 10, br = kc >> 1;
        const int row0 = u.pm * 256 + wr * 64 + fr, col0 = u.pn * 256 + wc * 32 + 8 * fq;
        u32x4 sg[2][4][2];
#pragma unroll
        for (int ai = 0; ai < 2; ++ai)
#pragma unroll
            for (int m = 0; m < 4; ++m)
#pragma unroll
                for (int bj = 0; bj < 2; ++bj) sg[ai][m][bj] = *(const u32x4*)(MG + (size_t)(row0 + ai * 128 + m * 16) * 16384 + br * 4096 + col0 + bj * 128);
        float* Pk = P + (size_t)kc * MCTX * 4096;
#pragma unroll
        for (int ai = 0; ai < 2; ++ai)
#pragma unroll
            for (int m = 0; m < 4; ++m) { const size_t rowc = (size_t)(row0 + ai * 128 + m * 16 - MLAT);
#pragma unroll
                for (int bj = 0; bj < 2; ++bj) { const u32x4 sv = sg[ai][m][bj]; const f32x4 v0 = acc[ai][bj][m][0], v1 = acc[ai][bj][m][1];
                    f32x4 o0, o1; o0[0] = v0[0] * bflo(sv.x); o0[1] = v0[1] * bfhi(sv.x); o0[2] = v0[2] * bflo(sv.y); o0[3] = v0[3] * bfhi(sv.y);
                    o1[0] = v1[0] * bflo(sv.z); o1[1] = v1[1] * bfhi(sv.z); o1[2] = v1[2] * bflo(sv.w); o1[3] = v1[3] * bfhi(sv.w);
                    *(f32x4*)(Pk + rowc * 4096 + col0 + bj * 128) = o0; *(f32x4*)(Pk + rowc * 4096 + col0 + bj * 128 + 4) = o1; } }
    }
};
struct EpiCtxPart4 {
    static constexpr bool PERM = true;
    float* P;
    __device__ __forceinline__ void operator()(const f32x4 (&acc)[2][2][4][2], const pg8::Unit& u, int wr, int wc, int fr, int fq) const {
        const int kc = u.kb >> 10;
        const int row0 = u.pm * 256 + wr * 64 + fr - MLAT, col0 = u.pn * 256 + wc * 32 + 8 * fq;
        float* Pk = P + (size_t)kc * MCTX * 4096;
#pragma unroll
        for (int ai = 0; ai < 2; ++ai)
#pragma unroll
            for (int m = 0; m < 4; ++m) { const size_t rowc = (size_t)(row0 + ai * 128 + m * 16);
#pragma unroll
                for (int bj = 0; bj < 2; ++bj) { *(f32x4*)(Pk + rowc * 4096 + col0 + bj * 128) = acc[ai][bj][m][0]; *(f32x4*)(Pk + rowc * 4096 + col0 + bj * 128 + 4) = acc[ai][bj][m][1]; } }
    }
};
struct EpiResid {
    static constexpr bool PERM = false;
    const float* xin; const float* cin; float* xout; float* cout; const float* mods;
    __device__ __forceinline__ void operator()(const f32x4 (&acc)[2][2][4][2], const pg8::Unit& u, int wr, int wc, int fr, int fq) const {
        const int j = u.pm < 32 ? 0 : (u.pm < 64 ? 1 : 2);
        const int rloc = (u.pm < 64 ? u.pm * 256 : (u.pm - 64) * 256) + wr * 64 + fr, col0 = u.pn * 256 + wc * 32 + 4 * fq;
        const float* bi = u.pm < 64 ? xin : cin; float* bo = u.pm < 64 ? xout : cout;
        const float* gt = mods + j * 12288 + 8192 + col0;
        f32x4 gv[2][2];
#pragma unroll
        for (int bj = 0; bj < 2; ++bj)
#pragma unroll
            for (int n = 0; n < 2; ++n) gv[bj][n] = *(const f32x4*)(gt + bj * 128 + n * 16);
#pragma unroll
        for (int ai = 0; ai < 2; ++ai) {
            f32x4 rb[4][2][2];
#pragma unroll
            for (int m = 0; m < 4; ++m) { const size_t off = (size_t)(rloc + ai * 128 + m * 16) * 4096 + col0;
#pragma unroll
                for (int bj = 0; bj < 2; ++bj)
#pragma unroll
                    for (int n = 0; n < 2; ++n) gld16f(rb[m][bj][n], bi + off + bj * 128 + n * 16); }
            GLD_WAIT();
#pragma unroll
            for (int m = 0; m < 4; ++m) { const size_t off = (size_t)(rloc + ai * 128 + m * 16) * 4096 + col0;
#pragma unroll
                for (int bj = 0; bj < 2; ++bj)
#pragma unroll
                    for (int n = 0; n < 2; ++n) *(f32x4*)(bo + off + bj * 128 + n * 16) = rb[m][bj][n] + gv[bj][n] * acc[ai][bj][m][n]; }
            asm volatile("" ::: "memory"); }
    }
};

namespace att {
#define SBAR() __builtin_amdgcn_sched_barrier(0)
__device__ __forceinline__ int crowc(int r) { return (r & 3) + 8 * (r >> 2); }
template <int DQK> __device__ __forceinline__ int kaddr(int row, int g) {
    const int r = row & 31;
    if (DQK == 128) { const int f = (r & 7) | ((r >> 1) & 8); return row * 256 + ((g ^ f) << 4); }
    else { const int s = ((r >> 1) & 3) | ((r >> 2) & 4); return row * (DQK * 2) + ((g ^ s) << 4); }
}
__device__ __forceinline__ int v_st(int k, int c) { const int kk = (k & ~0xC) | ((k & 4) << 1) | ((k & 8) >> 1); return ((kk >> 3) * 4 + (c >> 5)) * 512 + ((kk & 7) * 32 + (c & 31)) * 2; }
__device__ __forceinline__ int v_rd_base(int lane) { return ((lane & 3) << 3) | (((lane >> 2) & 3) << 6) | (((lane >> 4) & 1) << 5) | (((lane >> 5) & 1) << 8); }
constexpr int v_rd_off(int d0, int ks, int half) { return d0 * 512 + ks * 4096 + half * 2048; }
template <int OFF> __device__ __forceinline__ s16x4 tr_read(int vb) {
    s16x4 r; asm volatile("ds_read_b64_tr_b16 %0, %1 offset:%2" : "=&v"(r) : "v"(vb), "i"(OFF) : "memory"); return r;
}
template <int D0> __device__ __forceinline__ void pv_one(f32x16& od, int vb, bf16x8 pa0, bf16x8 pa1, bf16x8 pa2, bf16x8 pa3) {
    const s16x4 l0 = tr_read<v_rd_off(D0, 0, 0)>(vb), h0 = tr_read<v_rd_off(D0, 0, 1)>(vb), l1 = tr_read<v_rd_off(D0, 1, 0)>(vb), h1 = tr_read<v_rd_off(D0, 1, 1)>(vb);
    const s16x4 l2 = tr_read<v_rd_off(D0, 2, 0)>(vb), h2 = tr_read<v_rd_off(D0, 2, 1)>(vb), l3 = tr_read<v_rd_off(D0, 3, 0)>(vb), h3 = tr_read<v_rd_off(D0, 3, 1)>(vb);
    asm volatile("s_waitcnt lgkmcnt(0)" ::: "memory"); SBAR();
#define PK(L, H) (bf16x8){L[0], L[1], L[2], L[3], H[0], H[1], H[2], H[3]}
    od = __builtin_amdgcn_mfma_f32_32x32x16_bf16(pa0, PK(l0, h0), od, 0, 0, 0);
    od = __builtin_amdgcn_mfma_f32_32x32x16_bf16(pa1, PK(l1, h1), od, 0, 0, 0);
    od = __builtin_amdgcn_mfma_f32_32x32x16_bf16(pa2, PK(l2, h2), od, 0, 0, 0);
    od = __builtin_amdgcn_mfma_f32_32x32x16_bf16(pa3, PK(l3, h3), od, 0, 0, 0);
#undef PK
}
__device__ __forceinline__ void pv_d0(f32x16* o, int vb, bf16x8 pa0, bf16x8 pa1, bf16x8 pa2, bf16x8 pa3) {
    pv_one<0>(o[0], vb, pa0, pa1, pa2, pa3); pv_one<1>(o[1], vb, pa0, pa1, pa2, pa3); pv_one<2>(o[2], vb, pa0, pa1, pa2, pa3); pv_one<3>(o[3], vb, pa0, pa1, pa2, pa3);
}

constexpr int V_BYTES = 64 * 128 * 2;
template <int DQK> constexpr int k_bytes() { return 64 * DQK * 2; }
template <int DQK> constexpr int ring_k() { return DQK == 192 ? 3 : 4; }
template <int DQK> constexpr int ring_v() { return 4; }
template <int DQK> constexpr int off_k() { return ring_v<DQK>() * V_BYTES; }
template <int DQK> constexpr int off_li() { return off_k<DQK>() + ring_k<DQK>() * k_bytes<DQK>(); }
template <int DQK> constexpr int off_bias() { return off_li<DQK>() + 1024; }
constexpr int BIAS_SLACK = 256;
constexpr int ATT_LDS_MAX = 4 * V_BYTES + 3 * 64 * 192 * 2 + 1024 + 256 + 15 * 32 * 4 + 512;

struct AU {
    const bf16_t* Q;  int ldq;
    const bf16_t* Kl; const bf16_t* Vl;
    const bf16_t* Kc; const bf16_t* Vc;
    int ldk, ldv, nlat, nt;
    float C, MC, sinkL;
    int m0, m1;
    const float* rpb;
    const float* gq; const float* gq2;
    const float* rope; int qrope, tpos0;
    int out_mode;
    void* out; const bf16_t* gate; int ldo;
    const float* o0; const float* subw; float lam, om;
};

template <int DQK, int MODE>
__device__ __forceinline__ void attn_unit(const AU& u, LAS unsigned char* lds, const int wv0) {
    constexpr int NQ = DQK / 16, KB = k_bytes<DQK>(), NKP = DQK / 64, GPR = DQK / 8;
    int tid_ = wv0 * 64 + lane_id(); asm volatile("" : "+v"(tid_));
    const int tid = tid_, wid = __builtin_amdgcn_readfirstlane(tid >> 6), lane = tid & 63, r32 = lane & 31, hi = lane >> 5;
    constexpr int SK = ring_k<DQK>(), SV = ring_v<DQK>(), G_ = NKP + 2;
    LAS unsigned char* V_lds = lds; LAS unsigned char* K_lds = lds + off_k<DQK>();
    LAS float* li_l = (LAS float*)(lds + off_li<DQK>()) + wid * 32;
    LAS float* biasL = (LAS float*)(lds + off_bias<DQK>() + BIAS_SLACK);
    __syncthreads();
    if (MODE == 2) { if (tid < 480) { const int dr = tid >> 5, dc = tid & 31; biasL[tid] = dc < 31 ? u.rpb[dr * 31 + dc] * LOG2E - u.MC : 0.f; } }
    f32x16 o[4];
#pragma unroll
    for (int d = 0; d < 4; ++d)
#pragma unroll
        for (int r = 0; r < 16; ++r) o[d][r] = 0.f;
    float l_part = 0.f;
    bf16x8 qr[NQ];
    {
        constexpr int NQ1 = (DQK == 192) ? 8 : NQ;
        const bf16_t* Qw = u.Q + (size_t)(wid * 32 + r32) * u.ldq + hi * 8;
        u32x4 raw[NQ];
#pragma unroll
        for (int d0 = 0; d0 < NQ; ++d0) raw[d0] = *(const u32x4*)(Qw + d0 * 16);
        float qf[NQ][8];
#pragma unroll
        for (int d0 = 0; d0 < NQ; ++d0) { qf[d0][0] = bflo(raw[d0].x); qf[d0][1] = bfhi(raw[d0].x); qf[d0][2] = bflo(raw[d0].y); qf[d0][3] = bfhi(raw[d0].y);
            qf[d0][4] = bflo(raw[d0].z); qf[d0][5] = bfhi(raw[d0].z); qf[d0][6] = bflo(raw[d0].w); qf[d0][7] = bfhi(raw[d0].w); }
        float ss = 0.f;
#pragma unroll
        for (int d0 = 0; d0 < NQ1; ++d0)
#pragma unroll
            for (int q = 0; q < 8; ++q) ss += qf[d0][q] * qf[d0][q];
        ss = half_swap_sum(ss);
        const float qsc = (MODE == 0) ? u.C : 1.0f;
        const float rs = __builtin_amdgcn_rsqf(ss * (1.0f / (NQ1 * 16)) + EPS) * qsc;
#pragma unroll
        for (int d0 = 0; d0 < NQ1; ++d0) { const f32x4 g0 = *(const f32x4*)(u.gq + d0 * 16 + hi * 8), g1 = *(const f32x4*)(u.gq + d0 * 16 + hi * 8 + 4);
#pragma unroll
            for (int q = 0; q < 4; ++q) { qf[d0][q] *= rs * g0[q]; qf[d0][4 + q] *= rs * g1[q]; } }
        if constexpr (DQK == 192) {
            float s2 = 0.f;
#pragma unroll
            for (int d0 = 8; d0 < 12; ++d0)
#pragma unroll
                for (int q = 0; q < 8; ++q) s2 += qf[d0][q] * qf[d0][q];
            s2 = half_swap_sum(s2);
            const float rs2 = __builtin_amdgcn_rsqf(s2 * (1.0f / 64.f) + EPS) * qsc;
#pragma unroll
            for (int d0 = 8; d0 < 12; ++d0) { const f32x4 g0 = *(const f32x4*)(u.gq2 + (d0 - 8) * 16 + hi * 8), g1 = *(const f32x4*)(u.gq2 + (d0 - 8) * 16 + hi * 8 + 4);
#pragma unroll
                for (int q = 0; q < 4; ++q) { qf[d0][q] *= rs2 * g0[q]; qf[d0][4 + q] *= rs2 * g1[q]; } }
        }
        if (u.qrope) {
            const int tpos = u.tpos0 + wid * 32 + r32, grow = tpos >> 6, gcol = tpos & 63;
            if constexpr (DQK == 128) {
                const float* ct = u.rope; const float* st = u.rope + 4096;
#pragma unroll
                for (int d0 = 0; d0 < 4; ++d0) { const int idx = (d0 < 2 ? grow : gcol) * 32 + (d0 & 1) * 16 + hi * 8;
                    const f32x4 c0 = *(const f32x4*)(ct + idx), c1 = *(const f32x4*)(ct + idx + 4), s0 = *(const f32x4*)(st + idx), s1 = *(const f32x4*)(st + idx + 4);
#pragma unroll
                    for (int q = 0; q < 8; ++q) { const float c = q < 4 ? c0[q & 3] : c1[q & 3], sn = q < 4 ? s0[q & 3] : s1[q & 3]; const float x1 = qf[d0][q], x2 = qf[d0 + 4][q];
                        qf[d0][q] = x1 * c - x2 * sn; qf[d0 + 4][q] = x2 * c + x1 * sn; } }
            } else {
                constexpr int B0 = (DQK == 192) ? 8 : 0;
                const float* ct = u.rope + 8192; const float* st = u.rope + 8192 + 2048;
#pragma unroll
                for (int d0 = 0; d0 < 2; ++d0) { const int idx = (d0 == 0 ? grow : gcol) * 16 + hi * 8;
                    const f32x4 c0 = *(const f32x4*)(ct + idx), c1 = *(const f32x4*)(ct + idx + 4), s0 = *(const f32x4*)(st + idx), s1 = *(const f32x4*)(st + idx + 4);
#pragma unroll
                    for (int q = 0; q < 8; ++q) { const float c = q < 4 ? c0[q & 3] : c1[q & 3], sn = q < 4 ? s0[q & 3] : s1[q & 3]; const float x1 = qf[B0 + d0][q], x2 = qf[B0 + d0 + 2][q];
                        qf[B0 + d0][q] = x1 * c - x2 * sn; qf[B0 + d0 + 2][q] = x2 * c + x1 * sn; } }
            }
        }
#pragma unroll
        for (int d0 = 0; d0 < NQ; ++d0) { u32x4 w; w.x = cvt_pk_bf16(qf[d0][0], qf[d0][1]); w.y = cvt_pk_bf16(qf[d0][2], qf[d0][3]); w.z = cvt_pk_bf16(qf[d0][4], qf[d0][5]); w.w = cvt_pk_bf16(qf[d0][6], qf[d0][7]);
            qr[d0] = *reinterpret_cast<bf16x8*>(&w); }
    }
    int kgo[NKP], vgo[2];
#pragma unroll
    for (int p = 0; p < NKP; ++p) { const int pos = (wid + 8 * p) * 1024 + lane * 16, row = pos / (DQK * 2), slot = (pos % (DQK * 2)) >> 4, r = row & 31;
        const int g = (DQK == 128) ? (slot ^ ((r & 7) | ((r >> 1) & 8))) : (slot ^ (((r >> 1) & 3) | ((r >> 2) & 4)));
        kgo[p] = row * u.ldk + g * 8; }
#pragma unroll
    for (int p = 0; p < 2; ++p) { const int pos = (wid + 8 * p) * 1024 + lane * 16, sub = pos >> 9, within = pos & 511;
        const int kk = (sub >> 2) * 8 + (within >> 6), k = (kk & ~0xC) | ((kk & 4) << 1) | ((kk & 8) >> 1), cc = (sub & 3) * 32 + ((within & 63) >> 1);
        vgo[p] = k * u.ldv + cc; }
    const int vb0 = (int)(unsigned)(uintptr_t)V_lds + v_rd_base(lane);
    const int nlat = u.nlat, NT = u.nt;
#define TILE_K(j) ((j) < nlat ? u.Kl + (size_t)(j) * 64 * u.ldk : u.Kc + (size_t)((j) - nlat) * 64 * u.ldk)
#define TILE_V(j) ((j) < nlat ? u.Vl + (size_t)(j) * 64 * u.ldv : u.Vc + (size_t)((j) - nlat) * 64 * u.ldv)
    const int lastT = NT - 1;
    const unsigned kldsb = (unsigned)(uintptr_t)K_lds, vldsb = (unsigned)(uintptr_t)V_lds;
#define GLDS(sbase, voffb, ldsaddr) do { unsigned keep_; asm volatile("s_mov_b32 %0, m0\n\ts_mov_b32 m0, %3\n\ts_nop 0\n\tglobal_load_lds_dwordx4 %1, %2\n\ts_mov_b32 m0, %0" : "=&s"(keep_) : "v"(voffb), "s"(sbase), "s"(ldsaddr) : "memory"); } while (0)
#define DMA_K(j, slot) do { const int jj_ = (j) < lastT ? (j) : lastT; const bf16_t* kp_ = TILE_K(jj_); const unsigned kd_ = kldsb + (unsigned)((slot) * KB + wid * 1024); \
        _Pragma("unroll") for (int p = 0; p < NKP; ++p) GLDS(kp_, (unsigned)(kgo[p] * 2), kd_ + p * 8192); } while (0)
#define DMA_V(j, slot) do { const int jj_ = (j) < lastT ? (j) : lastT; const bf16_t* vp_ = TILE_V(jj_); const unsigned vd_ = vldsb + (unsigned)((slot) * V_BYTES + wid * 1024); \
        _Pragma("unroll") for (int p = 0; p < 2; ++p) GLDS(vp_, (unsigned)(vgo[p] * 2), vd_ + p * 8192); } while (0)
#define STEP_SYNC(N) do { asm volatile("s_waitcnt vmcnt(%0) lgkmcnt(0)" :: "n"(N) : "memory"); __builtin_amdgcn_s_barrier(); asm volatile("" ::: "memory"); SBAR(); } while (0)
#define INC(x, S) do { x = (x + 1 == (S)) ? 0 : x + 1; } while (0)
    constexpr int QGRP = (NQ == 12) ? 2 : NQ;
    int kab[(DQK == 128) ? 8 : 4];
#pragma unroll
    for (int j = 0; j < ((DQK == 128) ? 8 : 4); ++j) kab[j] = kaddr<DQK>(r32, j * 2 + hi);
#define QKT(P0, P1, kslot) do { const LAS unsigned char* kb_ = K_lds + (kslot) * KB; \
        _Pragma("unroll") for (int r = 0; r < 16; ++r) { P0[r] = pinit; P1[r] = pinit; } \
        _Pragma("unroll") for (int d0 = 0; d0 < NQ; ++d0) { const int ka_ = (DQK == 128) ? kab[d0] : kab[d0 & 3] + (d0 >> 2) * 128; \
            const bf16x8 b0_ = *(const LAS bf16x8*)(kb_ + ka_); const bf16x8 b1_ = *(const LAS bf16x8*)(kb_ + ka_ + 32 * DQK * 2); \
            P0 = __builtin_amdgcn_mfma_f32_32x32x16_bf16(b0_, qr[d0], P0, 0, 0, 0); P1 = __builtin_amdgcn_mfma_f32_32x32x16_bf16(b1_, qr[d0], P1, 0, 0, 0); \
            if ((d0 + 1) % QGRP == 0 && d0 + 1 < NQ) SBAR(); } } while (0)
    const float C = u.C, nMC = -u.MC, pinit = (MODE == 0) ? -u.MC : 0.f;
#define PART1(p0, p1, jj) do { const int j_ = (jj); bool plain = true; \
        if (MODE == 1) { if (j_ < nlat) { plain = false; \
            const int base = u.m0 + 64 * j_ - (wid * 32 + r32) + 128 + 4 * hi; \
            _Pragma("unroll") for (int r = 0; r < 16; ++r) { const int d0_ = base + crowc(r), d1_ = d0_ + 32; \
                p0[r] = ((unsigned)d0_ <= 256u) ? fmaf(p0[r], C, nMC) : -1e30f; p1[r] = ((unsigned)d1_ <= 256u) ? fmaf(p1[r], C, nMC) : -1e30f; } } } \
        if (MODE == 2) { if (j_ < nlat) { plain = false; \
            const int kr = u.m1 + j_, qrow = u.m0 + (wid >> 1); int rs = qrow - 4; rs = rs < 0 ? 0 : (rs > 120 ? 120 : rs); \
            if (kr < rs || kr >= rs + 8) { \
                _Pragma("unroll") for (int r = 0; r < 16; ++r) { p0[r] = -1e30f; p1[r] = -1e30f; } \
            } else { \
                const int wq = (wid & 1) * 32 + r32; int cs = wq - 8; cs = cs < 0 ? 0 : (cs > 48 ? 48 : cs); \
                const LAS float* bl = biasL + (kr - qrow + 7) * 32 + 15 - wq + 4 * hi; \
                const int cb = 4 * hi - cs; \
                _Pragma("unroll") for (int r = 0; r < 16; ++r) { const int k0_ = crowc(r), k1_ = k0_ + 32; \
                    const float b0_ = bl[k0_], b1_ = bl[k1_]; \
                    p0[r] = ((unsigned)(cb + k0_) < 16u) ? fmaf(p0[r], C, b0_) : -1e30f; p1[r] = ((unsigned)(cb + k1_) < 16u) ? fmaf(p1[r], C, b1_) : -1e30f; } \
            } } } \
        if (plain && MODE != 0) { _Pragma("unroll") for (int r = 0; r < 16; ++r) { p0[r] = fmaf(p0[r], C, nMC); p1[r] = fmaf(p1[r], C, nMC); } } \
        _Pragma("unroll") for (int r = 0; r < 16; ++r) p0[r] = fast_exp2(p0[r]); } while (0)
    bf16x8 pa0, pa1, pa2, pa3;
#define PK4(P, BASE, OUT) do { const unsigned a0 = cvt_pk_bf16(P[BASE + 0], P[BASE + 1]), a1 = cvt_pk_bf16(P[BASE + 2], P[BASE + 3]);   \
        const unsigned b0 = cvt_pk_bf16(P[BASE + 4], P[BASE + 5]), b1 = cvt_pk_bf16(P[BASE + 6], P[BASE + 7]);                              \
        auto r0 = __builtin_amdgcn_permlane32_swap(a0, b0, false, false); auto r1 = __builtin_amdgcn_permlane32_swap(a1, b1, false, false); \
        u32x4 w = {r0[0], r1[0], r0[1], r1[1]}; OUT = *reinterpret_cast<bf16x8*>(&w); } while (0)
#define PART2(p0, p1) do { \
        _Pragma("unroll") for (int r = 0; r < 16; ++r) p1[r] = fast_exp2(p1[r]); \
        float ps = 0.f; \
        _Pragma("unroll") for (int r = 0; r < 16; ++r) ps += p0[r]; \
        _Pragma("unroll") for (int r = 0; r < 16; ++r) ps += p1[r]; \
        l_part += ps; \
        PK4(p0, 0, pa0); PK4(p0, 8, pa1); PK4(p1, 0, pa2); PK4(p1, 8, pa3); } while (0)
    if constexpr (MODE == 0) {
        constexpr int NW = ((SK - 2) * G_ + 2) < ((SV - 2) * G_) ? ((SK - 2) * G_ + 2) : ((SV - 2) * G_);
#define KADR(d0) ((DQK == 128) ? kab[(d0) & 7] : kab[(d0) & 3] + ((d0) >> 2) * 128)
#define TRL(dst, D0) do { dst[0] = tr_read<v_rd_off(D0, 0, 0)>(vb_); dst[1] = tr_read<v_rd_off(D0, 0, 1)>(vb_); dst[2] = tr_read<v_rd_off(D0, 1, 0)>(vb_); dst[3] = tr_read<v_rd_off(D0, 1, 1)>(vb_); \
        dst[4] = tr_read<v_rd_off(D0, 2, 0)>(vb_); dst[5] = tr_read<v_rd_off(D0, 2, 1)>(vb_); dst[6] = tr_read<v_rd_off(D0, 3, 0)>(vb_); dst[7] = tr_read<v_rd_off(D0, 3, 1)>(vb_); } while (0)
#define QKT_P2(P0, P1, kslot, Q0, Q1, vbase, dj, dslot) do { const LAS unsigned char* kb_ = K_lds + (kslot) * KB; const int vb_ = (vbase); \
        _Pragma("unroll") for (int r = 0; r < 16; ++r) { P0[r] = pinit; P1[r] = pinit; } \
        bf16x8 kf_[2][2]; float ps_ = 0.f; \
        { const int ka_ = KADR(0); kf_[0][0] = *(const LAS bf16x8*)(kb_ + ka_); kf_[0][1] = *(const LAS bf16x8*)(kb_ + ka_ + 32 * DQK * 2); } \
        SBAR(); DMA_K(dj, dslot); SBAR(); \
        _Pragma("unroll") for (int d0 = 0; d0 < NQ; ++d0) { \
            if (d0 + 1 < NQ) { const int ka_ = KADR(d0 + 1); kf_[(d0 + 1) & 1][0] = *(const LAS bf16x8*)(kb_ + ka_); kf_[(d0 + 1) & 1][1] = *(const LAS bf16x8*)(kb_ + ka_ + 32 * DQK * 2); } \
            P0 = __builtin_amdgcn_mfma_f32_32x32x16_bf16(kf_[d0 & 1][0], qr[d0], P0, 0, 0, 0); P1 = __builtin_amdgcn_mfma_f32_32x32x16_bf16(kf_[d0 & 1][1], qr[d0], P1, 0, 0, 0); \
            _Pragma("unroll") for (int r = (16 * d0) / NQ; r < (16 * (d0 + 1)) / NQ; ++r) { Q1[r] = fast_exp2(Q1[r]); ps_ += Q0[r] + Q1[r]; } \
            if (d0 == 0) PK4(Q0, 0, pa0); \
            if (d0 == 1) PK4(Q0, 8, pa1); \
            if (d0 == NQ / 2) PK4(Q1, 0, pa2); \
            if (d0 == NQ - 1) { TRL(ta_, 0); TRL(tb_, 1); } \
            SBAR(); } \
        PK4(Q1, 8, pa3); l_part += ps_; } while (0)
#define PKV(L, H) (bf16x8){L[0], L[1], L[2], L[3], H[0], H[1], H[2], H[3]}
#define PVBLK(D0, CUR, P0, P1) do { \
        o[D0] = __builtin_amdgcn_mfma_f32_32x32x16_bf16(pa0, PKV(CUR[0], CUR[1]), o[D0], 0, 0, 0); o[D0] = __builtin_amdgcn_mfma_f32_32x32x16_bf16(pa1, PKV(CUR[2], CUR[3]), o[D0], 0, 0, 0); \
        o[D0] = __builtin_amdgcn_mfma_f32_32x32x16_bf16(pa2, PKV(CUR[4], CUR[5]), o[D0], 0, 0, 0); o[D0] = __builtin_amdgcn_mfma_f32_32x32x16_bf16(pa3, PKV(CUR[6], CUR[7]), o[D0], 0, 0, 0); \
        _Pragma("unroll") for (int r = 4 * D0; r < 4 * D0 + 4; ++r) { P0[r] = fast_exp2(P0[r]); } \
        SBAR(); } while (0)
#define PV_P1(vbase, P0, P1, dj, dslot) do { const int vb_ = (vbase); \
        asm volatile("s_waitcnt lgkmcnt(8)" ::: "memory"); SBAR(); PVBLK(0, ta_, P0, P1); DMA_V(dj, dslot); SBAR(); \
        TRL(ta_, 2); asm volatile("s_waitcnt lgkmcnt(8)" ::: "memory"); SBAR(); PVBLK(1, tb_, P0, P1); \
        TRL(tb_, 3); asm volatile("s_waitcnt lgkmcnt(8)" ::: "memory"); SBAR(); PVBLK(2, ta_, P0, P1); \
        asm volatile("s_waitcnt lgkmcnt(0)" ::: "memory"); SBAR(); PVBLK(3, tb_, P0, P1); } while (0)
        f32x16 pA0, pA1, pB0, pB1; s16x4 ta_[8], tb_[8];
#pragma unroll
        for (int j = 0; j < SK - 1; ++j) DMA_K(j, j);
#pragma unroll
        for (int j = 0; j < SV - 2; ++j) DMA_V(j, j);
        asm volatile("s_waitcnt vmcnt(0)" ::: "memory"); __syncthreads();
        int kc = 0, kl = SK - 1, vc = SV - 1, vl = SV - 2;
        DMA_K(SK - 1, kl); DMA_V(SV - 2, vl); SBAR();
        QKT(pA0, pA1, kc); PART1(pA0, pA1, 0);
        STEP_SYNC(NW); INC(kc, SK); INC(kl, SK); INC(vc, SV); INC(vl, SV);
        for (int t = 1; t + 1 < NT; t += 2) {
            QKT_P2(pB0, pB1, kc, pA0, pA1, vb0 + vc * V_BYTES, t + SK - 1, kl);
            PV_P1(vb0 + vc * V_BYTES, pB0, pB1, t + SV - 2, vl);
            STEP_SYNC(NW); INC(kc, SK); INC(kl, SK); INC(vc, SV); INC(vl, SV);
            QKT_P2(pA0, pA1, kc, pB0, pB1, vb0 + vc * V_BYTES, t + SK, kl);
            PV_P1(vb0 + vc * V_BYTES, pA0, pA1, t + SV - 1, vl);
            STEP_SYNC(NW); INC(kc, SK); INC(kl, SK); INC(vc, SV); INC(vl, SV);
        }
        QKT_P2(pB0, pB1, kc, pA0, pA1, vb0 + vc * V_BYTES, NT - 1, kl);
        PV_P1(vb0 + vc * V_BYTES, pB0, pB1, NT - 1, vl);
        STEP_SYNC(NW); INC(vc, SV);
        PART2(pB0, pB1); SBAR();
        pv_d0(o, vb0 + vc * V_BYTES, pa0, pa1, pa2, pa3);
#undef KADR
#undef QKT_P2
#undef TRL
#undef PKV
#undef PVBLK
#undef PV_P1
    } else {
        static_assert(SK == SV, "masked loop uses one ring index");
        f32x16 pA0, pA1;
#pragma unroll
        for (int j = 0; j < SK - 1; ++j) { DMA_K(j, j); DMA_V(j, j); }
        asm volatile("s_waitcnt vmcnt(0)" ::: "memory"); __syncthreads();
        int kc = 0, kl = SK - 1;
        for (int t = 0; t < NT; ++t) {
            DMA_K(t + SK - 1, kl); DMA_V(t + SK - 1, kl); SBAR();
            bool dead = false;
            if (MODE == 1) { if (t < nlat) { const int k0 = u.m0 + 64 * t, q0w = wid * 32; dead = (k0 - (q0w + 31) > 128) || (q0w - (k0 + 63) > 128); } }
            if (MODE == 2) { if (t < nlat) { const int kr = u.m1 + t, qrow = u.m0 + (wid >> 1); int rs = qrow - 4; rs = rs < 0 ? 0 : (rs > 120 ? 120 : rs); dead = (kr < rs || kr >= rs + 8); } }
            if (!dead) {
                QKT(pA0, pA1, kc);
                PART1(pA0, pA1, t); PART2(pA0, pA1); SBAR();
                pv_d0(o, vb0 + kc * V_BYTES, pa0, pa1, pa2, pa3);
            }
            STEP_SYNC((SK - 2) * G_); INC(kc, SK); INC(kl, SK);
        }
    }
    asm volatile("s_waitcnt vmcnt(0)" ::: "memory");
    const int lane_e = lane_id(), r32e = lane_e & 31, hie = lane_e >> 5;
    { auto rr = __builtin_amdgcn_permlane32_swap(__float_as_uint(l_part), __float_as_uint(l_part), false, false);
      l_part = __uint_as_float(rr[0]) + __uint_as_float(rr[1]); }
    l_part += fast_exp2(u.sinkL);
    if (hie == 0) li_l[r32e] = l_part;
    asm volatile("s_waitcnt lgkmcnt(0)" ::: "memory");
    float rli[16];
#pragma unroll
    for (int r = 0; r < 16; ++r) rli[r] = fast_rcp(li_l[crowc(r) + 4 * hie]);
    {
        int ldo = u.ldo; asm volatile("" : "+s"(ldo));
        const unsigned voff = (unsigned)(4 * hie * ldo + r32e);
        if (u.out_mode == 1) {
            float* Ow = (float*)u.out + (size_t)(wid * 32) * ldo;
#pragma unroll
            for (int r = 0; r < 16; ++r) { float* Or = Ow + (size_t)(crowc(r) * ldo);
#pragma unroll
                for (int d0 = 0; d0 < 4; ++d0) Or[voff + d0 * 32] = o[d0][r] * rli[r]; }
        } else if (u.out_mode == 0) {
            bf16_t* Ow = (bf16_t*)u.out + (size_t)(wid * 32) * ldo; const bf16_t* Gw = u.gate + (size_t)(wid * 32) * ldo;
#pragma unroll
            for (int rc = 0; rc < 16; rc += 4) {
                unsigned short gt[4][4];
#pragma unroll
                for (int r = 0; r < 4; ++r)
#pragma unroll
                    for (int d0 = 0; d0 < 4; ++d0) gt[r][d0] = (Gw + (size_t)(crowc(rc + r) * ldo))[voff + d0 * 32];
#pragma unroll
                for (int r = 0; r < 4; ++r)
#pragma unroll
                    for (int d0 = 0; d0 < 4; ++d0) (Ow + (size_t)(crowc(rc + r) * ldo))[voff + d0 * 32] = f2bf(o[d0][rc + r] * rli[rc + r] * bf2f(gt[r][d0]));
                asm volatile("" ::: "memory"); }
        } else {
            int ld0 = 2048; asm volatile("" : "+s"(ld0));
            const unsigned voff0 = (unsigned)(4 * hie * ld0 + r32e);
            const float* O0w = u.o0 + (size_t)(wid * 32) * ld0;
            float ssr[16];
#pragma unroll
            for (int rc = 0; rc < 16; rc += 4) {
                float ov[4][4];
#pragma unroll
                for (int r = 0; r < 4; ++r)
#pragma unroll
                    for (int d0 = 0; d0 < 4; ++d0) ov[r][d0] = (O0w + (size_t)(crowc(rc + r) * ld0))[voff0 + d0 * 32];
#pragma unroll
                for (int r = 0; r < 4; ++r) { float sacc = 0.f;
#pragma unroll
                    for (int d0 = 0; d0 < 4; ++d0) { const float dv = ov[r][d0] - u.lam * (o[d0][rc + r] * rli[rc + r]); o[d0][rc + r] = dv; sacc += dv * dv; }
                    ssr[rc + r] = sacc; }
                asm volatile("" ::: "memory"); }
#pragma unroll
            for (int r = 0; r < 16; ++r) ssr[r] = half_sum(ssr[r]);
            float sw[4];
#pragma unroll
            for (int d0 = 0; d0 < 4; ++d0) sw[d0] = u.subw[d0 * 32 + r32e] * u.om;
            bf16_t* Ow = (bf16_t*)u.out + (size_t)(wid * 32) * ldo; const bf16_t* Gw = u.gate + (size_t)(wid * 32) * ldo;
#pragma unroll
            for (int rc = 0; rc < 16; rc += 4) {
                unsigned short gt[4][4];
#pragma unroll
                for (int r = 0; r < 4; ++r)
#pragma unroll
                    for (int d0 = 0; d0 < 4; ++d0) gt[r][d0] = (Gw + (size_t)(crowc(rc + r) * ldo))[voff + d0 * 32];
#pragma unroll
                for (int r = 0; r < 4; ++r) { const float rsn = __builtin_amdgcn_rsqf(ssr[rc + r] * (1.0f / 128.f) + EPS);
#pragma unroll
                    for (int d0 = 0; d0 < 4; ++d0) (Ow + (size_t)(crowc(rc + r) * ldo))[voff + d0 * 32] = f2bf(o[d0][rc + r] * rsn * sw[d0] * bf2f(gt[r][d0])); }
                asm volatile("" ::: "memory"); }
        }
    }
#undef TILE_K
#undef TILE_V
#undef GLDS
#undef DMA_K
#undef DMA_V
#undef STEP_SYNC
#undef INC
#undef QKT
#undef PART1
#undef PART2
#undef PK4
}
}

struct Args { const float* in[31]; float* out; unsigned char* ws; int ph_lo, ph_hi; };
enum { I_X = 0, I_C, I_CTX, I_CCTX, I_WADA, I_BADA, I_GNORM, I_WIN, I_QNA, I_KNA, I_SINKA, I_QNB, I_KNB, I_RPB, I_GQA, I_GKVA, I_WQUP, I_WKVUP, I_QNNOPE, I_QNPE, I_KNNOPE, I_KNPE,
       I_QND, I_KND, I_LQ1, I_LK1, I_LQ2, I_LK2, I_SUBLN, I_WBR, I_WOUT };
constexpr int GRID = 256, NTHR = 512;
constexpr int LDS_BYTES = 144 * 1024;
constexpr int LDS_MISC = LDS_BYTES - 256;
static_assert(att::ATT_LDS_MAX <= LDS_MISC && pg8::STAGE_BYTES <= LDS_MISC, "LDS budget");

__device__ __forceinline__ void tr_tile_desc(const Args& a, int idx, const float*& src, int& lds_n, bf16_t*& dst, int& ldk, bool& zero, bool& q8, const unsigned*& cmx, float*& wscp, bool& firstk) {
    const int l = idx / 19240; int r = idx % 19240; zero = false; q8 = false; cmx = nullptr; wscp = nullptr; firstk = false;
    if (r < 14848) { const int tk = (r & 255) >> 3, tn = (r >> 8) * 8 + (r & 7); const int n0d = tn * 64; zero = (n0d == 8128); const int n0s = n0d < 8128 ? n0d : n0d - 64;
        src = a.in[I_WIN] + ((size_t)l * 4096 + tk * 128) * NIN + n0s; lds_n = NIN; ldk = 4096;
        const int pn = n0d >> 8, ro = n0d & 255;
        if (!G1_ISF8[pn]) dst = (bf16_t*)(a.ws + WS_WIN) + ((size_t)l * NT_BF * 256 + G1_LOCAL[pn] * 256 + ro) * 4096 + tk * 128;
        else { q8 = true; dst = (bf16_t*)(a.ws + WS_W8 + ((size_t)l * NT_F8 * 256 + G1_LOCAL[pn] * 256 + ro) * 4096 + tk * 128);
            cmx = (const unsigned*)(a.ws + WS_CMAX) + (size_t)l * NIN + n0s; wscp = (float*)(a.ws + WS_WSC) + (size_t)l * NINP + n0d; firstk = (tk == 0); }
        return; }
    r -= 14848;
    if (r < 168) { const int tk = r / 24, tn = r % 24;
        src = a.in[I_WQUP] + ((size_t)l * 896 + tk * 128) * 1536 + tn * 64; lds_n = 1536; dst = (bf16_t*)(a.ws + WS_WQ) + ((size_t)l * 1536 + tn * 64) * 896 + tk * 128; ldk = 896; return; }
    r -= 168;
    if (r < 128) { const int tk = r / 32, tn = r % 32;
        src = a.in[I_WKVUP] + ((size_t)l * 512 + tk * 128) * 2048 + tn * 64; lds_n = 2048; dst = (bf16_t*)(a.ws + WS_WKV) + ((size_t)l * 2048 + tn * 64) * 512 + tk * 128; ldk = 512; return; }
    r -= 128;
    if (r < 2048) { const int br = r / 512, r2 = r % 512, tk = (r2 & 255) >> 5, tn = (r2 >> 8) * 32 + (r2 & 31);
        src = a.in[I_WBR] + (((size_t)l * 4 + br) * 1024 + tk * 128) * 4096 + tn * 64; lds_n = 4096; dst = (bf16_t*)(a.ws + WS_WB) + ((size_t)l * 4096 + tn * 64) * 4096 + br * 1024 + tk * 128; ldk = 4096; return; }
    r -= 2048;
    { const int tk = (r & 255) >> 3, tn = (r >> 8) * 8 + (r & 7);
        src = a.in[I_WOUT] + ((size_t)l * 4096 + tk * 128) * 4096 + tn * 64; lds_n = 4096; dst = (bf16_t*)(a.ws + WS_WO) + ((size_t)l * 4096 + tn * 64) * 4096 + tk * 128; ldk = 4096; }
}
__device__ __forceinline__ void phase_pre0(const Args& a, LAS unsigned char* lds, const int wv0) {
    const int tid = wv0 * 64 + lane_id(), bid = blockIdx.x;
    for (int un = bid; un < 4 * 58; un += GRID) {
        const int l = un / 58, cb = un % 58, c0 = cb * 512 + tid;
        if (c0 < NIN) {
            const float* wp = a.in[I_WIN] + (size_t)l * 4096 * NIN + c0;
            float m = 0.f, q = 0.f;
#pragma unroll 32
            for (int k = 0; k < CS_ROWS; ++k) { const float w = wp[(size_t)(k * 16) * NIN]; m = fmaxf(m, fabsf(w)); q = fmaf(w, w, q); }
            ((float*)(a.ws + WS_CMAX))[(size_t)l * NIN + c0] = m; ((float*)(a.ws + WS_CSQ))[(size_t)l * NIN + c0] = q;
        }
    }
    LAS float* sv = (LAS float*)lds;
    for (int un = bid; un < 4 * 6 * 32; un += GRID) {
        const int l = un / 192, cb = (un % 192) / 32, ksp = un % 32;
        __syncthreads();
        if (tid < 384) { const int j = tid >> 7, k = ksp * 128 + (tid & 127); const float cv = j < 2 ? a.in[I_C][j * 4096 + k] : a.in[I_CCTX][k]; sv[tid] = silu_f(cv); }
        __syncthreads();
        const float* wp = a.in[I_WADA] + ((size_t)l * 4096 + ksp * 128) * 12288 + cb * 2048 + tid * 4;
        f32x4 a0 = {0.f, 0.f, 0.f, 0.f}, a1 = a0, a2 = a0;
#pragma unroll 8
        for (int k = 0; k < 128; ++k) { const f32x4 w = *(const f32x4*)(wp + (size_t)k * 12288); a0 += w * sv[k]; a1 += w * sv[128 + k]; a2 += w * sv[256 + k]; }
        float* pp = (float*)(a.ws + WS_MODP) + ((size_t)(l * 32 + ksp) * 3) * 12288 + cb * 2048 + tid * 4;
        *(f32x4*)(pp) = a0; *(f32x4*)(pp + 12288) = a1; *(f32x4*)(pp + 2 * 12288) = a2;
    }
}
__device__ __forceinline__ void phase_prologue(const Args& a, LAS unsigned char* lds, const int wv0) {
    const int tid = wv0 * 64 + lane_id(), bid = blockIdx.x;
    LAS float* T = (LAS float*)lds;
    constexpr int NTILES = 4 * 19240;
    f32x4 rgA[4], rgB[4];
    bf16_t* dstA = nullptr; bf16_t* dstB = nullptr; int ldkA = 0, ldkB = 0; bool q8A = false, q8B = false, zA = false, zB = false, fkA = false, fkB = false;
    const unsigned* cmA = nullptr; const unsigned* cmB = nullptr; float* wsA = nullptr; float* wsB = nullptr;
#define TR_LOAD(RG, DST, LDK, Q8, ZZ, CM, WS, FK, tt) do { const float* src_; int ldn_; tr_tile_desc(a, (tt), src_, ldn_, DST, LDK, ZZ, Q8, CM, WS, FK); \
        _Pragma("unroll") for (int i = 0; i < 4; ++i) { const int idx = tid + 512 * i, kr = idx >> 4, c4 = (idx & 15) * 4; RG[i] = ZZ ? (f32x4){0.f, 0.f, 0.f, 0.f} : *(const f32x4*)(src_ + (size_t)kr * ldn_ + c4); } } while (0)
#define TR_TILE(RG, DST, LDK, Q8, ZZ, CM, WS, FK, tnext) do { \
        _Pragma("unroll") for (int i = 0; i < 4; ++i) { const int idx = tid + 512 * i, kr = idx >> 4, c4 = (idx & 15) * 4; \
            T[kr * 65 + c4 + 0] = RG[i][0]; T[kr * 65 + c4 + 1] = RG[i][1]; T[kr * 65 + c4 + 2] = RG[i][2]; T[kr * 65 + c4 + 3] = RG[i][3]; } \
        __syncthreads(); \
        bf16_t* dcur = DST; const int ldkc = LDK; const bool q8c = Q8, zc = ZZ, fkc = FK; const unsigned* cmc = CM; float* wsc_ = WS; \
        if ((tnext) < NTILES) TR_LOAD(RG, DST, LDK, Q8, ZZ, CM, WS, FK, (tnext)); \
        _Pragma("unroll") for (int i = 0; i < 2; ++i) { const int idx = tid + 512 * i, n = idx >> 4, kc = (idx & 15) * 8; \
            float v[8]; \
            _Pragma("unroll") for (int q = 0; q < 8; ++q) v[q] = T[(kc + q) * 65 + n]; \
            if (q8c) { const float cm_ = zc ? 0.f : fmaxf(__uint_as_float(cmc[n]), 4.0f * sqrtf(((const float*)cmc)[(WS_CSQ - WS_CMAX) / 4 + n] * (1.0f / CS_ROWS))); const float sc_ = cm_ > 0.f ? 127.0f / cm_ : 0.f; \
                int qi[8]; \
                _Pragma("unroll") for (int q = 0; q < 8; ++q) qi[q] = (int)__builtin_rintf(__builtin_amdgcn_fmed3f(v[q] * sc_, -127.0f, 127.0f)) & 0xff; \
                u32x2 w8; w8.x = (unsigned)(qi[0] | (qi[1] << 8) | (qi[2] << 16) | (qi[3] << 24)); w8.y = (unsigned)(qi[4] | (qi[5] << 8) | (qi[6] << 16) | (qi[7] << 24)); \
                *(u32x2*)((unsigned char*)dcur + (size_t)n * ldkc + kc) = w8; \
                if (fkc && kc == 0) wsc_[n] = cm_ * (1.0f / 127.0f); } \
            else { u32x4 w; w.x = cvt_pk_bf16(v[0], v[1]); w.y = cvt_pk_bf16(v[2], v[3]); w.z = cvt_pk_bf16(v[4], v[5]); w.w = cvt_pk_bf16(v[6], v[7]); \
                *(u32x4*)(dcur + (size_t)n * ldkc + kc) = w; } } \
        __syncthreads(); } while (0)
    if (bid < NTILES) TR_LOAD(rgA, dstA, ldkA, q8A, zA, cmA, wsA, fkA, bid);
    if (bid + GRID < NTILES) TR_LOAD(rgB, dstB, ldkB, q8B, zB, cmB, wsB, fkB, bid + GRID);
    for (int t = bid; t < NTILES; t += 2 * GRID) {
        TR_TILE(rgA, dstA, ldkA, q8A, zA, cmA, wsA, fkA, t + 2 * GRID);
        if (t + GRID < NTILES) TR_TILE(rgB, dstB, ldkB, q8B, zB, cmB, wsB, fkB, t + 3 * GRID);
    }
#undef TR_LOAD
#undef TR_TILE
}

__device__ __forceinline__ void sincos_acc(float ang, float& c, float& s) {
    const double x = (double)ang;
    const double q = __builtin_rint(x * 0.6366197723675814);
    const double y = x - q * 1.5707963267948966 - q * 6.123233995736766e-17;
    const double y2 = y * y;
    const double sy = y * (1.0 + y2 * (-1.0 / 6 + y2 * (1.0 / 120 + y2 * (-1.0 / 5040 + y2 * (1.0 / 362880 + y2 * (-1.0 / 39916800 + y2 * (1.0 / 6227020800.0)))))));
    const double cy = 1.0 + y2 * (-0.5 + y2 * (1.0 / 24 + y2 * (-1.0 / 720 + y2 * (1.0 / 40320 + y2 * (-1.0 / 3628800 + y2 * (1.0 / 479001600.0))))));
    const int qi = ((int)q) & 3;
    const double sd = (qi == 0) ? sy : (qi == 1) ? cy : (qi == 2) ? -sy : -cy;
    const double cd = (qi == 0) ? cy : (qi == 1) ? -sy : (qi == 2) ? -cy : sy;
    c = (float)cd; s = (float)sd;
}
__device__ __forceinline__ float wave_maxabs(const float* p, int n, int lane) { float m = 0.f; for (int i = lane; i < n; i += 64) m = fmaxf(m, fabsf(p[i])); return wave_max(m); }
__device__ __forceinline__ float wave_dot(const float* p, const float* q, int n, int lane) { float s = 0.f; for (int i = lane; i < n; i += 64) s += p[i] * q[i]; return wave_sum(s); }
__device__ __forceinline__ void phase_mods(const Args& a, const int wv0) {
    const int tid = wv0 * 64 + lane_id(), bid = blockIdx.x, gid = bid * NTHR + tid;
    float* mods = (float*)(a.ws + WS_MODS); const float* mp = (const float*)(a.ws + WS_MODP);
    for (int i = gid; i < 4 * 3 * 12288; i += GRID * NTHR) { const int l = i / 36864, r = i % 36864, j = r / 12288, c = r % 12288;
        float s = a.in[I_BADA][l * 12288 + c];
        for (int ks = 0; ks < 32; ++ks) s += mp[((size_t)(l * 32 + ks) * 3 + j) * 12288 + c];
        mods[i] = s; }
    float* rope = (float*)(a.ws + WS_ROPE);
    if (gid < 4096) { const int pos = gid >> 5, j = gid & 31; double inv = 1.0; for (int q = 0; q < j; ++q) inv *= 0.7498942093324558;
        const float ang = (float)pos * (float)inv; float c, s; sincos_acc(ang, c, s); rope[gid] = c; rope[4096 + gid] = s; }
    else if (gid < 4096 + 2048) { const int g2 = gid - 4096, pos = g2 >> 4, j = g2 & 15; double inv = 1.0; for (int q = 0; q < j; ++q) inv *= 0.5623413251903491;
        const float ang = (float)pos * (float)inv; float c, s; sincos_acc(ang, c, s); rope[8192 + g2] = c; rope[8192 + 2048 + g2] = s; }
    if (bid >= 16 && bid < 20 && tid < 64) {
        const int l = bid - 16, lane = tid; float* bnd = (float*)(a.ws + WS_BND) + l * 32;
        const float SAFE = 1.03f;
        const float mqa = wave_maxabs(a.in[I_QNA] + l * 128, 128, lane), mka = wave_maxabs(a.in[I_KNA] + l * 128, 128, lane);
        const float mqb = wave_maxabs(a.in[I_QNB] + l * 128, 128, lane), mkb = wave_maxabs(a.in[I_KNB] + l * 128, 128, lane);
        const float mqn = wave_maxabs(a.in[I_QNNOPE] + l * 128, 128, lane), mkn = wave_maxabs(a.in[I_KNNOPE] + l * 128, 128, lane);
        const float mqp = wave_maxabs(a.in[I_QNPE] + l * 64, 64, lane), mkp = wave_maxabs(a.in[I_KNPE] + l * 64, 64, lane);
        const float mqd = wave_maxabs(a.in[I_QND] + l * 64, 64, lane), mkd = wave_maxabs(a.in[I_KND] + l * 64, 64, lane);
        const float bA = SAFE * 11.313708498984761f * mqa * mka;
        const float bB = SAFE * 11.313708498984761f * mqb * mkb;
        const float bC = SAFE * 0.07216878364870323f * (128.f * mqn * mkn + 64.f * mqp * mkp);
        const float bD = SAFE * 8.0f * mqd * mkd;
        const float li_[4] = {0.2f, 0.35550906759096934f, 0.4707130183435842f, 0.5560582041556406f};
        const float d1 = wave_dot(a.in[I_LQ1] + l * 64, a.in[I_LK1] + l * 64, 64, lane), d2 = wave_dot(a.in[I_LQ2] + l * 64, a.in[I_LK2] + l * 64, 64, lane);
        for (int h = 0; h < 8; ++h) {
            const float sk = a.in[I_SINKA][l * 8 + h]; const float MA = fmaxf(bA, sk);
            const float mr = wave_maxabs(a.in[I_RPB] + ((size_t)l * 8 + h) * 465, 465, lane);
            if (lane == 0) { bnd[h] = MA * LOG2E; bnd[8 + h] = (bB + mr) * LOG2E; bnd[19 + h] = (sk - MA) * LOG2E; }
        }
        if (lane == 0) { bnd[16] = bC * LOG2E; bnd[17] = bD * LOG2E; bnd[18] = expf(d1) - expf(d2) + li_[l]; }
    }
}

__device__ __forceinline__ void phase_xnorm(const Args& a, int l, const float* xin, const float* cin, float* cout, const int wv0) {
    int tid_ = wv0 * 64 + lane_id(); asm volatile("" : "+v"(tid_)); const int tid = tid_, lane = tid & 63, wv = blockIdx.x * 8 + (tid >> 6);
    const float* g = a.in[I_GNORM] + l * 4096; const float* mods = (const float*)(a.ws + WS_MODS) + l * 36864;
    bf16_t* H = (bf16_t*)(a.ws + WS_H);
    for (int row = wv; row < MTOT; row += GRID * 8) {
        const float* xr = row < MLAT ? xin + (size_t)row * 4096 : cin + (size_t)(row - MLAT) * 4096;
        const int j = row < SEQ ? 0 : (row < MLAT ? 1 : 2);
        const float* sh = mods + j * 12288; const float* sc = sh + 4096;
        f32x4 v[16]; float ss = 0.f;
#pragma unroll
        for (int i = 0; i < 16; ++i) v[i] = *(const f32x4*)(xr + (i * 64 + lane) * 4);
        if (row >= MLAT && l >= 1) {
            const float* gtp = (const float*)(a.ws + WS_MODS) + (l - 1) * 36864 + 2 * 12288 + 8192; const float* P4 = (const float*)(a.ws + WS_P4) + (size_t)(row - MLAT) * 4096;
#pragma unroll
            for (int i = 0; i < 16; ++i) { const int c = (i * 64 + lane) * 4; f32x4 sacc = *(const f32x4*)(P4 + c);
                for (int kc = 1; kc < 8; ++kc) sacc += *(const f32x4*)(P4 + (size_t)kc * MCTX * 4096 + c);
                v[i] += *(const f32x4*)(gtp + c) * sacc; *(f32x4*)(cout + (size_t)(row - MLAT) * 4096 + c) = v[i]; }
        }
#pragma unroll
        for (int i = 0; i < 16; ++i) ss += v[i][0] * v[i][0] + v[i][1] * v[i][1] + v[i][2] * v[i][2] + v[i][3] * v[i][3];
        ss = wave_sum(ss);
        const float rs = 1.0f / sqrtf(ss * (1.0f / 4096.f) + EPS);
        float amax = 0.f;
#pragma unroll
        for (int ib = 0; ib < 16; ib += 4) {
            f32x4 gv[4], scv[4], shv[4];
#pragma unroll
            for (int i = 0; i < 4; ++i) { const int c = ((ib + i) * 64 + lane) * 4; gld16f(gv[i], g + c); gld16f(scv[i], sc + c); gld16f(shv[i], sh + c); }
            GLD_WAIT();
#pragma unroll
            for (int i = 0; i < 4; ++i) { const f32x4 hv = v[ib + i] * rs * gv[i] * (1.0f + scv[i]) + shv[i]; v[ib + i] = hv;
                amax = fmaxf(amax, fmaxf(fmaxf(fabsf(hv[0]), fabsf(hv[1])), fmaxf(fabsf(hv[2]), fabsf(hv[3])))); }
        }
        amax = wave_max(amax);
        const float qs = amax > 0.f ? 127.0f / amax : 0.f;
        if (lane == 0) ((float*)(a.ws + WS_HS))[row] = amax * (1.0f / 127.0f);
#pragma unroll
        for (int i = 0; i < 16; ++i) { const int c = (i * 64 + lane) * 4; const f32x4 hv = v[i];
            u32x2 w; w.x = cvt_pk_bf16(hv[0], hv[1]); w.y = cvt_pk_bf16(hv[2], hv[3]);
            *(u32x2*)(H + (size_t)row * 4096 + c) = w;
            const int q0 = (int)__builtin_rintf(hv[0] * qs), q1 = (int)__builtin_rintf(hv[1] * qs), q2 = (int)__builtin_rintf(hv[2] * qs), q3 = (int)__builtin_rintf(hv[3] * qs);
            *(unsigned*)(a.ws + WS_H8 + (size_t)row * 4096 + c) = (unsigned)(q0 & 0xff) | ((unsigned)(q1 & 0xff) << 8) | ((unsigned)(q2 & 0xff) << 16) | ((unsigned)q3 << 24); }
    }
}

__device__ __forceinline__ void unpack8(const u32x4 v, float (&x)[8]) { x[0] = bflo(v.x); x[1] = bfhi(v.x); x[2] = bflo(v.y); x[3] = bfhi(v.y); x[4] = bflo(v.z); x[5] = bfhi(v.z); x[6] = bflo(v.w); x[7] = bfhi(v.w); }
__device__ __forceinline__ u32x4 pack8(const float (&x)[8]) { u32x4 w; w.x = cvt_pk_bf16(x[0], x[1]); w.y = cvt_pk_bf16(x[2], x[3]); w.z = cvt_pk_bf16(x[4], x[5]); w.w = cvt_pk_bf16(x[6], x[7]); return w; }
template <int GL> __device__ __forceinline__ u32x4 norm_group(const u32x4 v, const float* gain, bool rope, const float* ct, const float* st, int lane) {
    float x[8]; unpack8(v, x);
    float ss = 0.f;
#pragma unroll
    for (int q = 0; q < 8; ++q) ss += x[q] * x[q];
    if (GL == 16) ss += swz_xor<8>(ss);
    ss += swz_xor<4>(ss); ss += swz_xor<2>(ss); ss += swz_xor<1>(ss);
    const float rs = __builtin_amdgcn_rsqf(ss * (1.0f / (GL * 8)) + EPS);
    const f32x4 g0 = *(const f32x4*)gain, g1 = *(const f32x4*)(gain + 4);
#pragma unroll
    for (int q = 0; q < 4; ++q) { x[q] *= rs * g0[q]; x[4 + q] *= rs * g1[q]; }
    if (rope) {
        const f32x4 c0 = *(const f32x4*)ct, c1 = *(const f32x4*)(ct + 4), s0 = *(const f32x4*)st, s1 = *(const f32x4*)(st + 4);
        const bool first = (lane & (GL - 1)) < GL / 2;
#pragma unroll
        for (int q = 0; q < 8; ++q) { const float p = swz_xor<GL / 2>(x[q]); const float c = q < 4 ? c0[q & 3] : c1[q & 3], sn = q < 4 ? s0[q & 3] : s1[q & 3];
            x[q] = first ? (x[q] * c - p * sn) : (x[q] * c + p * sn); }
    }
    return pack8(x);
}
__device__ __forceinline__ void phase_post1(const Args& a, int l, const int wv0) {
    int tid_ = wv0 * 64 + lane_id(); asm volatile("" : "+v"(tid_)); const int tid = tid_, lane = tid & 63, wv = blockIdx.x * 8 + (tid >> 6);
    const float* rope = (const float*)(a.ws + WS_ROPE); const float* c128 = rope, *s128 = rope + 4096, *c64 = rope + 8192, *s64 = rope + 8192 + 2048;
    const int l16 = lane & 15, l8 = lane & 7;
    const float* gka = a.in[I_KNA] + l * 128 + l16 * 8; const float* gkb = a.in[I_KNB] + l * 128 + l16 * 8; const float* gkd = a.in[I_KND] + l * 64 + l8 * 8;
    const float* gq0 = a.in[I_GQA] + l * 896 + lane * 8; const float* gq1 = a.in[I_GQA] + l * 896 + 512 + (lane < 48 ? lane : 0) * 8; const float* gkv = a.in[I_GKVA] + l * 512 + lane * 8;
    const float* gpe = a.in[I_KNPE] + l * 64 + l8 * 8;
    for (int row = wv; row < MTOT; row += GRID * 8) {
        const bool lat = row < MLAT; const int tpos = row & (SEQ - 1), grow = tpos >> 6, gcol = tpos & 63;
        bf16_t* ka = (bf16_t*)(a.ws + WS_KA) + (size_t)row * 256; bf16_t* kb = (bf16_t*)(a.ws + WS_KB) + (size_t)row * 1024; bf16_t* kd = (bf16_t*)(a.ws + WS_KD) + (size_t)row * 1024;
        bf16_t* cc = (bf16_t*)(a.ws + WS_CC) + (size_t)row * 1536;
        const u32x4 z = {0u, 0u, 0u, 0u};
        const u32x4 rKA = lane < 32 ? *(const u32x4*)(ka + lane * 8) : z;
        const u32x4 rKB0 = *(const u32x4*)(kb + lane * 8), rKB1 = *(const u32x4*)(kb + 512 + lane * 8);
        const u32x4 rKD0 = *(const u32x4*)(kd + lane * 8), rKD1 = *(const u32x4*)(kd + 512 + lane * 8);
        const u32x4 rCQ0 = *(const u32x4*)(cc + lane * 8), rCQ1 = lane < 48 ? *(const u32x4*)(cc + 512 + lane * 8) : z, rCKV = *(const u32x4*)(cc + 896 + lane * 8);
        const u32x4 rPE = lane < 8 ? *(const u32x4*)(cc + 1408 + lane * 8) : z;
        const int p128 = (lane & 7) * 8, p64 = (lane & 3) * 8;
        const float* ct128 = c128 + (p128 < 32 ? grow : gcol) * 32 + (p128 & 31); const float* st128 = ct128 + 4096;
        const float* ct64 = c64 + (p64 < 16 ? grow : gcol) * 16 + (p64 & 15); const float* st64 = ct64 + 2048;
        const u32x4 oKA = norm_group<16>(rKA, gka, lat, ct128, st128, lane);
        const u32x4 oKB0 = norm_group<16>(rKB0, gkb, false, ct128, st128, lane), oKB1 = norm_group<16>(rKB1, gkb, false, ct128, st128, lane);
        const u32x4 oKD0 = norm_group<8>(rKD0, gkd, lat, ct64, st64, lane), oKD1 = norm_group<8>(rKD1, gkd, lat, ct64, st64, lane);
        const u32x4 oPE = norm_group<8>(rPE, gpe, lat, ct64, st64, lane);
        if (lane < 32) *(u32x4*)(ka + lane * 8) = oKA;
        *(u32x4*)(kb + lane * 8) = oKB0; *(u32x4*)(kb + 512 + lane * 8) = oKB1;
        *(u32x4*)(kd + lane * 8) = oKD0; *(u32x4*)(kd + 512 + lane * 8) = oKD1;
        if (lane < 8) *(u32x4*)(cc + 1408 + lane * 8) = oPE;
        {
            float x0[8], x1[8], xk[8]; unpack8(rCQ0, x0); unpack8(rCQ1, x1); unpack8(rCKV, xk);
            float s0 = 0.f, sk = 0.f;
#pragma unroll
            for (int q = 0; q < 8; ++q) { s0 += x0[q] * x0[q] + x1[q] * x1[q]; sk += xk[q] * xk[q]; }
            s0 = wave_sum(s0); sk = wave_sum(sk);
            const float r0 = __builtin_amdgcn_rsqf(s0 * (1.0f / 896.f) + EPS), rk = __builtin_amdgcn_rsqf(sk * (1.0f / 512.f) + EPS);
            const f32x4 ga = *(const f32x4*)gq0, gb = *(const f32x4*)(gq0 + 4), gc = *(const f32x4*)gq1, gd = *(const f32x4*)(gq1 + 4), ge = *(const f32x4*)gkv, gf = *(const f32x4*)(gkv + 4);
#pragma unroll
            for (int q = 0; q < 4; ++q) { x0[q] *= r0 * ga[q]; x0[4 + q] *= r0 * gb[q]; x1[q] *= r0 * gc[q]; x1[4 + q] *= r0 * gd[q]; xk[q] *= rk * ge[q]; xk[4 + q] *= rk * gf[q]; }
            *(u32x4*)(cc + lane * 8) = pack8(x0); if (lane < 48) *(u32x4*)(cc + 512 + lane * 8) = pack8(x1); *(u32x4*)(cc + 896 + lane * 8) = pack8(xk);
        }
    }
}

__device__ __forceinline__ void phase_post2(const Args& a, int l, const int wv0) {
    int tid_ = wv0 * 64 + lane_id(); asm volatile("" : "+v"(tid_)); const int tid = tid_, lane = tid & 63, wv = blockIdx.x * 8 + (tid >> 6);
    const float* gkn = a.in[I_KNNOPE] + l * 128 + (lane & 15) * 8;
    for (int row = wv; row < MTOT; row += GRID * 8) {
        const bf16_t* kv = (const bf16_t*)(a.ws + WS_KVUP) + (size_t)row * 2048 + (lane >> 4) * 256 + (lane & 15) * 8;
        bf16_t* kc = (bf16_t*)(a.ws + WS_KC) + (size_t)row * 1536;
        const u32x4 r0 = *(const u32x4*)kv, r1 = *(const u32x4*)(kv + 1024);
        const u32x4 pe = *(const u32x4*)((const bf16_t*)(a.ws + WS_CC) + (size_t)row * 1536 + 1408 + (lane & 7) * 8);
        const u32x4 o0 = norm_group<16>(r0, gkn, false, gkn, gkn, lane), o1 = norm_group<16>(r1, gkn, false, gkn, gkn, lane);
        *(u32x4*)(kc + (lane >> 4) * 192 + (lane & 15) * 8) = o0; *(u32x4*)(kc + (4 + (lane >> 4)) * 192 + (lane & 15) * 8) = o1;
        *(u32x4*)(kc + (lane >> 3) * 192 + 128 + (lane & 7) * 8) = pe;
    }
}

__device__ __forceinline__ void phase_attn(const Args& a, int l, LAS unsigned char* lds, bool ctx_out, const int wv0) {
    const int c = blockIdx.x, xcd = c & 7, rank = c >> 3;
    const float* bnd = (const float*)(a.ws + WS_BND) + l * 32;
    const float* rope = (const float*)(a.ws + WS_ROPE);
    const bf16_t* QA = (const bf16_t*)(a.ws + WS_QA); const bf16_t* KA = (const bf16_t*)(a.ws + WS_KA); const bf16_t* VA = (const bf16_t*)(a.ws + WS_VA);
    const bf16_t* QB = (const bf16_t*)(a.ws + WS_QB); const bf16_t* KB = (const bf16_t*)(a.ws + WS_KB); const bf16_t* VB = (const bf16_t*)(a.ws + WS_VB);
    const bf16_t* QD = (const bf16_t*)(a.ws + WS_QD); const bf16_t* KD = (const bf16_t*)(a.ws + WS_KD); const bf16_t* VD = (const bf16_t*)(a.ws + WS_VD);
    const bf16_t* QC = (const bf16_t*)(a.ws + WS_QUP); const bf16_t* KC = (const bf16_t*)(a.ws + WS_KC); const bf16_t* VC = (const bf16_t*)(a.ws + WS_KVUP);
    const bf16_t* G4 = (const bf16_t*)(a.ws + WS_G4); bf16_t* Y = (bf16_t*)(a.ws + WS_Y); float* OD = (float*)(a.ws + WS_OD);
    const float li_[4] = {0.2f, 0.35550906759096934f, 0.4707130183435842f, 0.5560582041556406f};
#ifndef ATTK
#define ATTK -1
#endif
    if (ATTK < 0 || ATTK == 0)
    for (int pass = 0; pass < 6; ++pass) {
        const int rnd = pass >> 1, i = pass & 1;
        att::AU u; int b, h; size_t row0;
        if (rnd < 2) { const int bh = xcd + 8 * rnd; b = bh >> 3; h = bh & 7; row0 = (size_t)b * SEQ + rank * 256; u.nlat = 128; u.nt = 132; u.qrope = 1; u.tpos0 = rank * 256; }
        else { if (!ctx_out || c < 48 || c >= 64) break; const int bh = c - 48; b = bh >> 3; h = bh & 7; row0 = (size_t)MLAT + b * CTXL; u.nlat = 0; u.nt = 4; u.qrope = 0; u.tpos0 = 0; }
        const int col = h * 128 + i * 64;
        u.Q = QD + row0 * 1024 + col; u.ldq = 1024;
        u.Kl = KD + (size_t)b * SEQ * 1024 + col; u.Vl = VD + (size_t)b * SEQ * 1024 + h * 128;
        u.Kc = KD + ((size_t)MLAT + b * CTXL) * 1024 + col; u.Vc = VD + ((size_t)MLAT + b * CTXL) * 1024 + h * 128;
        u.ldk = 1024; u.ldv = 1024; u.C = 0.125f * LOG2E; u.MC = bnd[17]; u.sinkL = -1e30f; u.m0 = 0; u.m1 = 0; u.rpb = nullptr;
        u.gq = a.in[I_QND] + l * 64; u.gq2 = nullptr; u.rope = rope;
        u.o0 = OD + row0 * 2048 + h * 256; u.subw = a.in[I_SUBLN] + l * 128; u.lam = bnd[18]; u.om = 1.0f - li_[l];
        if (i == 0) { u.out_mode = 1; u.out = OD + row0 * 2048 + h * 256; u.gate = nullptr; u.ldo = 2048; }
        else { u.out_mode = 2; u.out = Y + row0 * 4096 + 3072 + h * 128; u.gate = G4 + row0 * 4096 + 3072 + h * 128; u.ldo = 4096; }
        att::attn_unit<64, 0>(u, lds, wv0);
    }
    if (ATTK < 0 || ATTK == 1)
    for (int rnd = 0; rnd < 3; ++rnd) {
        att::AU u; int b, h; size_t row0;
        if (rnd < 2) { const int bh = xcd + 8 * rnd; b = bh >> 3; h = bh & 7; row0 = (size_t)b * SEQ + rank * 256; u.nlat = 128; u.nt = 132; u.qrope = 1; u.tpos0 = rank * 256; }
        else { if (!ctx_out || c < 32 || c >= 48) break; const int bh = c - 32; b = bh >> 3; h = bh & 7; row0 = (size_t)MLAT + b * CTXL; u.nlat = 0; u.nt = 4; u.qrope = 0; u.tpos0 = 0; }
        u.Q = QC + row0 * 1536 + h * 192; u.ldq = 1536;
        u.Kl = KC + (size_t)b * SEQ * 1536 + h * 192; u.Vl = VC + (size_t)b * SEQ * 2048 + h * 256 + 128;
        u.Kc = KC + ((size_t)MLAT + b * CTXL) * 1536 + h * 192; u.Vc = VC + ((size_t)MLAT + b * CTXL) * 2048 + h * 256 + 128;
        u.ldk = 1536; u.ldv = 2048; u.C = 0.07216878364870323f * LOG2E; u.MC = bnd[16]; u.sinkL = -1e30f; u.m0 = 0; u.m1 = 0; u.rpb = nullptr;
        u.gq = a.in[I_QNNOPE] + l * 128; u.gq2 = a.in[I_QNPE] + l * 64; u.rope = rope;
        u.o0 = nullptr; u.subw = nullptr; u.lam = 0.f; u.om = 0.f;
        u.out_mode = 0; u.out = Y + row0 * 4096 + 2048 + h * 128; u.gate = G4 + row0 * 4096 + 2048 + h * 128; u.ldo = 4096;
        att::attn_unit<192, 0>(u, lds, wv0);
    }
    if (ATTK < 0 || ATTK >= 2) {
        unsigned* qc = (unsigned*)(a.ws + WS_CTL) + 8192 + l * 128;
        volatile LAS unsigned* misc = (volatile LAS unsigned*)(lds + LDS_MISC);
        const unsigned qlen = ctx_out ? 132u : 128u;
        for (;;) {
            if (wv0 == 0 && lane_id() == 0) {
                unsigned pk = 0xFFFFFFFFu;
                for (int k = 0; k < 8; ++k) { const int x = (xcd + k) & 7; const unsigned v = xb_add(qc + x * 16, 1u); if (v < qlen) { pk = (unsigned)x * 256u + v; break; } }
                misc[8] = pk;
            }
            __syncthreads();
            const unsigned pk = (unsigned)__builtin_amdgcn_readfirstlane((int)misc[8]);
            if (pk == 0xFFFFFFFFu) break;
            const int h = (int)(pk >> 8), id = (int)(pk & 255u);
            att::AU u; size_t row0;
            if (id < 64 || id == 128 || id == 129) {
                int b, kstart = 0, q0 = 0;
                if (id < 64) { b = id >> 5; q0 = (id & 31) * 256; row0 = (size_t)b * SEQ + q0;
                    kstart = q0 - 128 < 0 ? 0 : q0 - 128; const int kend = q0 + 384 > SEQ ? SEQ : q0 + 384; u.nlat = (kend - kstart) >> 6; u.nt = u.nlat + 4; u.qrope = 1; u.tpos0 = q0; }
                else { b = id & 1; row0 = (size_t)MLAT + b * CTXL; u.nlat = 0; u.nt = 4; u.qrope = 0; u.tpos0 = 0; }
                const int kvh = h >> 2;
                u.Q = QA + row0 * 1024 + h * 128; u.ldq = 1024;
                u.Kl = KA + ((size_t)b * SEQ + kstart) * 256 + kvh * 128; u.Vl = VA + ((size_t)b * SEQ + kstart) * 256 + kvh * 128;
                u.Kc = KA + ((size_t)MLAT + b * CTXL) * 256 + kvh * 128; u.Vc = VA + ((size_t)MLAT + b * CTXL) * 256 + kvh * 128;
                u.ldk = 256; u.ldv = 256; u.C = 0.08838834764831845f * LOG2E; u.MC = bnd[h]; u.sinkL = bnd[19 + h]; u.m0 = kstart - q0; u.m1 = 0; u.rpb = nullptr;
                u.gq = a.in[I_QNA] + l * 128; u.gq2 = nullptr; u.rope = rope;
                u.o0 = nullptr; u.subw = nullptr; u.lam = 0.f; u.om = 0.f;
                u.out_mode = 0; u.out = Y + row0 * 4096 + h * 128; u.gate = G4 + row0 * 4096 + h * 128; u.ldo = 4096;
                att::attn_unit<128, 1>(u, lds, wv0);
            } else {
                int b, krow0 = 0, rg = 0;
                if (id < 128) { b = (id - 64) >> 5; rg = id & 31; row0 = (size_t)b * SEQ + rg * 256;
                    krow0 = 4 * rg - 4 < 0 ? 0 : 4 * rg - 4; u.nlat = (rg == 0 || rg == 31) ? 8 : 12; u.nt = u.nlat + 4; }
                else { b = id & 1; row0 = (size_t)MLAT + b * CTXL; u.nlat = 0; u.nt = 4; }
                u.Q = QB + row0 * 1024 + h * 128; u.ldq = 1024;
                u.Kl = KB + ((size_t)b * SEQ + krow0 * 64) * 1024 + h * 128; u.Vl = VB + ((size_t)b * SEQ + krow0 * 64) * 1024 + h * 128;
                u.Kc = KB + ((size_t)MLAT + b * CTXL) * 1024 + h * 128; u.Vc = VB + ((size_t)MLAT + b * CTXL) * 1024 + h * 128;
                u.ldk = 1024; u.ldv = 1024; u.C = 0.08838834764831845f * LOG2E; u.MC = bnd[8 + h]; u.sinkL = -1e30f; u.m0 = 4 * rg; u.m1 = krow0;
                u.rpb = a.in[I_RPB] + ((size_t)l * 8 + h) * 465;
                u.gq = a.in[I_QNB] + l * 128; u.gq2 = nullptr; u.rope = rope; u.qrope = 0; u.tpos0 = 0;
                u.o0 = nullptr; u.subw = nullptr; u.lam = 0.f; u.om = 0.f;
                u.out_mode = 0; u.out = Y + row0 * 4096 + 1024 + h * 128; u.gate = G4 + row0 * 4096 + 1024 + h * 128; u.ldo = 4096;
                att::attn_unit<128, 2>(u, lds, wv0);
            }
        }
    }
}

__device__ __forceinline__ Args load_args(const Args& a) {
#if defined(__HIP_DEVICE_COMPILE__)
    typedef const Args __attribute__((address_space(4)))* KArgsP;
    KArgsP p = (KArgsP)__builtin_amdgcn_kernarg_segment_ptr();
    asm volatile("" : "+s"(p));
    Args b;
#pragma unroll
    for (int i = 0; i < 31; ++i) b.in[i] = p->in[i];
    b.out = p->out; b.ws = p->ws; b.ph_lo = p->ph_lo; b.ph_hi = p->ph_hi;
    return b;
#else
    return a;
#endif
}

constexpr int N_PHASES = 2 + 9 * DEPTH;
__global__ void __launch_bounds__(NTHR, 2) mega_fwd(Args a) {
    extern __shared__ __attribute__((aligned(16))) unsigned char lds_raw[];
    LAS unsigned char* lds = (LAS unsigned char*)lds_raw;
    volatile LAS unsigned* misc = (volatile LAS unsigned*)(lds + LDS_MISC);
    const int wv0 = __builtin_amdgcn_readfirstlane((int)threadIdx.x >> 6);
    if (threadIdx.x < 4) misc[threadIdx.x] = 0u;
    __syncthreads();
    const int lo = a.ph_lo, hi = a.ph_hi;
    XcdBarrier bar; bar.bar = (unsigned*)(a.ws + WS_CTL); bar.x = 0; bar.st = misc;
    if (hi - lo > 1) bar = xcd_barrier_post((unsigned*)(a.ws + WS_CTL), misc, wv0);
#ifndef TESTKIND
#define TESTKIND -1
#endif
#define KIND_OK(kind) (TESTKIND < 0 || TESTKIND == (kind))
#define IN(k) (lo <= (k) && (k) < hi)
#define SEAM(k) do { if (IN((k) + 1)) xcd_barrier(bar, wv0); } while (0)
#ifndef PROBE_K1
#define PROBE_K1 -1
#endif
#ifndef PROBE_K2
#define PROBE_K2 -1
#endif
    unsigned long long pt0 = 0, pacc1 = 0;
#ifndef PROBE_MASK
#define PROBE_MASK 0
#endif
#define PT_BEGIN(kind) do { if ((PROBE_MASK >> (kind)) & 1) pt0 = __builtin_amdgcn_s_memrealtime(); } while (0)
#define PT_END(kind) do { if ((PROBE_MASK >> (kind)) & 1) pacc1 += __builtin_amdgcn_s_memrealtime() - pt0; } while (0)
#define PA() load_args(a)
    if (KIND_OK(0) && IN(0)) { PT_BEGIN(0); phase_pre0(PA(), lds, wv0); SEAM(0); PT_END(0); }
    if (KIND_OK(1) && IN(1)) { PT_BEGIN(1); phase_prologue(PA(), lds, wv0); phase_mods(PA(), wv0); SEAM(1); PT_END(1); }
    for (int l = 0; l < DEPTH; ++l) {
        const Args al = PA(); float* XB = (float*)(al.ws + WS_XBUF);
        const int pb = 2 + 9 * l;
        const bool ctx_out = l < DEPTH - 1;
        const float* xin = l == 0 ? al.in[I_X] : XB;
        const float* cin = l <= 1 ? al.in[I_CTX] : XB + (size_t)MLAT * 4096;
        float* xout = l == DEPTH - 1 ? al.out : XB; float* cout = XB + (size_t)MLAT * 4096;
        if (KIND_OK(2) && IN(pb + 0)) { PT_BEGIN(2); phase_xnorm(PA(), l, xin, cin, cout, wv0); SEAM(pb + 0); PT_END(2); }
        if (KIND_OK(3) && IN(pb + 1)) { PT_BEGIN(3); const Args b = PA();
            { pg8::Gemm g{b.ws + WS_H, (const bf16_t*)(b.ws + WS_WIN) + (size_t)l * NT_BF * 256 * 4096, MTOT, NT_BF * 256, 4096, 8192, 8192};
              pg8::StaticOrder S; S.init(MTOT, NT_BF * 256, (int)gridDim.x, (int)blockIdx.x);
              EpiG1 E{b.ws, 0, nullptr, nullptr}; pg8::NoHook nh;
              pg8::gemm_phase<false>(lds, g, S, E, nh, wv0); }
            { pg8::Gemm g{b.ws + WS_H8, b.ws + WS_W8 + (size_t)l * NT_F8 * 256 * 4096, MTOT, NT_F8 * 256, 4096, 4096, 4096};
              pg8::DynTailOrder S; S.S.init(MTOT, NT_F8 * 256, (int)gridDim.x, (int)blockIdx.x); S.R = 26; S.ctr = (unsigned*)(b.ws + WS_CTL) + 8192 + 512 + l * 128;
              EpiG1 E{b.ws, 1, (const float*)(b.ws + WS_HS), (const float*)(b.ws + WS_WSC) + (size_t)l * NINP}; pg8::NoHook nh;
              pg8::gemm_phase<true>(lds, g, S, E, nh, wv0); }
            SEAM(pb + 1); PT_END(3); }
        if (KIND_OK(4) && IN(pb + 2)) { PT_BEGIN(4); phase_post1(PA(), l, wv0); SEAM(pb + 2); PT_END(4); }
        if (KIND_OK(5) && IN(pb + 3)) { PT_BEGIN(5); const Args b = PA();
            { pg8::Gemm g{(const bf16_t*)(b.ws + WS_CC), (const bf16_t*)(b.ws + WS_WQ) + (size_t)l * 1536 * 896, MTOT, 1536, 896, 1536 * 2, 896 * 2};
              pg8::StaticOrder S; S.init(MTOT, 1536, (int)gridDim.x, (int)blockIdx.x);
              EpiPlain E{(bf16_t*)(b.ws + WS_QUP), 1536}; pg8::NoHook nh;
              pg8::gemm_phase<false>(lds, g, S, E, nh, wv0); }
            { pg8::Gemm g{(const bf16_t*)(b.ws + WS_CC) + 896, (const bf16_t*)(b.ws + WS_WKV) + (size_t)l * 2048 * 512, MTOT, 2048, 512, 1536 * 2, 512 * 2};
              pg8::StaticOrder S; S.init(MTOT, 2048, (int)gridDim.x, (int)((blockIdx.x + 112u) & 255u));
              EpiPlain E{(bf16_t*)(b.ws + WS_KVUP), 2048}; pg8::NoHook nh;
              pg8::gemm_phase<false>(lds, g, S, E, nh, wv0); }
            SEAM(pb + 3); PT_END(5); }
        if (KIND_OK(6) && IN(pb + 4)) { PT_BEGIN(6); phase_post2(PA(), l, wv0); SEAM(pb + 4); PT_END(6); }
        if (KIND_OK(7) && IN(pb + 5)) { PT_BEGIN(7); phase_attn(PA(), l, lds, ctx_out, wv0); SEAM(pb + 5); PT_END(7); }
        if (KIND_OK(9) && IN(pb + 6)) { PT_BEGIN(9); const Args b = PA();
            { pg8::Gemm g{(const bf16_t*)(b.ws + WS_Y), (const bf16_t*)(b.ws + WS_WB) + (size_t)l * 4096 * 4096, MLAT, 4096, 4096, 8192, 8192};
              pg8::StaticOrder S; S.init(MLAT, 4096, (int)gridDim.x, (int)blockIdx.x);
              EpiMerge E{(const bf16_t*)(b.ws + WS_MG), (bf16_t*)(b.ws + WS_MERGED)}; HookMerge hk{(const bf16_t*)(b.ws + WS_MG)};
              pg8::gemm_phase<false>(lds, g, S, E, hk, wv0); }
            if (ctx_out) { pg8::Gemm g{(const bf16_t*)(b.ws + WS_Y), (const bf16_t*)(b.ws + WS_WB) + (size_t)l * 4096 * 4096, MTOT, 4096, 512, 8192, 8192};
              pg8::CtxSplitOrder S{(int)blockIdx.x};
              EpiCtxPart3 E{(const bf16_t*)(b.ws + WS_MG), (float*)(b.ws + WS_P3)}; pg8::NoHook nh;
              pg8::gemm_phase<false>(lds, g, S, E, nh, wv0); }
            SEAM(pb + 6); PT_END(9); }
        if (KIND_OK(10) && IN(pb + 7)) { PT_BEGIN(10); const Args b = PA();
            if (ctx_out) {
                const int tid = wv0 * 64 + lane_id(); const int r = blockIdx.x * 2 + (tid >> 8), c0 = (tid & 255) * 16;
                const float* P3 = (const float*)(b.ws + WS_P3) + (size_t)r * 4096 + c0;
                f32x4 sacc[4];
#pragma unroll
                for (int q = 0; q < 4; ++q) sacc[q] = *(const f32x4*)(P3 + q * 4);
                for (int kc = 1; kc < 8; ++kc)
#pragma unroll
                    for (int q = 0; q < 4; ++q) sacc[q] += *(const f32x4*)(P3 + (size_t)kc * MCTX * 4096 + q * 4);
                u32x4 w0, w1; w0.x = cvt_pk_bf16(sacc[0][0], sacc[0][1]); w0.y = cvt_pk_bf16(sacc[0][2], sacc[0][3]); w0.z = cvt_pk_bf16(sacc[1][0], sacc[1][1]); w0.w = cvt_pk_bf16(sacc[1][2], sacc[1][3]);
                w1.x = cvt_pk_bf16(sacc[2][0], sacc[2][1]); w1.y = cvt_pk_bf16(sacc[2][2], sacc[2][3]); w1.z = cvt_pk_bf16(sacc[3][0], sacc[3][1]); w1.w = cvt_pk_bf16(sacc[3][2], sacc[3][3]);
                bf16_t* mo = (bf16_t*)(b.ws + WS_MERGED) + (size_t)(MLAT + r) * 4096 + c0; *(u32x4*)mo = w0; *(u32x4*)(mo + 8) = w1;
            }
            pg8::Gemm g{(const bf16_t*)(b.ws + WS_MERGED), (const bf16_t*)(b.ws + WS_WO) + (size_t)l * 4096 * 4096, MLAT, 4096, 4096, 8192, 8192};
            pg8::StaticOrder S; S.init(MLAT, 4096, (int)gridDim.x, (int)blockIdx.x);
            EpiResid E{xin, cin, xout, cout, (const float*)(b.ws + WS_MODS) + l * 36864}; pg8::NoHook nh;
            pg8::gemm_phase<false>(lds, g, S, E, nh, wv0);
            if (ctx_out || l + 1 < DEPTH) SEAM(pb + 7); PT_END(10); }
        if (KIND_OK(8) && ctx_out && IN(pb + 8)) { PT_BEGIN(8); const Args b = PA();
            pg8::Gemm g{(const bf16_t*)(b.ws + WS_MERGED), (const bf16_t*)(b.ws + WS_WO) + (size_t)l * 4096 * 4096, MTOT, 4096, 512, 8192, 8192};
            pg8::CtxSplitOrder S{(int)blockIdx.x};
            EpiCtxPart4 E{(float*)(b.ws + WS_P4)}; pg8::NoHook nh;
            pg8::gemm_phase<false>(lds, g, S, E, nh, wv0); SEAM(pb + 8); PT_END(8); }
    }
    if (PROBE_MASK != 0 && blockIdx.x == 0) {
        const unsigned long long t0 = __builtin_amdgcn_s_memrealtime();
        while (__builtin_amdgcn_s_memrealtime() - t0 < pacc1) __builtin_amdgcn_s_sleep(8);
    }
#undef IN
#undef SEAM
#undef PA
}

extern "C" void kernel_launch(void* const* d_in, const int* in_sizes, int n_in, void* d_out, int out_size, void* d_ws, size_t ws_size, hipStream_t stream) {
    static int ready = 0;
    if (ready == 0) {
        if (n_in != 31 || in_sizes[0] != MLAT * DM || out_size != MLAT * DM || ws_size < WS_END) {
            fprintf(stderr, "kernel_launch: shape mismatch: n_in %d in0 %d out %d ws %zu (need >= %zu)\n", n_in, n_in > 0 ? in_sizes[0] : -1, out_size, ws_size, (size_t)WS_END); ready = -1; return; }
        if (hipFuncSetAttribute((const void*)mega_fwd, hipFuncAttributeMaxDynamicSharedMemorySize, LDS_BYTES) != hipSuccess) { fprintf(stderr, "kernel_launch: hipFuncSetAttribute failed\n"); ready = -1; return; }
        int per_cu = 0, dev = 0, cus = 0;
        (void)hipGetDevice(&dev); (void)hipDeviceGetAttribute(&cus, hipDeviceAttributeMultiprocessorCount, dev);
        if (hipOccupancyMaxActiveBlocksPerMultiprocessor(&per_cu, (const void*)mega_fwd, NTHR, LDS_BYTES) != hipSuccess || per_cu < 1 || cus < GRID)
            fprintf(stderr, "kernel_launch: note: occupancy query %d blocks/CU, %d CUs (grid %d needs one resident block per CU)\n", per_cu, cus, GRID);
        (void)hipGetLastError();
        ready = 1;
    }
    if (ready < 0) return;
    (void)hipMemsetAsync((char*)d_ws + WS_CTL, 0, CTL_ZERO_BYTES, stream);
    Args a{};
    for (int i = 0; i < 31; ++i) a.in[i] = (const float*)d_in[i];
    a.out = (float*)d_out; a.ws = (unsigned char*)d_ws;
#if MK_LAUNCH_PER_PHASE
    for (int p = 0; p < N_PHASES; ++p) { a.ph_lo = p; a.ph_hi = p + 1; hipLaunchKernelGGL(mega_fwd, dim3(GRID), dim3(NTHR), LDS_BYTES, stream, a); }
#else
    a.ph_lo = 0; a.ph_hi = N_PHASES;
    hipLaunchKernelGGL(mega_fwd, dim3(GRID), dim3(NTHR), LDS_BYTES, stream, a);
#endif
    const hipError_t le = hipPeekAtLastError();
    if (le != hipSuccess) fprintf(stderr, "kernel_launch: launch failed: %s\n", hipGetErrorName(le));
}
```

```cpp
#include <hip/hip_runtime.h>
#include <cstdio>
#include <cstdint>

#define LAS __attribute__((address_space(3)))
typedef unsigned short bf16_t;
typedef short bf16x8 __attribute__((ext_vector_type(8)));
typedef short s16x4 __attribute__((ext_vector_type(4)));
typedef float f32x2 __attribute__((ext_vector_type(2)));
typedef float f32x4 __attribute__((ext_vector_type(4)));
typedef float f32x16 __attribute__((ext_vector_type(16)));
typedef unsigned u32x2 __attribute__((ext_vector_type(2)));
typedef unsigned u32x4 __attribute__((ext_vector_type(4)));
typedef int i32x4_t __attribute__((ext_vector_type(4)));
typedef int i32x8_t __attribute__((ext_vector_type(8)));

#ifndef MK_LAUNCH_PER_PHASE
#define MK_LAUNCH_PER_PHASE 0
#endif

constexpr int DM = 4096, NBATCH = 2, SEQ = 8192, DEPTH = 4, CTXL = 256, GRIDW = 64;
constexpr int MLAT = NBATCH * SEQ, MCTX = NBATCH * CTXL, MTOT = MLAT + MCTX;
constexpr int NIN = 29632, NINP = 29696;
constexpr float LOG2E = 1.4426950408889634f;
constexpr float EPS = 1e-6f;

constexpr size_t al256(size_t x) { return (x + 255) / 256 * 256; }
constexpr size_t WS_CTL = 0;
constexpr size_t WS_MODS = 65536 + 2 * (((size_t)4 * 29632 * 4 + 255) / 256 * 256);
constexpr size_t WS_MODP = WS_MODS + al256((size_t)4 * 3 * 12288 * 4);
constexpr size_t WS_ROPE = WS_MODP + al256((size_t)4 * 32 * 3 * 12288 * 4);
constexpr size_t WS_BND = WS_ROPE + al256((size_t)(4096 * 2 + 2048 * 2) * 4);
constexpr size_t WS_WIN = WS_BND + 4096;
constexpr int NT_BF = 4, NT_F8 = 112;
constexpr size_t WS_WQ = WS_WIN + (size_t)4 * NT_BF * 256 * 4096 * 2;
constexpr size_t WS_WKV = WS_WQ + (size_t)4 * 1536 * 896 * 2;
constexpr size_t WS_WB = WS_WKV + (size_t)4 * 2048 * 512 * 2;
constexpr size_t WS_WO = WS_WB + (size_t)4 * 4096 * 4096 * 2;
constexpr size_t WS_H = WS_WO + (size_t)4 * 4096 * 4096 * 2;
constexpr size_t WS_QA = WS_H + (size_t)MTOT * 4096 * 2;
constexpr size_t WS_KA = WS_QA + (size_t)MTOT * 1024 * 2;
constexpr size_t WS_VA = WS_KA + (size_t)MTOT * 256 * 2;
constexpr size_t WS_QB = WS_VA + (size_t)MTOT * 256 * 2;
constexpr size_t WS_KB = WS_QB + (size_t)MTOT * 1024 * 2;
constexpr size_t WS_VB = WS_KB + (size_t)MTOT * 1024 * 2;
constexpr size_t WS_CC = WS_VB + (size_t)MTOT * 1024 * 2;
constexpr size_t WS_QD = WS_CC + (size_t)MTOT * 1536 * 2;
constexpr size_t WS_KD = WS_QD + (size_t)MTOT * 1024 * 2;
constexpr size_t WS_VD = WS_KD + (size_t)MTOT * 1024 * 2;
constexpr size_t WS_G4 = WS_VD + (size_t)MTOT * 1024 * 2;
constexpr size_t WS_MG = WS_G4 + (size_t)MTOT * 4096 * 2;
constexpr size_t WS_QUP = WS_MG + (size_t)MTOT * 16384 * 2;
constexpr size_t WS_KVUP = WS_QUP + (size_t)MTOT * 1536 * 2;
constexpr size_t WS_KC = WS_KVUP + (size_t)MTOT * 2048 * 2;
constexpr size_t WS_OD = WS_KC + (size_t)MTOT * 1536 * 2;
constexpr size_t WS_Y = WS_OD + (size_t)MTOT * 2048 * 4;
constexpr size_t WS_MERGED = WS_Y + (size_t)MTOT * 4096 * 2;
constexpr size_t WS_XBUF = WS_MERGED + (size_t)MTOT * 4096 * 2;
constexpr size_t WS_P3 = WS_XBUF + (size_t)MTOT * 4096 * 4;
constexpr size_t WS_P4 = WS_P3 + (size_t)8 * MCTX * 4096 * 4;
constexpr size_t WS_H8 = WS_P4 + (size_t)8 * MCTX * 4096 * 4;
constexpr size_t WS_W8 = WS_H8 + (size_t)MTOT * 4096;
constexpr size_t WS_HS = WS_W8 + (size_t)4 * NT_F8 * 256 * 4096;
constexpr size_t WS_WSC = WS_HS + al256((size_t)MTOT * 4);
constexpr size_t WS_END = WS_WSC + al256((size_t)4 * NINP * 4);
constexpr size_t WS_CMAX = 65536;
constexpr size_t WS_CSQ = WS_CMAX + al256((size_t)4 * NIN * 4);
constexpr int CS_ROWS = 256;
constexpr size_t CTL_ZERO_BYTES = 65536;

__device__ __forceinline__ unsigned cvt_pk_bf16(float lo, float hi) { unsigned r; asm volatile("v_cvt_pk_bf16_f32 %0, %1, %2" : "=v"(r) : "v"(lo), "v"(hi)); return r; }
__device__ __forceinline__ float bf2f(unsigned short b) { return __uint_as_float(((unsigned)b) << 16); }
__device__ __forceinline__ float bflo(unsigned w) { return __uint_as_float(w << 16); }
__device__ __forceinline__ float bfhi(unsigned w) { return __uint_as_float(w & 0xffff0000u); }
__device__ __forceinline__ bf16_t f2bf(float f) { return (bf16_t)(cvt_pk_bf16(f, f) & 0xffffu); }
__device__ __forceinline__ float fast_exp2(float x) { return __builtin_amdgcn_exp2f(x); }
__device__ __forceinline__ float fast_rcp(float x) { return __builtin_amdgcn_rcpf(x); }
__device__ __forceinline__ float silu_f(float v) { return v * fast_rcp(1.0f + fast_exp2(-v * LOG2E)); }
__device__ __forceinline__ float sigm_f(float v) { const float c = fminf(fmaxf(v, -30.f), 30.f); return fast_rcp(1.0f + fast_exp2(-c * LOG2E)); }
__device__ __forceinline__ int lane_id() { int v; asm volatile("v_mbcnt_lo_u32_b32 %0, -1, 0\n\tv_mbcnt_hi_u32_b32 %0, -1, %0" : "=v"(v)); return v; }
template <int M> __device__ __forceinline__ float swz_xor(float v) {
    return __int_as_float(__builtin_amdgcn_ds_swizzle(__float_as_int(v), (M << 10) | 0x1f));
}
__device__ __forceinline__ float half_swap_sum(float v) {
    auto rr = __builtin_amdgcn_permlane32_swap(__float_as_uint(v), __float_as_uint(v), false, false); return __uint_as_float(rr[0]) + __uint_as_float(rr[1]);
}
__device__ __forceinline__ float half_swap_max(float v) {
    auto rr = __builtin_amdgcn_permlane32_swap(__float_as_uint(v), __float_as_uint(v), false, false); return fmaxf(__uint_as_float(rr[0]), __uint_as_float(rr[1]));
}
__device__ __forceinline__ float half_sum(float v) {
    v += swz_xor<16>(v); v += swz_xor<8>(v); v += swz_xor<4>(v); v += swz_xor<2>(v); v += swz_xor<1>(v); return v;
}
__device__ __forceinline__ float wave_sum(float v) { return half_sum(half_swap_sum(v)); }
__device__ __forceinline__ float wave_max(float v) {
    v = half_swap_max(v); v = fmaxf(v, swz_xor<16>(v)); v = fmaxf(v, swz_xor<8>(v)); v = fmaxf(v, swz_xor<4>(v)); v = fmaxf(v, swz_xor<2>(v)); v = fmaxf(v, swz_xor<1>(v)); return v;
}

__device__ __forceinline__ void gld16(u32x4& d, const void* p) { asm volatile("global_load_dwordx4 %0, %1, off" : "=&v"(d) : "v"(p) : "memory"); }
__device__ __forceinline__ void gld16f(f32x4& d, const void* p) { asm volatile("global_load_dwordx4 %0, %1, off" : "=&v"(d) : "v"(p) : "memory"); }
#define GLD_WAIT() do { asm volatile("s_waitcnt vmcnt(0)" ::: "memory"); __builtin_amdgcn_sched_barrier(0); } while (0)

#define XB_TMO      128
#define XB_XCNT(j)  (256  + 64 * (j))
#define XB_XSUB(j)  (1280 + 64 * (j))
#define XB_XGEN(j)  (2304 + 64 * (j))
#define XB_TOP      3328
#define XB_TOPGEN   3392
#define XCD_BAR_WORDS 3456
#define XB_SPIN_CAP (1u << 22)

__device__ __forceinline__ unsigned xb_ld(unsigned* p)              { asm volatile("" : "+v"(p)); return __hip_atomic_load(p, __ATOMIC_RELAXED, __HIP_MEMORY_SCOPE_AGENT); }
__device__ __forceinline__ unsigned xb_add(unsigned* p, unsigned v) { asm volatile("" : "+v"(p), "+v"(v)); return __hip_atomic_fetch_add(p, v, __ATOMIC_RELAXED, __HIP_MEMORY_SCOPE_AGENT); }
__device__ __forceinline__ unsigned xb_xcc_id() { return (unsigned)__builtin_amdgcn_s_getreg((3 << 11) | 20) & 0xFu; }
#define XB_SPIN(cond, bar) do { unsigned _sp = 0; while (cond) { __builtin_amdgcn_s_sleep(1); \
    if ((++_sp & 255u) == 0u) { if (xb_ld(&(bar)[XB_TMO])) break; if (_sp > XB_SPIN_CAP) { (void)xb_add(&(bar)[XB_TMO], 1u); break; } } } } while (0)

struct XcdBarrier { unsigned* bar; unsigned x; volatile LAS unsigned* st; };

__device__ __forceinline__ XcdBarrier xcd_barrier_post(unsigned* bar, volatile LAS unsigned* st, const int wv0) {
    XcdBarrier b; b.bar = bar; b.x = xb_xcc_id(); b.st = st;
    if (wv0 == 0 && lane_id() == 0) (void)xb_add(&bar[XB_XCNT(b.x)], 1u);
    return b;
}
__device__ __forceinline__ void xcd_barrier_complete(unsigned* bar, unsigned x, unsigned& nloc, unsigned& nx) {
    const unsigned G = gridDim.x * gridDim.y * gridDim.z;
    unsigned sum, cnt, mine, sp = 0u;
    for (;;) {
        sum = 0u; cnt = 0u; mine = 0u;
#pragma unroll
        for (unsigned j = 0; j < 16; ++j) { const unsigned c = xb_ld(&bar[XB_XCNT(j)]); sum += c; cnt += (c > 0u) ? 1u : 0u; mine = (j == x) ? c : mine; }
        if (sum == G) break;
        __builtin_amdgcn_s_sleep(1);
        if ((++sp & 255u) == 0u) { if (xb_ld(&bar[XB_TMO])) break; if (sp > XB_SPIN_CAP) { (void)xb_add(&bar[XB_TMO], 1u); break; } }
    }
    nloc = mine > 0u ? mine : 1u; nx = cnt > 0u ? cnt : 1u;
}
__device__ __forceinline__ void xcd_barrier(const XcdBarrier& b, const int wv0) {
    asm volatile("s_waitcnt vmcnt(0)" ::: "memory");
    __syncthreads();
    if (wv0 == 0 && lane_id() == 0) {
        unsigned* bar = b.bar;
        __builtin_amdgcn_s_waitcnt(0);
        unsigned nloc = b.st[0], nx = b.st[1];
        if (nloc == 0u) { xcd_barrier_complete(bar, b.x, nloc, nx); b.st[0] = nloc; b.st[1] = nx; }
        const unsigned old = xb_add(&bar[XB_XSUB(b.x)], 1u);
        const unsigned gen = old / nloc;
        if (old + 1u == (gen + 1u) * nloc) {
            __builtin_amdgcn_fence(__ATOMIC_RELEASE, "agent");
            asm volatile("s_waitcnt vmcnt(0)" ::: "memory");
            const unsigned og = xb_add(&bar[XB_TOP], 1u);
            const unsigned tg = og / nx;
            if (og + 1u == (tg + 1u) * nx) xb_add(&bar[XB_TOPGEN], 1u);
            else XB_SPIN(xb_ld(&bar[XB_TOPGEN]) == tg, bar);
            __builtin_amdgcn_fence(__ATOMIC_ACQUIRE, "agent");
            xb_add(&bar[XB_XGEN(b.x)], 1u);
            asm volatile("s_waitcnt vmcnt(0)" ::: "memory");
        } else {
            XB_SPIN(xb_ld(&bar[XB_XGEN(b.x)]) == gen, bar);
            __builtin_amdgcn_fence(__ATOMIC_ACQUIRE, "agent");
            asm volatile("s_waitcnt vmcnt(0)" ::: "memory");
        }
    }
    __syncthreads();
}

namespace pg8 {
constexpr int BM = 256, BK = 64, HALF = 128, HTB = HALF * BK * 2, STAGE_BYTES = 8 * HTB, NXCD = 8, WGM = 8;
__host__ __device__ __forceinline__ int lds_byte(int r, int c) { const int st = (r >> 4) * 2 + (c >> 5), rr = r & 15, cc = c & 31, ob = rr * 64 + cc * 2; return st * 1024 + (ob ^ (((ob >> 9) & 1) << 5)); }
__host__ __device__ __forceinline__ void stage_rc(int b, int& R, int& C) { const int st = b / 1024, sb = b % 1024, swz = sb ^ (((sb >> 9) & 1) << 5); R = (st >> 1) * 16 + swz / 64; C = (st & 1) * 32 + (swz % 64) / 2; }
__host__ __device__ __forceinline__ int perm32(int rho) { const int n = rho >> 4, i = rho & 15; return 8 * (i >> 2) + 4 * n + (i & 3); }

struct Unit { int pm, pn, kb; };
struct Gemm { const void* A; const void* Bt; int M, N, K, ldaB, ldbB; };

struct StaticOrder {
    static constexpr bool DYN = false;
    int nM, nN, nwg, G, c;
    __device__ void init(int M, int N, int G_, int c_) { nM = M / BM; nN = N / BM; nwg = nM * nN; G = G_; c = c_; }
    __device__ void map(int L, Unit& u) const {
        int wgid = L; { const int q = nwg / NXCD, r = nwg % NXCD, xcd = wgid % NXCD, off = wgid / NXCD; wgid = (xcd < r ? xcd * (q + 1) : r * (q + 1) + (xcd - r) * q) + off; }
        const int nig = WGM * nN, gid = wgid / nig, fm = gid * WGM, gsz = (nM - fm) < WGM ? (nM - fm) : WGM;
        u.pm = fm + ((wgid % nig) % gsz); u.pn = (wgid % nig) / gsz; u.kb = 0;
    }
    __device__ bool next(int i, Unit& u) const { const long L = (long)i * G + c; if (L >= nwg) return false; map((int)L, u); return true; }
};
struct DynTailOrder {
    static constexpr bool DYN = true;
    StaticOrder S; int R; unsigned* ctr;
    __device__ bool next(int i, Unit& u) const { return S.next(i, u); }
    __device__ int claim() const {
        const int x0 = S.c & 7, base = R * S.G;
        for (int k = 0; k < 8; ++k) { const int x = (x0 + k) & 7; const int L = base + 8 * (int)xb_add(ctr + x * 16, 1u) + x; if (L < S.nwg) return L; }
        return -1;
    }
};
struct G1Int8Order {
    static constexpr bool DYN = false;
    StaticOrder S;
    __device__ bool next(int i, Unit& u) const {
        const int c = S.c;
        if (c >= 248 && i >= 27) return false;
        if (i == 28 && c >= 224 && c < 232) { StaticOrder T = S; T.c = c + 24; return T.next(27, u); }
        return S.next(i, u);
    }
};
struct CtxSplitOrder {
    static constexpr bool DYN = false;
    int c;
    __device__ bool next(int i, Unit& u) const { if (i > 0 || c >= 256) return false; u.pm = 64 + (c >> 7); u.pn = (c >> 3) & 15; u.kb = (c & 7) * 512 * 2; return true; }
};
struct NoHook { static constexpr bool ON = false; __device__ __forceinline__ void operator()(f32x4 (&)[2][2][4][2], const Unit&, int, int, int, int, int) const {} };

template <bool F8, class Epi, class Sched, class Hook>
__device__ __forceinline__ void gemm_phase(LAS unsigned char* lds, const Gemm g, const Sched& S, const Epi& E, const Hook& HK, const int wv0) {
    int tid_ = wv0 * 64 + lane_id(); asm volatile("" : "+v"(tid_));
    const int tid = tid_, wid = __builtin_amdgcn_readfirstlane(tid >> 6), lane = tid & 63, wr = wid >> 2, wc = wid & 3, fr = lane & 15, fq = lane >> 4;
    const int K = g.K, nt = F8 ? K / 128 : K / BK;
    unsigned voffA, voffB;
    { int R, C; stage_rc(tid * 16, R, C); const int Rb = Epi::PERM ? ((R & ~31) + perm32(R & 31)) : R;
      voffA = (unsigned)(R * g.ldaB + C * 2); voffB = (unsigned)(Rb * g.ldbB + C * 2); }
    const size_t p1A = (size_t)64 * g.ldaB, p1B = (size_t)64 * g.ldbB;
    const size_t kstep = (size_t)(BK * 2);
    const size_t hstepA = (size_t)HALF * g.ldaB, hstepB = (size_t)HALF * g.ldbB;
    const size_t tstepA = 2 * hstepA, tstepB = 2 * hstepB;
    const unsigned ldsw = (unsigned)wid * 1024u;
    const unsigned ldsbase = (unsigned)(uintptr_t)lds;
    const int aoff = lds_byte(wr * 64 + fr, fq * 8), boff = lds_byte(wc * 32 + fr, fq * 8);
#define PG8_SA(b, h) (((b) * 2 + (h)) * HTB)
#define PG8_SB(b, h) ((4 + (b) * 2 + (h)) * HTB)
#define PG8_STAGE(bufoff, gbase, voff) do { const char* sb_ = (const char*)(gbase); const unsigned ld_ = ldsbase + (unsigned)(bufoff) + ldsw; \
        _Pragma("unroll") for (int _i = 0; _i < 2; ++_i) { unsigned keep_; const char* sbi_ = sb_ + (_i ? voff##_p1 : 0); \
            asm volatile("s_mov_b32 %0, m0\n\ts_mov_b32 m0, %3\n\ts_nop 0\n\tglobal_load_lds_dwordx4 %1, %2\n\ts_mov_b32 m0, %0" : "=&s"(keep_) : "v"(voff), "s"(sbi_), "s"(ld_ + _i * 8192) : "memory"); } } while (0)
#define voffA_p1 p1A
#define voffB_p1 p1B
#define PG8_LDA(dst, b, h) do { _Pragma("unroll") for (int m = 0; m < 4; ++m) _Pragma("unroll") for (int k = 0; k < 2; ++k) dst[m][k] = *(const LAS bf16x8*)(lds + PG8_SA(b, h) + aoff + m * 2048 + k * 1024); } while (0)
#define PG8_LDB(dst, b, h) do { _Pragma("unroll") for (int n = 0; n < 2; ++n) _Pragma("unroll") for (int k = 0; k < 2; ++k) dst[n][k] = *(const LAS bf16x8*)(lds + PG8_SB(b, h) + boff + n * 2048 + k * 1024); } while (0)
#define PG8_MMA(ai, bj, At, Bt) do { __builtin_amdgcn_s_setprio(1); \
        if constexpr (F8) { _Pragma("unroll") for (int m = 0; m < 4; ++m) _Pragma("unroll") for (int n = 0; n < 2; ++n) _Pragma("unroll") for (int k = 0; k < 2; ++k) \
            acc[ai][bj][m][n] = __builtin_bit_cast(f32x4, __builtin_amdgcn_mfma_i32_16x16x64_i8(__builtin_bit_cast(i32x4_t, Bt[n][k]), __builtin_bit_cast(i32x4_t, At[m][k]), __builtin_bit_cast(i32x4_t, acc[ai][bj][m][n]), 0, 0, 0)); } \
        else { _Pragma("unroll") for (int m = 0; m < 4; ++m) _Pragma("unroll") for (int n = 0; n < 2; ++n) _Pragma("unroll") for (int k = 0; k < 2; ++k) \
            acc[ai][bj][m][n] = __builtin_amdgcn_mfma_f32_16x16x32_bf16(Bt[n][k], At[m][k], acc[ai][bj][m][n], 0, 0, 0); } \
        __builtin_amdgcn_s_setprio(0); } while (0)
#define PG8_WAIT_V(n) asm volatile("s_waitcnt vmcnt(" #n ")" ::: "memory")
#define PG8_WAIT_L(n) asm volatile("s_waitcnt lgkmcnt(" #n ")" ::: "memory")
#define PG8_BAR __builtin_amdgcn_s_barrier()
#define PG8_SCHED __builtin_amdgcn_sched_barrier(0)
    Unit cur, nxt; int ui = 0;
    if (!S.next(0, cur)) return;
    f32x4 acc[2][2][4][2];
#pragma unroll
    for (int a = 0; a < 2; ++a)
#pragma unroll
        for (int b = 0; b < 2; ++b)
#pragma unroll
            for (int m = 0; m < 4; ++m)
#pragma unroll
                for (int n = 0; n < 2; ++n) acc[a][b][m][n] = (f32x4){0.f, 0.f, 0.f, 0.f};
    bf16x8 At[4][2], B0[2][2], B1[2][2];
    const char* cA = (const char*)g.A + (size_t)cur.pm * tstepA + cur.kb; const char* cB = (const char*)g.Bt + (size_t)cur.pn * tstepB + cur.kb;
    PG8_STAGE(PG8_SB(0, 0), cB, voffB); PG8_STAGE(PG8_SA(0, 0), cA, voffA); PG8_STAGE(PG8_SB(0, 1), cB + hstepB, voffB); PG8_STAGE(PG8_SA(0, 1), cA + hstepA, voffA);
    if (wr == 1) PG8_BAR;
    PG8_WAIT_V(4); PG8_BAR;
    PG8_STAGE(PG8_SB(1, 0), cB + kstep, voffB); PG8_STAGE(PG8_SA(1, 0), cA + kstep, voffA); PG8_STAGE(PG8_SB(1, 1), cB + hstepB + kstep, voffB);
    PG8_WAIT_V(6); PG8_BAR;
    for (;;) {
        bool has_next = false, dyn_next = false;
        if constexpr (Sched::DYN) { dyn_next = (ui + 1 >= S.R); }
        if (dyn_next) { if constexpr (Sched::DYN) { if (wid == 0 && lane == 0) { *(volatile LAS int*)(lds + (144 * 1024 - 256) + 36) = S.claim(); } } }
        else has_next = S.next(ui + 1, nxt);
        const char* nA = has_next ? (const char*)g.A + (size_t)nxt.pm * tstepA + nxt.kb : cA; const char* nB = has_next ? (const char*)g.Bt + (size_t)nxt.pn * tstepB + nxt.kb : cB;
        for (int t = 0; t < nt; t += 2) {
            const bool last = (t == nt - 2);
            const char* a1 = cA + (size_t)(t + 1) * kstep;
            const char* a2 = last ? nA : cA + (size_t)(t + 2) * kstep; const char* b2 = last ? nB : cB + (size_t)(t + 2) * kstep;
            const char* a3 = a2 + kstep; const char* b3 = b2 + kstep;
            if constexpr (Sched::DYN) { if (dyn_next && t == 2) { const int L_ = __builtin_amdgcn_readfirstlane(*(volatile LAS int*)(lds + (144 * 1024 - 256) + 36));
                has_next = (L_ >= 0); if (has_next) { S.S.map(L_, nxt); nA = (const char*)g.A + (size_t)nxt.pm * tstepA + nxt.kb; nB = (const char*)g.Bt + (size_t)nxt.pn * tstepB + nxt.kb; } } }
            if (Hook::ON) { if (t > 0 && (t & 15) == 0) HK(acc, cur, t >> 4, wr, wc, fr, fq); }
            PG8_LDB(B0, 0, 0); PG8_SCHED; PG8_LDA(At, 0, 0); PG8_STAGE(PG8_SA(1, 1), a1 + hstepA, voffA);
            PG8_WAIT_L(8); PG8_BAR; PG8_WAIT_L(0); PG8_MMA(0, 0, At, B0); PG8_BAR; PG8_SCHED;
            PG8_LDB(B1, 0, 1); PG8_STAGE(PG8_SB(0, 0), b2, voffB);
            PG8_BAR; PG8_WAIT_L(0); PG8_MMA(0, 1, At, B1); PG8_BAR;
            PG8_LDA(At, 0, 1); PG8_STAGE(PG8_SA(0, 0), a2, voffA);
            PG8_BAR; PG8_WAIT_L(0); PG8_MMA(1, 0, At, B0); PG8_BAR; PG8_SCHED;
            PG8_STAGE(PG8_SB(0, 1), b2 + hstepB, voffB);
            PG8_WAIT_V(6); PG8_BAR; PG8_MMA(1, 1, At, B1); PG8_BAR;
            PG8_LDB(B0, 1, 0); PG8_SCHED; PG8_LDA(At, 1, 0); PG8_STAGE(PG8_SA(0, 1), a2 + hstepA, voffA);
            PG8_WAIT_L(8); PG8_BAR; PG8_WAIT_L(0); PG8_MMA(0, 0, At, B0); PG8_BAR; PG8_SCHED;
            PG8_LDB(B1, 1, 1); PG8_STAGE(PG8_SB(1, 0), b3, voffB);
            PG8_BAR; PG8_WAIT_L(0); PG8_MMA(0, 1, At, B1); PG8_BAR;
            PG8_LDA(At, 1, 1); PG8_STAGE(PG8_SA(1, 0), a3, voffA);
            PG8_BAR; PG8_WAIT_L(0); PG8_MMA(1, 0, At, B0); PG8_BAR; PG8_SCHED;
            PG8_STAGE(PG8_SB(1, 1), b3 + hstepB, voffB);
            PG8_WAIT_V(6); PG8_BAR; PG8_MMA(1, 1, At, B1); PG8_BAR;
        }
        E(acc, cur, wr, wc, fr, fq);
        if (!has_next) break;
#pragma unroll
        for (int a = 0; a < 2; ++a)
#pragma unroll
            for (int b = 0; b < 2; ++b)
#pragma unroll
                for (int m = 0; m < 4; ++m)
#pragma unroll
                    for (int n = 0; n < 2; ++n) acc[a][b][m][n] = (f32x4){0.f, 0.f, 0.f, 0.f};
        cur = nxt; cA = nA; cB = nB; ++ui;
    }
    PG8_WAIT_V(0);
    if (wr == 0) PG8_BAR;
    PG8_BAR;
#undef PG8_SA
#undef PG8_SB
#undef PG8_STAGE
#undef voffA_p1
#undef voffB_p1
#undef PG8_LDA
#undef PG8_LDB
#undef PG8_MMA
#undef PG8_WAIT_V
#undef PG8_WAIT_L
#undef PG8_BAR
#undef PG8_SCHED
}
}

__device__ static const unsigned char G1_ISF8[116] = {1,1,1,1,1,1,1,1,1,1,1,1,1,1,1,1,1,1,1,1,1,1,1,1,1,1,1,1,1,1,1,1,1,1,1,1,1,1,1,1,1,1,1,1,1,1,1,1,0,0,0,0,1,1,1,1,1,1,1,1,1,1,1,1,1,1,1,1,1,1,1,1,1,1,1,1,1,1,1,1,1,1,1,1,1,1,1,1,1,1,1,1,1,1,1,1,1,1,1,1,1,1,1,1,1,1,1,1,1,1,1,1,1,1,1,1};
__device__ static const unsigned char G1_LOCAL[116] = {0,1,2,3,4,5,6,7,8,9,10,11,12,13,14,15,16,17,18,19,20,21,22,23,24,25,26,27,28,29,30,31,32,33,34,35,36,37,38,39,40,41,42,43,44,45,46,47,0,1,2,3,48,49,50,51,52,53,54,55,56,57,58,59,60,61,62,63,64,65,66,67,68,69,70,71,72,73,74,75,76,77,78,79,80,81,82,83,84,85,86,87,88,89,90,91,92,93,94,95,96,97,98,99,100,101,102,103,104,105,106,107,108,109,110,111};
__device__ static const unsigned char G1_BF_LIST[4] = {48,49,50,51};
__device__ static const unsigned char G1_F8_LIST[112] = {0,1,2,3,4,5,6,7,8,9,10,11,12,13,14,15,16,17,18,19,20,21,22,23,24,25,26,27,28,29,30,31,32,33,34,35,36,37,38,39,40,41,42,43,44,45,46,47,52,53,54,55,56,57,58,59,60,61,62,63,64,65,66,67,68,69,70,71,72,73,74,75,76,77,78,79,80,81,82,83,84,85,86,87,88,89,90,91,92,93,94,95,96,97,98,99,100,101,102,103,104,105,106,107,108,109,110,111,112,113,114,115};
__device__ __forceinline__ int g1_global_bf(int lp) { return G1_BF_LIST[lp]; }
__device__ __forceinline__ int g1_global_f8(int lp) { return G1_F8_LIST[lp]; }
__device__ __forceinline__ void g1_dest(unsigned char* ws, int pn, bf16_t*& base, int& ld, int& col, int& act) {
    act = 0;
    if (pn < 4)        { base = (bf16_t*)(ws + WS_QA); ld = 1024; col = pn * 256; }
    else if (pn == 4)  { base = (bf16_t*)(ws + WS_KA); ld = 256;  col = 0; }
    else if (pn == 5)  { base = (bf16_t*)(ws + WS_VA); ld = 256;  col = 0; }
    else if (pn < 10)  { base = (bf16_t*)(ws + WS_G4); ld = 4096; col = (pn - 6) * 256; act = 1; }
    else if (pn < 14)  { base = (bf16_t*)(ws + WS_QB); ld = 1024; col = (pn - 10) * 256; }
    else if (pn < 18)  { base = (bf16_t*)(ws + WS_KB); ld = 1024; col = (pn - 14) * 256; }
    else if (pn < 22)  { base = (bf16_t*)(ws + WS_VB); ld = 1024; col = (pn - 18) * 256; }
    else if (pn < 26)  { base = (bf16_t*)(ws + WS_G4); ld = 4096; col = 1024 + (pn - 22) * 256; act = 1; }
    else if (pn < 32)  { base = (bf16_t*)(ws + WS_CC); ld = 1536; col = (pn - 26) * 256; }
    else if (pn < 36)  { base = (bf16_t*)(ws + WS_G4); ld = 4096; col = 2048 + (pn - 32) * 256; act = 1; }
    else if (pn < 40)  { base = (bf16_t*)(ws + WS_QD); ld = 1024; col = (pn - 36) * 256; }
    else if (pn < 44)  { base = (bf16_t*)(ws + WS_KD); ld = 1024; col = (pn - 40) * 256; }
    else if (pn < 48)  { base = (bf16_t*)(ws + WS_VD); ld = 1024; col = (pn - 44) * 256; }
    else if (pn < 52)  { base = (bf16_t*)(ws + WS_G4); ld = 4096; col = 3072 + (pn - 48) * 256; act = 1; }
    else               { base = (bf16_t*)(ws + WS_MG); ld = 16384; col = (pn - 52) * 256; act = 2; }
}
struct EpiG1 {
    static constexpr bool PERM = true;
    unsigned char* ws; int f8; const float* hs; const float* wsc;
    __device__ __forceinline__ void operator()(const f32x4 (&acc)[2][2][4][2], const pg8::Unit& u, int wr, int wc, int fr, int fq) const {
        unsigned char* wsl = ws; asm volatile("" : "+s"(wsl));
        const int gpn = f8 ? (u.pn < 48 ? u.pn : u.pn + 4) : 48 + u.pn;
        bf16_t* base; int ld, col, act; g1_dest(wsl, gpn, base, ld, col, act);
        const int row0 = u.pm * 256 + wr * 64 + fr, col0 = col + wc * 32 + 8 * fq;
        f32x4 cs[2][2];
        float rs8[2][4];
        if (f8) {
#pragma unroll
            for (int bj = 0; bj < 2; ++bj) { const float* wp = wsc + gpn * 256 + bj * 128 + wc * 32 + 8 * fq; gld16f(cs[bj][0], wp); gld16f(cs[bj][1], wp + 4); }
#pragma unroll
            for (int ai = 0; ai < 2; ++ai)
#pragma unroll
                for (int m = 0; m < 4; ++m) asm volatile("global_load_dword %0, %1, off" : "=&v"(rs8[ai][m]) : "v"(hs + row0 + ai * 128 + m * 16) : "memory");
            GLD_WAIT();
            if (act == 2) {
#pragma unroll
                for (int bj = 0; bj < 2; ++bj) { cs[bj][0] *= -LOG2E; cs[bj][1] *= -LOG2E; } }
        } else {
#pragma unroll
            for (int ai = 0; ai < 2; ++ai)
#pragma unroll
                for (int m = 0; m < 4; ++m) rs8[ai][m] = 1.0f;
        }
#pragma unroll
        for (int ai = 0; ai < 2; ++ai)
#pragma unroll
            for (int m = 0; m < 4; ++m) { const int row = row0 + ai * 128 + m * 16; bf16_t* rowp = base + (size_t)row * ld + col0;
                const float rsc = rs8[ai][m];
#pragma unroll
                for (int bj = 0; bj < 2; ++bj) { f32x4 v0 = acc[ai][bj][m][0], v1 = acc[ai][bj][m][1];
                    if (f8 && act == 2) {
#pragma unroll
                        for (int j = 0; j < 4; ++j) { v0[j] = fast_rcp(1.0f + fast_exp2((float)__float_as_int(v0[j]) * (rsc * cs[bj][0][j]))); v1[j] = fast_rcp(1.0f + fast_exp2((float)__float_as_int(v1[j]) * (rsc * cs[bj][1][j]))); } }
                    else {
                    if (f8) {
#pragma unroll
                        for (int j = 0; j < 4; ++j) { v0[j] = (float)__float_as_int(v0[j]) * (rsc * cs[bj][0][j]); v1[j] = (float)__float_as_int(v1[j]) * (rsc * cs[bj][1][j]); } }
                    if (act == 1) {
#pragma unroll
                        for (int j = 0; j < 4; ++j) { v0[j] = silu_f(v0[j]); v1[j] = silu_f(v1[j]); } }
                    else if (act == 2) {
#pragma unroll
                        for (int j = 0; j < 4; ++j) { v0[j] = sigm_f(v0[j]); v1[j] = sigm_f(v1[j]); } }
                    }
                    u32x4 w; w.x = cvt_pk_bf16(v0[0], v0[1]); w.y = cvt_pk_bf16(v0[2], v0[3]); w.z = cvt_pk_bf16(v1[0], v1[1]); w.w = cvt_pk_bf16(v1[2], v1[3]);
                    *(u32x4*)(rowp + bj * 128) = w; }
                asm volatile("" ::: "memory"); }
    }
};
struct EpiPlain {
    static constexpr bool PERM = true;
    bf16_t* O; int ld;
    __device__ __forceinline__ void operator()(const f32x4 (&acc)[2][2][4][2], const pg8::Unit& u, int wr, int wc, int fr, int fq) const {
        const int row0 = u.pm * 256 + wr * 64 + fr, col0 = u.pn * 256 + wc * 32 + 8 * fq;
#pragma unroll
        for (int ai = 0; ai < 2; ++ai)
#pragma unroll
            for (int m = 0; m < 4; ++m) { bf16_t* rowp = O + (size_t)(row0 + ai * 128 + m * 16) * ld + col0;
#pragma unroll
                for (int bj = 0; bj < 2; ++bj) { const f32x4 v0 = acc[ai][bj][m][0], v1 = acc[ai][bj][m][1];
                    u32x4 w; w.x = cvt_pk_bf16(v0[0], v0[1]); w.y = cvt_pk_bf16(v0[2], v0[3]); w.z = cvt_pk_bf16(v1[0], v1[1]); w.w = cvt_pk_bf16(v1[2], v1[3]);
                    *(u32x4*)(rowp + bj * 128) = w; } }
    }
};
struct HookMerge {
    static constexpr bool ON = true;
    const bf16_t* MG;
    __device__ __forceinline__ void operator()(f32x4 (&acc)[2][2][4][2], const pg8::Unit& u, int seg, int wr, int wc, int fr, int fq) const {
        const int row0 = u.pm * 256 + wr * 64 + fr, col0 = u.pn * 256 + wc * 32 + 8 * fq;
        u32x4 spA[2][2], snA[2][2], spB[2][2], snB[2][2];
#define HK_LOAD(SP, SN, AI, M0) do { _Pragma("unroll") for (int mm = 0; mm < 2; ++mm) { const bf16_t* rowp = MG + (size_t)(row0 + (AI) * 128 + ((M0) + mm) * 16) * 16384 + col0; \
            _Pragma("unroll") for (int bj = 0; bj < 2; ++bj) { gld16(SP[mm][bj], rowp + (seg - 1) * 4096 + bj * 128); gld16(SN[mm][bj], rowp + seg * 4096 + bj * 128); } } } while (0)
#define HK_COMP(SP, SN, AI, M0) do { _Pragma("unroll") for (int mm = 0; mm < 2; ++mm) _Pragma("unroll") for (int bj = 0; bj < 2; ++bj) { const u32x4 p = SP[mm][bj], n = SN[mm][bj]; \
            f32x4 r0, r1; \
            r0[0] = bflo(p.x) * fast_rcp(bflo(n.x)); r0[1] = bfhi(p.x) * fast_rcp(bfhi(n.x)); \
            r0[2] = bflo(p.y) * fast_rcp(bflo(n.y)); r0[3] = bfhi(p.y) * fast_rcp(bfhi(n.y)); \
            r1[0] = bflo(p.z) * fast_rcp(bflo(n.z)); r1[1] = bfhi(p.z) * fast_rcp(bfhi(n.z)); \
            r1[2] = bflo(p.w) * fast_rcp(bflo(n.w)); r1[3] = bfhi(p.w) * fast_rcp(bfhi(n.w)); \
            acc[AI][bj][(M0) + mm][0] *= r0; acc[AI][bj][(M0) + mm][1] *= r1; } } while (0)
#define HK_WAIT(N) do { asm volatile("s_waitcnt vmcnt(" #N ")" ::: "memory"); __builtin_amdgcn_sched_barrier(0); } while (0)
        HK_LOAD(spA, snA, 0, 0); HK_LOAD(spB, snB, 0, 2);
        HK_WAIT(8); HK_COMP(spA, snA, 0, 0); __builtin_amdgcn_sched_barrier(0); HK_LOAD(spA, snA, 1, 0);
        HK_WAIT(8); HK_COMP(spB, snB, 0, 2); __builtin_amdgcn_sched_barrier(0); HK_LOAD(spB, snB, 1, 2);
        HK_WAIT(8); HK_COMP(spA, snA, 1, 0);
        HK_WAIT(0); HK_COMP(spB, snB, 1, 2);
#undef HK_LOAD
#undef HK_COMP
#undef HK_WAIT
    }
};
struct EpiMerge {
    static constexpr bool PERM = true;
    const bf16_t* MG; bf16_t* O;
    __device__ __forceinline__ void operator()(const f32x4 (&acc)[2][2][4][2], const pg8::Unit& u, int wr, int wc, int fr, int fq) const {
        const int row0 = u.pm * 256 + wr * 64 + fr, col0 = u.pn * 256 + wc * 32 + 8 * fq;
        u32x4 sg[2][4][2];
#pragma unroll
        for (int ai = 0; ai < 2; ++ai)
#pragma unroll
            for (int m = 0; m < 4; ++m)
#pragma unroll
                for (int bj = 0; bj < 2; ++bj) sg[ai][m][bj] = *(const u32x4*)(MG + (size_t)(row0 + ai * 128 + m * 16) * 16384 + 3 * 4096 + col0 + bj * 128);
#pragma unroll
        for (int ai = 0; ai < 2; ++ai)
#pragma unroll
            for (int m = 0; m < 4; ++m) { const size_t row = (size_t)(row0 + ai * 128 + m * 16);
#pragma unroll
                for (int bj = 0; bj < 2; ++bj) { const u32x4 sv = sg[ai][m][bj];
                    const f32x4 v0 = acc[ai][bj][m][0], v1 = acc[ai][bj][m][1];
                    u32x4 w; w.x = cvt_pk_bf16(v0[0] * bflo(sv.x), v0[1] * bfhi(sv.x)); w.y = cvt_pk_bf16(v0[2] * bflo(sv.y), v0[3] * bfhi(sv.y));
                    w.z = cvt_pk_bf16(v1[0] * bflo(sv.z), v1[1] * bfhi(sv.z)); w.w = cvt_pk_bf16(v1[2] * bflo(sv.w), v1[3] * bfhi(sv.w));
                    *(u32x4*)(O + row * 4096 + col0 + bj * 128) = w; } }
    }
};
struct EpiCtxPart3 {
    static constexpr bool PERM = true;
    const bf16_t* MG; float* P;
    __device__ __forceinline__ void operator()(const f32x4 (&acc)[2][2][4][2], const pg8::Unit& u, int wr, int wc, int fr, int fq) const {
        const int kc = u.kb >> 10, br = kc >> 1;
        const int row0 = u.pm * 256 + wr * 64 + fr, col0 = u.pn * 256 + wc * 32 + 8 * fq;
        u32x4 sg[2][4][2];
#pragma unroll
        for (int ai = 0; ai < 2; ++ai)
#pragma unroll
            for (int m = 0; m < 4; ++m)
#pragma unroll
                for (int bj = 0; bj < 2; ++bj) sg[ai][m][bj] = *(const u32x4*)(MG + (size_t)(row0 + ai * 128 + m * 16) * 16384 + br * 4096 + col0 + bj * 128);
        float* Pk = P + (size_t)kc * MCTX * 4096;
#pragma unroll
        for (int ai = 0; ai < 2; ++ai)
#pragma unroll
            for (int m = 0; m < 4; ++m) { const size_t rowc = (size_t)(row0 + ai * 128 + m * 16 - MLAT);
#pragma unroll
                for (int bj = 0; bj < 2; ++bj) { const u32x4 sv = sg[ai][m][bj]; const f32x4 v0 = acc[ai][bj][m][0], v1 = acc[ai][bj][m][1];
                    f32x4 o0, o1; o0[0] = v0[0] * bflo(sv.x); o0[1] = v0[1] * bfhi(sv.x); o0[2] = v0[2] * bflo(sv.y); o0[3] = v0[3] * bfhi(sv.y);
                    o1[0] = v1[0] * bflo(sv.z); o1[1] = v1[1] * bfhi(sv.z); o1[2] = v1[2] * bflo(sv.w); o1[3] = v1[3] * bfhi(sv.w);
                    *(f32x4*)(Pk + rowc * 4096 + col0 + bj * 128) = o0; *(f32x4*)(Pk + rowc * 4096 + col0 + bj * 128 + 4) = o1; } }
    }
};
struct EpiCtxPart4 {
    static constexpr bool PERM = true;
    float* P;
    __device__ __forceinline__ void operator()(const f32x4 (&acc)[2][2][4][2], const pg8::Unit& u, int wr, int wc, int fr, int fq) const {
        const int kc = u.kb >> 10;
        const int row0 = u.pm * 256 + wr * 64 + fr - MLAT, col0 = u.pn * 256 + wc * 32 + 8 * fq;
        float* Pk = P + (size_t)kc * MCTX * 4096;
#pragma unroll
        for (int ai = 0; ai < 2; ++ai)
#pragma unroll
            for (int m = 0; m < 4; ++m) { const size_t rowc = (size_t)(row0 + ai * 128 + m * 16);
#pragma unroll
                for (int bj = 0; bj < 2; ++bj) { *(f32x4*)(Pk + rowc * 4096 + col0 + bj * 128) = acc[ai][bj][m][0]; *(f32x4*)(Pk + rowc * 4096 + col0 + bj * 128 + 4) = acc[ai][bj][m][1]; } }
    }
};
struct EpiResid {
    static constexpr bool PERM = false;
    const float* xin; const float* cin; float* xout; float* cout; const float* mods;
    __device__ __forceinline__ void operator()(const f32x4 (&acc)[2][2][4][2], const pg8::Unit& u, int wr, int wc, int fr, int fq) const {
        const int j = u.pm < 32 ? 0 : (u.pm < 64 ? 1 : 2);
        const int rloc = (u.pm < 64 ? u.pm * 256 : (u.pm - 64) * 256) + wr * 64 + fr, col0 = u.pn * 256 + wc * 32 + 4 * fq;
        const float* bi = u.pm < 64 ? xin : cin; float* bo = u.pm < 64 ? xout : cout;
        const float* gt = mods + j * 12288 + 8192 + col0;
        f32x4 gv[2][2];
#pragma unroll
        for (int bj = 0; bj < 2; ++bj)
#pragma unroll
            for (int n = 0; n < 2; ++n) gv[bj][n] = *(const f32x4*)(gt + bj * 128 + n * 16);
#pragma unroll
        for (int ai = 0; ai < 2; ++ai) {
            f32x4 rb[4][2][2];
#pragma unroll
            for (int m = 0; m < 4; ++m) { const size_t off = (size_t)(rloc + ai * 128 + m * 16) * 4096 + col0;
#pragma unroll
                for (int bj = 0; bj < 2; ++bj)
#pragma unroll
                    for (int n = 0; n < 2; ++n) gld16f(rb[m][bj][n], bi + off + bj * 128 + n * 16); }
            GLD_WAIT();
#pragma unroll
            for (int m = 0; m < 4; ++m) { const size_t off = (size_t)(rloc + ai * 128 + m * 16) * 4096 + col0;
#pragma unroll
                for (int bj = 0; bj < 2; ++bj)
#pragma unroll
                    for (int n = 0; n < 2; ++n) *(f32x4*)(bo + off + bj * 128 + n * 16) = rb[m][bj][n] + gv[bj][n] * acc[ai][bj][m][n]; }
            asm volatile("" ::: "memory"); }
    }
};

namespace att {
#define SBAR() __builtin_amdgcn_sched_barrier(0)
__device__ __forceinline__ int crowc(int r) { return (r & 3) + 8 * (r >> 2); }
template <int DQK> __device__ __forceinline__ int kaddr(int row, int g) {
    const int r = row & 31;
    if (DQK == 128) { const int f = (r & 7) | ((r >> 1) & 8); return row * 256 + ((g ^ f) << 4); }
    else { const int s = ((r >> 1) & 3) | ((r >> 2) & 4); return row * (DQK * 2) + ((g ^ s) << 4); }
}
__device__ __forceinline__ int v_st(int k, int c) { const int kk = (k & ~0xC) | ((k & 4) << 1) | ((k & 8) >> 1); return ((kk >> 3) * 4 + (c >> 5)) * 512 + ((kk & 7) * 32 + (c & 31)) * 2; }
__device__ __forceinline__ int v_rd_base(int lane) { return ((lane & 3) << 3) | (((lane >> 2) & 3) << 6) | (((lane >> 4) & 1) << 5) | (((lane >> 5) & 1) << 8); }
constexpr int v_rd_off(int d0, int ks, int half) { return d0 * 512 + ks * 4096 + half * 2048; }
template <int OFF> __device__ __forceinline__ s16x4 tr_read(int vb) {
    s16x4 r; asm volatile("ds_read_b64_tr_b16 %0, %1 offset:%2" : "=&v"(r) : "v"(vb), "i"(OFF) : "memory"); return r;
}
template <int D0> __device__ __forceinline__ void pv_one(f32x16& od, int vb, bf16x8 pa0, bf16x8 pa1, bf16x8 pa2, bf16x8 pa3) {
    const s16x4 l0 = tr_read<v_rd_off(D0, 0, 0)>(vb), h0 = tr_read<v_rd_off(D0, 0, 1)>(vb), l1 = tr_read<v_rd_off(D0, 1, 0)>(vb), h1 = tr_read<v_rd_off(D0, 1, 1)>(vb);
    const s16x4 l2 = tr_read<v_rd_off(D0, 2, 0)>(vb), h2 = tr_read<v_rd_off(D0, 2, 1)>(vb), l3 = tr_read<v_rd_off(D0, 3, 0)>(vb), h3 = tr_read<v_rd_off(D0, 3, 1)>(vb);
    asm volatile("s_waitcnt lgkmcnt(0)" ::: "memory"); SBAR();
#define PK(L, H) (bf16x8){L[0], L[1], L[2], L[3], H[0], H[1], H[2], H[3]}
    od = __builtin_amdgcn_mfma_f32_32x32x16_bf16(pa0, PK(l0, h0), od, 0, 0, 0);
    od = __builtin_amdgcn_mfma_f32_32x32x16_bf16(pa1, PK(l1, h1), od, 0, 0, 0);
    od = __builtin_amdgcn_mfma_f32_32x32x16_bf16(pa2, PK(l2, h2), od, 0, 0, 0);
    od = __builtin_amdgcn_mfma_f32_32x32x16_bf16(pa3, PK(l3, h3), od, 0, 0, 0);
#undef PK
}
__device__ __forceinline__ void pv_d0(f32x16* o, int vb, bf16x8 pa0, bf16x8 pa1, bf16x8 pa2, bf16x8 pa3) {
    pv_one<0>(o[0], vb, pa0, pa1, pa2, pa3); pv_one<1>(o[1], vb, pa0, pa1, pa2, pa3); pv_one<2>(o[2], vb, pa0, pa1, pa2, pa3); pv_one<3>(o[3], vb, pa0, pa1, pa2, pa3);
}

constexpr int V_BYTES = 64 * 128 * 2;
template <int DQK> constexpr int k_bytes() { return 64 * DQK * 2; }
template <int DQK> constexpr int ring_k() { return DQK == 192 ? 3 : 4; }
template <int DQK> constexpr int ring_v() { return 4; }
template <int DQK> constexpr int off_k() { return ring_v<DQK>() * V_BYTES; }
template <int DQK> constexpr int off_li() { return off_k<DQK>() + ring_k<DQK>() * k_bytes<DQK>(); }
template <int DQK> constexpr int off_bias() { return off_li<DQK>() + 1024; }
constexpr int BIAS_SLACK = 256;
constexpr int ATT_LDS_MAX = 4 * V_BYTES + 3 * 64 * 192 * 2 + 1024 + 256 + 15 * 32 * 4 + 512;

struct AU {
    const bf16_t* Q;  int ldq;
    const bf16_t* Kl; const bf16_t* Vl;
    const bf16_t* Kc; const bf16_t* Vc;
    int ldk, ldv, nlat, nt;
    float C, MC, sinkL;
    int m0, m1;
    const float* rpb;
    const float* gq; const float* gq2;
    const float* rope; int qrope, tpos0;
    int out_mode;
    void* out; const bf16_t* gate; int ldo;
    const float* o0; const float* subw; float lam, om;
};

template <int DQK, int MODE>
__device__ __forceinline__ void attn_unit(const AU& u, LAS unsigned char* lds, const int wv0) {
    constexpr int NQ = DQK / 16, KB = k_bytes<DQK>(), NKP = DQK / 64, GPR = DQK / 8;
    int tid_ = wv0 * 64 + lane_id(); asm volatile("" : "+v"(tid_));
    const int tid = tid_, wid = __builtin_amdgcn_readfirstlane(tid >> 6), lane = tid & 63, r32 = lane & 31, hi = lane >> 5;
    constexpr int SK = ring_k<DQK>(), SV = ring_v<DQK>(), G_ = NKP + 2;
    LAS unsigned char* V_lds = lds; LAS unsigned char* K_lds = lds + off_k<DQK>();
    LAS float* li_l = (LAS float*)(lds + off_li<DQK>()) + wid * 32;
    LAS float* biasL = (LAS float*)(lds + off_bias<DQK>() + BIAS_SLACK);
    __syncthreads();
    if (MODE == 2) { if (tid < 480) { const int dr = tid >> 5, dc = tid & 31; biasL[tid] = dc < 31 ? u.rpb[dr * 31 + dc] * LOG2E - u.MC : 0.f; } }
    f32x16 o[4];
#pragma unroll
    for (int d = 0; d < 4; ++d)
#pragma unroll
        for (int r = 0; r < 16; ++r) o[d][r] = 0.f;
    float l_part = 0.f;
    bf16x8 qr[NQ];
    {
        constexpr int NQ1 = (DQK == 192) ? 8 : NQ;
        const bf16_t* Qw = u.Q + (size_t)(wid * 32 + r32) * u.ldq + hi * 8;
        u32x4 raw[NQ];
#pragma unroll
        for (int d0 = 0; d0 < NQ; ++d0) raw[d0] = *(const u32x4*)(Qw + d0 * 16);
        float qf[NQ][8];
#pragma unroll
        for (int d0 = 0; d0 < NQ; ++d0) { qf[d0][0] = bflo(raw[d0].x); qf[d0][1] = bfhi(raw[d0].x); qf[d0][2] = bflo(raw[d0].y); qf[d0][3] = bfhi(raw[d0].y);
            qf[d0][4] = bflo(raw[d0].z); qf[d0][5] = bfhi(raw[d0].z); qf[d0][6] = bflo(raw[d0].w); qf[d0][7] = bfhi(raw[d0].w); }
        float ss = 0.f;
#pragma unroll
        for (int d0 = 0; d0 < NQ1; ++d0)
#pragma unroll
            for (int q = 0; q < 8; ++q) ss += qf[d0][q] * qf[d0][q];
        ss = half_swap_sum(ss);
        const float qsc = (MODE == 0) ? u.C : 1.0f;
        const float rs = __builtin_amdgcn_rsqf(ss * (1.0f / (NQ1 * 16)) + EPS) * qsc;
#pragma unroll
        for (int d0 = 0; d0 < NQ1; ++d0) { const f32x4 g0 = *(const f32x4*)(u.gq + d0 * 16 + hi * 8), g1 = *(const f32x4*)(u.gq + d0 * 16 + hi * 8 + 4);
#pragma unroll
            for (int q = 0; q < 4; ++q) { qf[d0][q] *= rs * g0[q]; qf[d0][4 + q] *= rs * g1[q]; } }
        if constexpr (DQK == 192) {
            float s2 = 0.f;
#pragma unroll
            for (int d0 = 8; d0 < 12; ++d0)
#pragma unroll
                for (int q = 0; q < 8; ++q) s2 += qf[d0][q] * qf[d0][q];
            s2 = half_swap_sum(s2);
            const float rs2 = __builtin_amdgcn_rsqf(s2 * (1.0f / 64.f) + EPS) * qsc;
#pragma unroll
            for (int d0 = 8; d0 < 12; ++d0) { const f32x4 g0 = *(const f32x4*)(u.gq2 + (d0 - 8) * 16 + hi * 8), g1 = *(const f32x4*)(u.gq2 + (d0 - 8) * 16 + hi * 8 + 4);
#pragma unroll
                for (int q = 0; q < 4; ++q) { qf[d0][q] *= rs2 * g0[q]; qf[d0][4 + q] *= rs2 * g1[q]; } }
        }
        if (u.qrope) {
            const int tpos = u.tpos0 + wid * 32 + r32, grow = tpos >> 6, gcol = tpos & 63;
            if constexpr (DQK == 128) {
                const float* ct = u.rope; const float* st = u.rope + 4096;
#pragma unroll
                for (int d0 = 0; d0 < 4; ++d0) { const int idx = (d0 < 2 ? grow : gcol) * 32 + (d0 & 1) * 16 + hi * 8;
                    const f32x4 c0 = *(const f32x4*)(ct + idx), c1 = *(const f32x4*)(ct + idx + 4), s0 = *(const f32x4*)(st + idx), s1 = *(const f32x4*)(st + idx + 4);
#pragma unroll
                    for (int q = 0; q < 8; ++q) { const float c = q < 4 ? c0[q & 3] : c1[q & 3], sn = q < 4 ? s0[q & 3] : s1[q & 3]; const float x1 = qf[d0][q], x2 = qf[d0 + 4][q];
                        qf[d0][q] = x1 * c - x2 * sn; qf[d0 + 4][q] = x2 * c + x1 * sn; } }
            } else {
                constexpr int B0 = (DQK == 192) ? 8 : 0;
                const float* ct = u.rope + 8192; const float* st = u.rope + 8192 + 2048;
#pragma unroll
                for (int d0 = 0; d0 < 2; ++d0) { const int idx = (d0 == 0 ? grow : gcol) * 16 + hi * 8;
                    const f32x4 c0 = *(const f32x4*)(ct + idx), c1 = *(const f32x4*)(ct + idx + 4), s0 = *(const f32x4*)(st + idx), s1 = *(const f32x4*)(st + idx + 4);
#pragma unroll
                    for (int q = 0; q < 8; ++q) { const float c = q < 4 ? c0[q & 3] : c1[q & 3], sn = q < 4 ? s0[q & 3] : s1[q & 3]; const float x1 = qf[B0 + d0][q], x2 = qf[B0 + d0 + 2][q];
                        qf[B0 + d0][q] = x1 * c - x2 * sn; qf[B0 + d0 + 2][q] = x2 * c + x1 * sn; } }
            }
        }
#pragma unroll
        for (int d0 = 0; d0 < NQ; ++d0) { u32x4 w; w.x = cvt_pk_bf16(qf[d0][0], qf[d0][1]); w.y = cvt_pk_bf16(qf[d0][2], qf[d0][3]); w.z = cvt_pk_bf16(qf[d0][4], qf[d0][5]); w.w = cvt_pk_bf16(qf[d0][6], qf[d0][7]);
            qr[d0] = *reinterpret_cast<bf16x8*>(&w); }
    }
    int kgo[NKP], vgo[2];
#pragma unroll
    for (int p = 0; p < NKP; ++p) { const int pos = (wid + 8 * p) * 1024 + lane * 16, row = pos / (DQK * 2), slot = (pos % (DQK * 2)) >> 4, r = row & 31;
        const int g = (DQK == 128) ? (slot ^ ((r & 7) | ((r >> 1) & 8))) : (slot ^ (((r >> 1) & 3) | ((r >> 2) & 4)));
        kgo[p] = row * u.ldk + g * 8; }
#pragma unroll
    for (int p = 0; p < 2; ++p) { const int pos = (wid + 8 * p) * 1024 + lane * 16, sub = pos >> 9, within = pos & 511;
        const int kk = (sub >> 2) * 8 + (within >> 6), k = (kk & ~0xC) | ((kk & 4) << 1) | ((kk & 8) >> 1), cc = (sub & 3) * 32 + ((within & 63) >> 1);
        vgo[p] = k * u.ldv + cc; }
    const int vb0 = (int)(unsigned)(uintptr_t)V_lds + v_rd_base(lane);
    const int nlat = u.nlat, NT = u.nt;
#define TILE_K(j) ((j) < nlat ? u.Kl + (size_t)(j) * 64 * u.ldk : u.Kc + (size_t)((j) - nlat) * 64 * u.ldk)
#define TILE_V(j) ((j) < nlat ? u.Vl + (size_t)(j) * 64 * u.ldv : u.Vc + (size_t)((j) - nlat) * 64 * u.ldv)
    const int lastT = NT - 1;
    const unsigned kldsb = (unsigned)(uintptr_t)K_lds, vldsb = (unsigned)(uintptr_t)V_lds;
#define GLDS(sbase, voffb, ldsaddr) do { unsigned keep_; asm volatile("s_mov_b32 %0, m0\n\ts_mov_b32 m0, %3\n\ts_nop 0\n\tglobal_load_lds_dwordx4 %1, %2\n\ts_mov_b32 m0, %0" : "=&s"(keep_) : "v"(voffb), "s"(sbase), "s"(ldsaddr) : "memory"); } while (0)
#define DMA_K(j, slot) do { const int jj_ = (j) < lastT ? (j) : lastT; const bf16_t* kp_ = TILE_K(jj_); const unsigned kd_ = kldsb + (unsigned)((slot) * KB + wid * 1024); \
        _Pragma("unroll") for (int p = 0; p < NKP; ++p) GLDS(kp_, (unsigned)(kgo[p] * 2), kd_ + p * 8192); } while (0)
#define DMA_V(j, slot) do { const int jj_ = (j) < lastT ? (j) : lastT; const bf16_t* vp_ = TILE_V(jj_); const unsigned vd_ = vldsb + (unsigned)((slot) * V_BYTES + wid * 1024); \
        _Pragma("unroll") for (int p = 0; p < 2; ++p) GLDS(vp_, (unsigned)(vgo[p] * 2), vd_ + p * 8192); } while (0)
#define STEP_SYNC(N) do { asm volatile("s_waitcnt vmcnt(%0) lgkmcnt(0)" :: "n"(N) : "memory"); __builtin_amdgcn_s_barrier(); asm volatile("" ::: "memory"); SBAR(); } while (0)
#define INC(x, S) do { x = (x + 1 == (S)) ? 0 : x + 1; } while (0)
    constexpr int QGRP = (NQ == 12) ? 2 : NQ;
    int kab[(DQK == 128) ? 8 : 4];
#pragma unroll
    for (int j = 0; j < ((DQK == 128) ? 8 : 4); ++j) kab[j] = kaddr<DQK>(r32, j * 2 + hi);
#define QKT(P0, P1, kslot) do { const LAS unsigned char* kb_ = K_lds + (kslot) * KB; \
        _Pragma("unroll") for (int r = 0; r < 16; ++r) { P0[r] = pinit; P1[r] = pinit; } \
        _Pragma("unroll") for (int d0 = 0; d0 < NQ; ++d0) { const int ka_ = (DQK == 128) ? kab[d0] : kab[d0 & 3] + (d0 >> 2) * 128; \
            const bf16x8 b0_ = *(const LAS bf16x8*)(kb_ + ka_); const bf16x8 b1_ = *(const LAS bf16x8*)(kb_ + ka_ + 32 * DQK * 2); \
            P0 = __builtin_amdgcn_mfma_f32_32x32x16_bf16(b0_, qr[d0], P0, 0, 0, 0); P1 = __builtin_amdgcn_mfma_f32_32x32x16_bf16(b1_, qr[d0], P1, 0, 0, 0); \
            if ((d0 + 1) % QGRP == 0 && d0 + 1 < NQ) SBAR(); } } while (0)
    const float C = u.C, nMC = -u.MC, pinit = (MODE == 0) ? -u.MC : 0.f;
#define PART1(p0, p1, jj) do { const int j_ = (jj); bool plain = true; \
        if (MODE == 1) { if (j_ < nlat) { plain = false; \
            const int base = u.m0 + 64 * j_ - (wid * 32 + r32) + 128 + 4 * hi; \
            _Pragma("unroll") for (int r = 0; r < 16; ++r) { const int d0_ = base + crowc(r), d1_ = d0_ + 32; \
                p0[r] = ((unsigned)d0_ <= 256u) ? fmaf(p0[r], C, nMC) : -1e30f; p1[r] = ((unsigned)d1_ <= 256u) ? fmaf(p1[r], C, nMC) : -1e30f; } } } \
        if (MODE == 2) { if (j_ < nlat) { plain = false; \
            const int kr = u.m1 + j_, qrow = u.m0 + (wid >> 1); int rs = qrow - 4; rs = rs < 0 ? 0 : (rs > 120 ? 120 : rs); \
            if (kr < rs || kr >= rs + 8) { \
                _Pragma("unroll") for (int r = 0; r < 16; ++r) { p0[r] = -1e30f; p1[r] = -1e30f; } \
            } else { \
                const int wq = (wid & 1) * 32 + r32; int cs = wq - 8; cs = cs < 0 ? 0 : (cs > 48 ? 48 : cs); \
                const LAS float* bl = biasL + (kr - qrow + 7) * 32 + 15 - wq + 4 * hi; \
                const int cb = 4 * hi - cs; \
                _Pragma("unroll") for (int r = 0; r < 16; ++r) { const int k0_ = crowc(r), k1_ = k0_ + 32; \
                    const float b0_ = bl[k0_], b1_ = bl[k1_]; \
                    p0[r] = ((unsigned)(cb + k0_) < 16u) ? fmaf(p0[r], C, b0_) : -1e30f; p1[r] = ((unsigned)(cb + k1_) < 16u) ? fmaf(p1[r], C, b1_) : -1e30f; } \
            } } } \
        if (plain && MODE != 0) { _Pragma("unroll") for (int r = 0; r < 16; ++r) { p0[r] = fmaf(p0[r], C, nMC); p1[r] = fmaf(p1[r], C, nMC); } } \
        _Pragma("unroll") for (int r = 0; r < 16; ++r) p0[r] = fast_exp2(p0[r]); } while (0)
    bf16x8 pa0, pa1, pa2, pa3;
#define PK4(P, BASE, OUT) do { const unsigned a0 = cvt_pk_bf16(P[BASE + 0], P[BASE + 1]), a1 = cvt_pk_bf16(P[BASE + 2], P[BASE + 3]);   \
        const unsigned b0 = cvt_pk_bf16(P[BASE + 4], P[BASE + 5]), b1 = cvt_pk_bf16(P[BASE + 6], P[BASE + 7]);                              \
        auto r0 = __builtin_amdgcn_permlane32_swap(a0, b0, false, false); auto r1 = __builtin_amdgcn_permlane32_swap(a1, b1, false, false); \
        u32x4 w = {r0[0], r1[0], r0[1], r1[1]}; OUT = *reinterpret_cast<bf16x8*>(&w); } while (0)
#define PART2(p0, p1) do { \
        _Pragma("unroll") for (int r = 0; r < 16; ++r) p1[r] = fast_exp2(p1[r]); \
        float ps = 0.f; \
        _Pragma("unroll") for (int r = 0; r < 16; ++r) ps += p0[r]; \
        _Pragma("unroll") for (int r = 0; r < 16; ++r) ps += p1[r]; \
        l_part += ps; \
        PK4(p0, 0, pa0); PK4(p0, 8, pa1); PK4(p1, 0, pa2); PK4(p1, 8, pa3); } while (0)
    if constexpr (MODE == 0) {
        constexpr int NW = ((SK - 2) * G_ + 2) < ((SV - 2) * G_) ? ((SK - 2) * G_ + 2) : ((SV - 2) * G_);
#define KADR(d0) ((DQK == 128) ? kab[(d0) & 7] : kab[(d0) & 3] + ((d0) >> 2) * 128)
#define TRL(dst, D0) do { dst[0] = tr_read<v_rd_off(D0, 0, 0)>(vb_); dst[1] = tr_read<v_rd_off(D0, 0, 1)>(vb_); dst[2] = tr_read<v_rd_off(D0, 1, 0)>(vb_); dst[3] = tr_read<v_rd_off(D0, 1, 1)>(vb_); \
        dst[4] = tr_read<v_rd_off(D0, 2, 0)>(vb_); dst[5] = tr_read<v_rd_off(D0, 2, 1)>(vb_); dst[6] = tr_read<v_rd_off(D0, 3, 0)>(vb_); dst[7] = tr_read<v_rd_off(D0, 3, 1)>(vb_); } while (0)
#define QKT_P2(P0, P1, kslot, Q0, Q1, vbase, dj, dslot) do { const LAS unsigned char* kb_ = K_lds + (kslot) * KB; const int vb_ = (vbase); \
        _Pragma("unroll") for (int r = 0; r < 16; ++r) { P0[r] = pinit; P1[r] = pinit; } \
        bf16x8 kf_[2][2]; float ps_ = 0.f; \
        { const int ka_ = KADR(0); kf_[0][0] = *(const LAS bf16x8*)(kb_ + ka_); kf_[0][1] = *(const LAS bf16x8*)(kb_ + ka_ + 32 * DQK * 2); } \
        SBAR(); DMA_K(dj, dslot); SBAR(); \
        _Pragma("unroll") for (int d0 = 0; d0 < NQ; ++d0) { \
            if (d0 + 1 < NQ) { const int ka_ = KADR(d0 + 1); kf_[(d0 + 1) & 1][0] = *(const LAS bf16x8*)(kb_ + ka_); kf_[(d0 + 1) & 1][1] = *(const LAS bf16x8*)(kb_ + ka_ + 32 * DQK * 2); } \
            P0 = __builtin_amdgcn_mfma_f32_32x32x16_bf16(kf_[d0 & 1][0], qr[d0], P0, 0, 0, 0); P1 = __builtin_amdgcn_mfma_f32_32x32x16_bf16(kf_[d0 & 1][1], qr[d0], P1, 0, 0, 0); \
            _Pragma("unroll") for (int r = (16 * d0) / NQ; r < (16 * (d0 + 1)) / NQ; ++r) { Q1[r] = fast_exp2(Q1[r]); ps_ += Q0[r] + Q1[r]; } \
            if (d0 == 0) PK4(Q0, 0, pa0); \
            if (d0 == 1) PK4(Q0, 8, pa1); \
            if (d0 == NQ / 2) PK4(Q1, 0, pa2); \
            if (d0 == NQ - 1) { TRL(ta_, 0); TRL(tb_, 1); } \
            SBAR(); } \
        PK4(Q1, 8, pa3); l_part += ps_; } while (0)
#define PKV(L, H) (bf16x8){L[0], L[1], L[2], L[3], H[0], H[1], H[2], H[3]}
#define PVBLK(D0, CUR, P0, P1) do { \
        o[D0] = __builtin_amdgcn_mfma_f32_32x32x16_bf16(pa0, PKV(CUR[0], CUR[1]), o[D0], 0, 0, 0); o[D0] = __builtin_amdgcn_mfma_f32_32x32x16_bf16(pa1, PKV(CUR[2], CUR[3]), o[D0], 0, 0, 0); \
        o[D0] = __builtin_amdgcn_mfma_f32_32x32x16_bf16(pa2, PKV(CUR[4], CUR[5]), o[D0], 0, 0, 0); o[D0] = __builtin_amdgcn_mfma_f32_32x32x16_bf16(pa3, PKV(CUR[6], CUR[7]), o[D0], 0, 0, 0); \
        _Pragma("unroll") for (int r = 4 * D0; r < 4 * D0 + 4; ++r) { P0[r] = fast_exp2(P0[r]); } \
        SBAR(); } while (0)
#define PV_P1(vbase, P0, P1, dj, dslot) do { const int vb_ = (vbase); \
        asm volatile("s_waitcnt lgkmcnt(8)" ::: "memory"); SBAR(); PVBLK(0, ta_, P0, P1); DMA_V(dj, dslot); SBAR(); \
        TRL(ta_, 2); asm volatile("s_waitcnt lgkmcnt(8)" ::: "memory"); SBAR(); PVBLK(1, tb_, P0, P1); \
        TRL(tb_, 3); asm volatile("s_waitcnt lgkmcnt(8)" ::: "memory"); SBAR(); PVBLK(2, ta_, P0, P1); \
        asm volatile("s_waitcnt lgkmcnt(0)" ::: "memory"); SBAR(); PVBLK(3, tb_, P0, P1); } while (0)
        f32x16 pA0, pA1, pB0, pB1; s16x4 ta_[8], tb_[8];
#pragma unroll
        for (int j = 0; j < SK - 1; ++j) DMA_K(j, j);
#pragma unroll
        for (int j = 0; j < SV - 2; ++j) DMA_V(j, j);
        asm volatile("s_waitcnt vmcnt(0)" ::: "memory"); __syncthreads();
        int kc = 0, kl = SK - 1, vc = SV - 1, vl = SV - 2;
        DMA_K(SK - 1, kl); DMA_V(SV - 2, vl); SBAR();
        QKT(pA0, pA1, kc); PART1(pA0, pA1, 0);
        STEP_SYNC(NW); INC(kc, SK); INC(kl, SK); INC(vc, SV); INC(vl, SV);
        for (int t = 1; t + 1 < NT; t += 2) {
            QKT_P2(pB0, pB1, kc, pA0, pA1, vb0 + vc * V_BYTES, t + SK - 1, kl);
            PV_P1(vb0 + vc * V_BYTES, pB0, pB1, t + SV - 2, vl);
            STEP_SYNC(NW); INC(kc, SK); INC(kl, SK); INC(vc, SV); INC(vl, SV);
            QKT_P2(pA0, pA1, kc, pB0, pB1, vb0 + vc * V_BYTES, t + SK, kl);
            PV_P1(vb0 + vc * V_BYTES, pA0, pA1, t + SV - 1, vl);
            STEP_SYNC(NW); INC(kc, SK); INC(kl, SK); INC(vc, SV); INC(vl, SV);
        }
        QKT_P2(pB0, pB1, kc, pA0, pA1, vb0 + vc * V_BYTES, NT - 1, kl);
        PV_P1(vb0 + vc * V_BYTES, pB0, pB1, NT - 1, vl);
        STEP_SYNC(NW); INC(vc, SV);
        PART2(pB0, pB1); SBAR();
        pv_d0(o, vb0 + vc * V_BYTES, pa0, pa1, pa2, pa3);
#undef KADR
#undef QKT_P2
#undef TRL
#undef PKV
#undef PVBLK
#undef PV_P1
    } else {
        static_assert(SK == SV, "masked loop uses one ring index");
        f32x16 pA0, pA1;
#pragma unroll
        for (int j = 0; j < SK - 1; ++j) { DMA_K(j, j); DMA_V(j, j); }
        asm volatile("s_waitcnt vmcnt(0)" ::: "memory"); __syncthreads();
        int kc = 0, kl = SK - 1;
        for (int t = 0; t < NT; ++t) {
            DMA_K(t + SK - 1, kl); DMA_V(t + SK - 1, kl); SBAR();
            bool dead = false;
            if (MODE == 1) { if (t < nlat) { const int k0 = u.m0 + 64 * t, q0w = wid * 32; dead = (k0 - (q0w + 31) > 128) || (q0w - (k0 + 63) > 128); } }
            if (MODE == 2) { if (t < nlat) { const int kr = u.m1 + t, qrow = u.m0 + (wid >> 1); int rs = qrow - 4; rs = rs < 0 ? 0 : (rs > 120 ? 120 : rs); dead = (kr < rs || kr >= rs + 8); } }
            if (!dead) {
                QKT(pA0, pA1, kc);
                PART1(pA0, pA1, t); PART2(pA0, pA1); SBAR();
                pv_d0(o, vb0 + kc * V_BYTES, pa0, pa1, pa2, pa3);
            }
            STEP_SYNC((SK - 2) * G_); INC(kc, SK); INC(kl, SK);
        }
    }
    asm volatile("s_waitcnt vmcnt(0)" ::: "memory");
    const int lane_e = lane_id(), r32e = lane_e & 31, hie = lane_e >> 5;
    { auto rr = __builtin_amdgcn_permlane32_swap(__float_as_uint(l_part), __float_as_uint(l_part), false, false);
      l_part = __uint_as_float(rr[0]) + __uint_as_float(rr[1]); }
    l_part += fast_exp2(u.sinkL);
    if (hie == 0) li_l[r32e] = l_part;
    asm volatile("s_waitcnt lgkmcnt(0)" ::: "memory");
    float rli[16];
#pragma unroll
    for (int r = 0; r < 16; ++r) rli[r] = fast_rcp(li_l[crowc(r) + 4 * hie]);
    {
        int ldo = u.ldo; asm volatile("" : "+s"(ldo));
        const unsigned voff = (unsigned)(4 * hie * ldo + r32e);
        if (u.out_mode == 1) {
            float* Ow = (float*)u.out + (size_t)(wid * 32) * ldo;
#pragma unroll
            for (int r = 0; r < 16; ++r) { float* Or = Ow + (size_t)(crowc(r) * ldo);
#pragma unroll
                for (int d0 = 0; d0 < 4; ++d0) Or[voff + d0 * 32] = o[d0][r] * rli[r]; }
        } else if (u.out_mode == 0) {
            bf16_t* Ow = (bf16_t*)u.out + (size_t)(wid * 32) * ldo; const bf16_t* Gw = u.gate + (size_t)(wid * 32) * ldo;
#pragma unroll
            for (int rc = 0; rc < 16; rc += 4) {
                unsigned short gt[4][4];
#pragma unroll
                for (int r = 0; r < 4; ++r)
#pragma unroll
                    for (int d0 = 0; d0 < 4; ++d0) gt[r][d0] = (Gw + (size_t)(crowc(rc + r) * ldo))[voff + d0 * 32];
#pragma unroll
                for (int r = 0; r < 4; ++r)
#pragma unroll
                    for (int d0 = 0; d0 < 4; ++d0) (Ow + (size_t)(crowc(rc + r) * ldo))[voff + d0 * 32] = f2bf(o[d0][rc + r] * rli[rc + r] * bf2f(gt[r][d0]));
                asm volatile("" ::: "memory"); }
        } else {
            int ld0 = 2048; asm volatile("" : "+s"(ld0));
            const unsigned voff0 = (unsigned)(4 * hie * ld0 + r32e);
            const float* O0w = u.o0 + (size_t)(wid * 32) * ld0;
            float ssr[16];
#pragma unroll
            for (int rc = 0; rc < 16; rc += 4) {
                float ov[4][4];
#pragma unroll
                for (int r = 0; r < 4; ++r)
#pragma unroll
                    for (int d0 = 0; d0 < 4; ++d0) ov[r][d0] = (O0w + (size_t)(crowc(rc + r) * ld0))[voff0 + d0 * 32];
#pragma unroll
                for (int r = 0; r < 4; ++r) { float sacc = 0.f;
#pragma unroll
                    for (int d0 = 0; d0 < 4; ++d0) { const float dv = ov[r][d0] - u.lam * (o[d0][rc + r] * rli[rc + r]); o[d0][rc + r] = dv; sacc += dv * dv; }
                    ssr[rc + r] = sacc; }
                asm volatile("" ::: "memory"); }
#pragma unroll
            for (int r = 0; r < 16; ++r) ssr[r] = half_sum(ssr[r]);
            float sw[4];
#pragma unroll
            for (int d0 = 0; d0 < 4; ++d0) sw[d0] = u.subw[d0 * 32 + r32e] * u.om;
            bf16_t* Ow = (bf16_t*)u.out + (size_t)(wid * 32) * ldo; const bf16_t* Gw = u.gate + (size_t)(wid * 32) * ldo;
#pragma unroll
            for (int rc = 0; rc < 16; rc += 4) {
                unsigned short gt[4][4];
#pragma unroll
                for (int r = 0; r < 4; ++r)
#pragma unroll
                    for (int d0 = 0; d0 < 4; ++d0) gt[r][d0] = (Gw + (size_t)(crowc(rc + r) * ldo))[voff + d0 * 32];
#pragma unroll
                for (int r = 0; r < 4; ++r) { const float rsn = __builtin_amdgcn_rsqf(ssr[rc + r] * (1.0f / 128.f) + EPS);
#pragma unroll
                    for (int d0 = 0; d0 < 4; ++d0) (Ow + (size_t)(crowc(rc + r) * ldo))[voff + d0 * 32] = f2bf(o[d0][rc + r] * rsn * sw[d0] * bf2f(gt[r][d0])); }
                asm volatile("" ::: "memory"); }
        }
    }
#undef TILE_K
#undef TILE_V
#undef GLDS
#undef DMA_K
#undef DMA_V
#undef STEP_SYNC
#undef INC
#undef QKT
#undef PART1
#undef PART2
#undef PK4
}
}

struct Args { const float* in[31]; float* out; unsigned char* ws; int ph_lo, ph_hi; };
enum { I_X = 0, I_C, I_CTX, I_CCTX, I_WADA, I_BADA, I_GNORM, I_WIN, I_QNA, I_KNA, I_SINKA, I_QNB, I_KNB, I_RPB, I_GQA, I_GKVA, I_WQUP, I_WKVUP, I_QNNOPE, I_QNPE, I_KNNOPE, I_KNPE,
       I_QND, I_KND, I_LQ1, I_LK1, I_LQ2, I_LK2, I_SUBLN, I_WBR, I_WOUT };
constexpr int GRID = 256, NTHR = 512;
constexpr int LDS_BYTES = 144 * 1024;
constexpr int LDS_MISC = LDS_BYTES - 256;
static_assert(att::ATT_LDS_MAX <= LDS_MISC && pg8::STAGE_BYTES <= LDS_MISC, "LDS budget");

__device__ __forceinline__ void tr_tile_desc(const Args& a, int idx, const float*& src, int& lds_n, bf16_t*& dst, int& ldk, bool& zero, bool& q8, const unsigned*& cmx, float*& wscp, bool& firstk) {
    const int l = idx / 19240; int r = idx % 19240; zero = false; q8 = false; cmx = nullptr; wscp = nullptr; firstk = false;
    if (r < 14848) { const int tk = (r & 255) >> 3, tn = (r >> 8) * 8 + (r & 7); const int n0d = tn * 64; zero = (n0d == 8128); const int n0s = n0d < 8128 ? n0d : n0d - 64;
        src = a.in[I_WIN] + ((size_t)l * 4096 + tk * 128) * NIN + n0s; lds_n = NIN; ldk = 4096;
        const int pn = n0d >> 8, ro = n0d & 255;
        const bool isbf = pn >= 48 && pn < 52; const int lpn = pn < 48 ? pn : (pn < 52 ? pn - 48 : pn - 4);
        if (isbf) dst = (bf16_t*)(a.ws + WS_WIN) + ((size_t)l * NT_BF * 256 + lpn * 256 + ro) * 4096 + tk * 128;
        else { q8 = true; dst = (bf16_t*)(a.ws + WS_W8 + ((size_t)l * NT_F8 * 256 + lpn * 256 + ro) * 4096 + tk * 128);
            cmx = (const unsigned*)(a.ws + WS_CMAX) + (size_t)l * NIN + n0s; wscp = (float*)(a.ws + WS_WSC) + (size_t)l * NINP + n0d; firstk = (tk == 0); }
        return; }
    r -= 14848;
    if (r < 168) { const int tk = r / 24, tn = r % 24;
        src = a.in[I_WQUP] + ((size_t)l * 896 + tk * 128) * 1536 + tn * 64; lds_n = 1536; dst = (bf16_t*)(a.ws + WS_WQ) + ((size_t)l * 1536 + tn * 64) * 896 + tk * 128; ldk = 896; return; }
    r -= 168;
    if (r < 128) { const int tk = r / 32, tn = r % 32;
        src = a.in[I_WKVUP] + ((size_t)l * 512 + tk * 128) * 2048 + tn * 64; lds_n = 2048; dst = (bf16_t*)(a.ws + WS_WKV) + ((size_t)l * 2048 + tn * 64) * 512 + tk * 128; ldk = 512; return; }
    r -= 128;
    if (r < 2048) { const int br = r / 512, r2 = r % 512, tk = (r2 & 255) >> 5, tn = (r2 >> 8) * 32 + (r2 & 31);
        src = a.in[I_WBR] + (((size_t)l * 4 + br) * 1024 + tk * 128) * 4096 + tn * 64; lds_n = 4096; dst = (bf16_t*)(a.ws + WS_WB) + ((size_t)l * 4096 + tn * 64) * 4096 + br * 1024 + tk * 128; ldk = 4096; return; }
    r -= 2048;
    { const int tk = (r & 255) >> 3, tn = (r >> 8) * 8 + (r & 7);
        src = a.in[I_WOUT] + ((size_t)l * 4096 + tk * 128) * 4096 + tn * 64; lds_n = 4096; dst = (bf16_t*)(a.ws + WS_WO) + ((size_t)l * 4096 + tn * 64) * 4096 + tk * 128; ldk = 4096; }
}
__device__ __forceinline__ void phase_pre0(const Args& a, LAS unsigned char* lds, const int wv0) {
    const int tid = wv0 * 64 + lane_id(), bid = blockIdx.x;
    for (int un = bid; un < 4 * 58; un += GRID) {
        const int l = un / 58, cb = un % 58, c0 = cb * 512 + tid;
        if (c0 < NIN) {
            const float* wp = a.in[I_WIN] + (size_t)l * 4096 * NIN + c0;
            float m = 0.f, q = 0.f;
#pragma unroll 32
            for (int k = 0; k < CS_ROWS; ++k) { const float w = wp[(size_t)(k * 16) * NIN]; m = fmaxf(m, fabsf(w)); q = fmaf(w, w, q); }
            ((float*)(a.ws + WS_CMAX))[(size_t)l * NIN + c0] = m; ((float*)(a.ws + WS_CSQ))[(size_t)l * NIN + c0] = q;
        }
    }
    LAS float* sv = (LAS float*)lds;
    for (int un = bid; un < 4 * 6 * 32; un += GRID) {
        const int l = un / 192, cb = (un % 192) / 32, ksp = un % 32;
        __syncthreads();
        if (tid < 384) { const int j = tid >> 7, k = ksp * 128 + (tid & 127); const float cv = j < 2 ? a.in[I_C][j * 4096 + k] : a.in[I_CCTX][k]; sv[tid] = silu_f(cv); }
        __syncthreads();
        const float* wp = a.in[I_WADA] + ((size_t)l * 4096 + ksp * 128) * 12288 + cb * 2048 + tid * 4;
        f32x4 a0 = {0.f, 0.f, 0.f, 0.f}, a1 = a0, a2 = a0;
#pragma unroll 8
        for (int k = 0; k < 128; ++k) { const f32x4 w = *(const f32x4*)(wp + (size_t)k * 12288); a0 += w * sv[k]; a1 += w * sv[128 + k]; a2 += w * sv[256 + k]; }
        float* pp = (float*)(a.ws + WS_MODP) + ((size_t)(l * 32 + ksp) * 3) * 12288 + cb * 2048 + tid * 4;
        *(f32x4*)(pp) = a0; *(f32x4*)(pp + 12288) = a1; *(f32x4*)(pp + 2 * 12288) = a2;
    }
}
__device__ __forceinline__ void phase_prologue(const Args& a, LAS unsigned char* lds, const int wv0) {
    const int tid = wv0 * 64 + lane_id(), bid = blockIdx.x;
    LAS float* T = (LAS float*)lds;
    constexpr int NTILES = 4 * 19240;
    f32x4 rgA[4], rgB[4];
    bf16_t* dstA = nullptr; bf16_t* dstB = nullptr; int ldkA = 0, ldkB = 0; bool q8A = false, q8B = false, zA = false, zB = false, fkA = false, fkB = false;
    const unsigned* cmA = nullptr; const unsigned* cmB = nullptr; float* wsA = nullptr; float* wsB = nullptr;
    float cvA[2] = {0.f, 0.f}, sqA[2] = {0.f, 0.f}, cvB[2] = {0.f, 0.f}, sqB[2] = {0.f, 0.f};
#define TR_LOAD(RG, DST, LDK, Q8, ZZ, CM, WS, FK, CV, SQ, tt) do { const float* src_; int ldn_; tr_tile_desc(a, (tt), src_, ldn_, DST, LDK, ZZ, Q8, CM, WS, FK); \
        if (Q8 && !ZZ) { _Pragma("unroll") for (int i = 0; i < 2; ++i) { const int n_ = (tid + 512 * i) >> 4; CV[i] = __uint_as_float(CM[n_]); SQ[i] = ((const float*)CM)[(WS_CSQ - WS_CMAX) / 4 + n_]; } } \
        else { CV[0] = 0.f; CV[1] = 0.f; SQ[0] = 0.f; SQ[1] = 0.f; } \
        _Pragma("unroll") for (int i = 0; i < 4; ++i) { const int idx = tid + 512 * i, kr = idx >> 4, c4 = (idx & 15) * 4; RG[i] = ZZ ? (f32x4){0.f, 0.f, 0.f, 0.f} : *(const f32x4*)(src_ + (size_t)kr * ldn_ + c4); } } while (0)
#define TR_TILE(RG, DST, LDK, Q8, ZZ, CM, WS, FK, CV, SQ, tnext) do { \
        _Pragma("unroll") for (int i = 0; i < 4; ++i) { const int idx = tid + 512 * i, kr = idx >> 4, c4 = (idx & 15) * 4; \
            T[kr * 65 + c4 + 0] = RG[i][0]; T[kr * 65 + c4 + 1] = RG[i][1]; T[kr * 65 + c4 + 2] = RG[i][2]; T[kr * 65 + c4 + 3] = RG[i][3]; } \
        __syncthreads(); \
        bf16_t* dcur = DST; const int ldkc = LDK; const bool q8c = Q8, zc = ZZ, fkc = FK; float* wsc_ = WS; const float cv0_ = CV[0], cv1_ = CV[1], sq0_ = SQ[0], sq1_ = SQ[1]; \
        if ((tnext) < NTILES) TR_LOAD(RG, DST, LDK, Q8, ZZ, CM, WS, FK, CV, SQ, (tnext)); \
        _Pragma("unroll") for (int i = 0; i < 2; ++i) { const int idx = tid + 512 * i, n = idx >> 4, kc = (idx & 15) * 8; \
            float v[8]; \
            _Pragma("unroll") for (int q = 0; q < 8; ++q) v[q] = T[(kc + q) * 65 + n]; \
            if (q8c) { const float cm_ = zc ? 0.f : fmaxf(i == 0 ? cv0_ : cv1_, 4.0f * sqrtf((i == 0 ? sq0_ : sq1_) * (1.0f / CS_ROWS))); const float sc_ = cm_ > 0.f ? 127.0f / cm_ : 0.f; \
                int qi[8]; \
                _Pragma("unroll") for (int q = 0; q < 8; ++q) qi[q] = (int)__builtin_rintf(__builtin_amdgcn_fmed3f(v[q] * sc_, -127.0f, 127.0f)) & 0xff; \
                u32x2 w8; w8.x = (unsigned)(qi[0] | (qi[1] << 8) | (qi[2] << 16) | (qi[3] << 24)); w8.y = (unsigned)(qi[4] | (qi[5] << 8) | (qi[6] << 16) | (qi[7] << 24)); \
                *(u32x2*)((unsigned char*)dcur + (size_t)n * ldkc + kc) = w8; \
                if (fkc && kc == 0) wsc_[n] = cm_ * (1.0f / 127.0f); } \
            else { u32x4 w; w.x = cvt_pk_bf16(v[0], v[1]); w.y = cvt_pk_bf16(v[2], v[3]); w.z = cvt_pk_bf16(v[4], v[5]); w.w = cvt_pk_bf16(v[6], v[7]); \
                *(u32x4*)(dcur + (size_t)n * ldkc + kc) = w; } } \
        __syncthreads(); } while (0)
    if (bid < NTILES) TR_LOAD(rgA, dstA, ldkA, q8A, zA, cmA, wsA, fkA, cvA, sqA, bid);
    if (bid + GRID < NTILES) TR_LOAD(rgB, dstB, ldkB, q8B, zB, cmB, wsB, fkB, cvB, sqB, bid + GRID);
    for (int t = bid; t < NTILES; t += 2 * GRID) {
        TR_TILE(rgA, dstA, ldkA, q8A, zA, cmA, wsA, fkA, cvA, sqA, t + 2 * GRID);
        if (t + GRID < NTILES) TR_TILE(rgB, dstB, ldkB, q8B, zB, cmB, wsB, fkB, cvB, sqB, t + 3 * GRID);
    }
#undef TR_LOAD
#undef TR_TILE
}

__device__ __forceinline__ void sincos_acc(float ang, float& c, float& s) {
    const double x = (double)ang;
    const double q = __builtin_rint(x * 0.6366197723675814);
    const double y = x - q * 1.5707963267948966 - q * 6.123233995736766e-17;
    const double y2 = y * y;
    const double sy = y * (1.0 + y2 * (-1.0 / 6 + y2 * (1.0 / 120 + y2 * (-1.0 / 5040 + y2 * (1.0 / 362880 + y2 * (-1.0 / 39916800 + y2 * (1.0 / 6227020800.0)))))));
    const double cy = 1.0 + y2 * (-0.5 + y2 * (1.0 / 24 + y2 * (-1.0 / 720 + y2 * (1.0 / 40320 + y2 * (-1.0 / 3628800 + y2 * (1.0 / 479001600.0))))));
    const int qi = ((int)q) & 3;
    const double sd = (qi == 0) ? sy : (qi == 1) ? cy : (qi == 2) ? -sy : -cy;
    const double cd = (qi == 0) ? cy : (qi == 1) ? -sy : (qi == 2) ? -cy : sy;
    c = (float)cd; s = (float)sd;
}
__device__ __forceinline__ float wave_maxabs(const float* p, int n, int lane) { float m = 0.f; for (int i = lane; i < n; i += 64) m = fmaxf(m, fabsf(p[i])); return wave_max(m); }
__device__ __forceinline__ float wave_dot(const float* p, const float* q, int n, int lane) { float s = 0.f; for (int i = lane; i < n; i += 64) s += p[i] * q[i]; return wave_sum(s); }
__device__ __forceinline__ void phase_mods(const Args& a, const int wv0) {
    const int tid = wv0 * 64 + lane_id(), bid = blockIdx.x, gid = bid * NTHR + tid;
    float* mods = (float*)(a.ws + WS_MODS); const float* mp = (const float*)(a.ws + WS_MODP);
    for (int i = gid; i < 4 * 3 * 12288; i += GRID * NTHR) { const int l = i / 36864, r = i % 36864, j = r / 12288, c = r % 12288;
        float s = a.in[I_BADA][l * 12288 + c];
        for (int ks = 0; ks < 32; ++ks) s += mp[((size_t)(l * 32 + ks) * 3 + j) * 12288 + c];
        mods[i] = s; }
    float* rope = (float*)(a.ws + WS_ROPE);
    if (gid < 4096) { const int pos = gid >> 5, j = gid & 31; double inv = 1.0; for (int q = 0; q < j; ++q) inv *= 0.7498942093324558;
        const float ang = (float)pos * (float)inv; float c, s; sincos_acc(ang, c, s); rope[gid] = c; rope[4096 + gid] = s; }
    else if (gid < 4096 + 2048) { const int g2 = gid - 4096, pos = g2 >> 4, j = g2 & 15; double inv = 1.0; for (int q = 0; q < j; ++q) inv *= 0.5623413251903491;
        const float ang = (float)pos * (float)inv; float c, s; sincos_acc(ang, c, s); rope[8192 + g2] = c; rope[8192 + 2048 + g2] = s; }
    if (bid >= 16 && bid < 20 && tid < 64) {
        const int l = bid - 16, lane = tid; float* bnd = (float*)(a.ws + WS_BND) + l * 32;
        const float SAFE = 1.03f;
        const float mqa = wave_maxabs(a.in[I_QNA] + l * 128, 128, lane), mka = wave_maxabs(a.in[I_KNA] + l * 128, 128, lane);
        const float mqb = wave_maxabs(a.in[I_QNB] + l * 128, 128, lane), mkb = wave_maxabs(a.in[I_KNB] + l * 128, 128, lane);
        const float mqn = wave_maxabs(a.in[I_QNNOPE] + l * 128, 128, lane), mkn = wave_maxabs(a.in[I_KNNOPE] + l * 128, 128, lane);
        const float mqp = wave_maxabs(a.in[I_QNPE] + l * 64, 64, lane), mkp = wave_maxabs(a.in[I_KNPE] + l * 64, 64, lane);
        const float mqd = wave_maxabs(a.in[I_QND] + l * 64, 64, lane), mkd = wave_maxabs(a.in[I_KND] + l * 64, 64, lane);
        const float bA = SAFE * 11.313708498984761f * mqa * mka;
        const float bB = SAFE * 11.313708498984761f * mqb * mkb;
        const float bC = SAFE * 0.07216878364870323f * (128.f * mqn * mkn + 64.f * mqp * mkp);
        const float bD = SAFE * 8.0f * mqd * mkd;
        const float li_[4] = {0.2f, 0.35550906759096934f, 0.4707130183435842f, 0.5560582041556406f};
        const float d1 = wave_dot(a.in[I_LQ1] + l * 64, a.in[I_LK1] + l * 64, 64, lane), d2 = wave_dot(a.in[I_LQ2] + l * 64, a.in[I_LK2] + l * 64, 64, lane);
        for (int h = 0; h < 8; ++h) {
            const float sk = a.in[I_SINKA][l * 8 + h]; const float MA = fmaxf(bA, sk);
            const float mr = wave_maxabs(a.in[I_RPB] + ((size_t)l * 8 + h) * 465, 465, lane);
            if (lane == 0) { bnd[h] = MA * LOG2E; bnd[8 + h] = (bB + mr) * LOG2E; bnd[19 + h] = (sk - MA) * LOG2E; }
        }
        if (lane == 0) { bnd[16] = bC * LOG2E; bnd[17] = bD * LOG2E; bnd[18] = expf(d1) - expf(d2) + li_[l]; }
    }
}

__device__ __forceinline__ void phase_xnorm(const Args& a, int l, const float* xin, const float* cin, float* cout, const int wv0) {
    int tid_ = wv0 * 64 + lane_id(); asm volatile("" : "+v"(tid_)); const int tid = tid_, lane = tid & 63, wv = blockIdx.x * 8 + (tid >> 6);
    const float* g = a.in[I_GNORM] + l * 4096; const float* mods = (const float*)(a.ws + WS_MODS) + l * 36864;
    bf16_t* H = (bf16_t*)(a.ws + WS_H);
    for (int row = wv; row < MTOT; row += GRID * 8) {
        const float* xr = row < MLAT ? xin + (size_t)row * 4096 : cin + (size_t)(row - MLAT) * 4096;
        const int j = row < SEQ ? 0 : (row < MLAT ? 1 : 2);
        const float* sh = mods + j * 12288; const float* sc = sh + 4096;
        f32x4 v[16]; float ss = 0.f;
#pragma unroll
        for (int i = 0; i < 16; ++i) v[i] = *(const f32x4*)(xr + (i * 64 + lane) * 4);
        if (row >= MLAT && l >= 1) {
            const float* gtp = (const float*)(a.ws + WS_MODS) + (l - 1) * 36864 + 2 * 12288 + 8192; const float* P4 = (const float*)(a.ws + WS_P4) + (size_t)(row - MLAT) * 4096;
#pragma unroll
            for (int i = 0; i < 16; ++i) { const int c = (i * 64 + lane) * 4; f32x4 sacc = *(const f32x4*)(P4 + c);
                for (int kc = 1; kc < 8; ++kc) sacc += *(const f32x4*)(P4 + (size_t)kc * MCTX * 4096 + c);
                v[i] += *(const f32x4*)(gtp + c) * sacc; *(f32x4*)(cout + (size_t)(row - MLAT) * 4096 + c) = v[i]; }
        }
#pragma unroll
        for (int i = 0; i < 16; ++i) ss += v[i][0] * v[i][0] + v[i][1] * v[i][1] + v[i][2] * v[i][2] + v[i][3] * v[i][3];
        ss = wave_sum(ss);
        const float rs = 1.0f / sqrtf(ss * (1.0f / 4096.f) + EPS);
        float amax = 0.f;
#pragma unroll
        for (int ib = 0; ib < 16; ib += 4) {
            f32x4 gv[4], scv[4], shv[4];
#pragma unroll
            for (int i = 0; i < 4; ++i) { const int c = ((ib + i) * 64 + lane) * 4; gld16f(gv[i], g + c); gld16f(scv[i], sc + c); gld16f(shv[i], sh + c); }
            GLD_WAIT();
#pragma unroll
            for (int i = 0; i < 4; ++i) { const f32x4 hv = v[ib + i] * rs * gv[i] * (1.0f + scv[i]) + shv[i]; v[ib + i] = hv;
                amax = fmaxf(amax, fmaxf(fmaxf(fabsf(hv[0]), fabsf(hv[1])), fmaxf(fabsf(hv[2]), fabsf(hv[3])))); }
        }
        amax = wave_max(amax);
        const float qs = amax > 0.f ? 127.0f / amax : 0.f;
        if (lane == 0) ((float*)(a.ws + WS_HS))[row] = amax * (1.0f / 127.0f);
#pragma unroll
        for (int i = 0; i < 16; ++i) { const int c = (i * 64 + lane) * 4; const f32x4 hv = v[i];
            u32x2 w; w.x = cvt_pk_bf16(hv[0], hv[1]); w.y = cvt_pk_bf16(hv[2], hv[3]);
            *(u32x2*)(H + (size_t)row * 4096 + c) = w;
            const int q0 = (int)__builtin_rintf(hv[0] * qs), q1 = (int)__builtin_rintf(hv[1] * qs), q2 = (int)__builtin_rintf(hv[2] * qs), q3 = (int)__builtin_rintf(hv[3] * qs);
            *(unsigned*)(a.ws + WS_H8 + (size_t)row * 4096 + c) = (unsigned)(q0 & 0xff) | ((unsigned)(q1 & 0xff) << 8) | ((unsigned)(q2 & 0xff) << 16) | ((unsigned)q3 << 24); }
    }
}

__device__ __forceinline__ void unpack8(const u32x4 v, float (&x)[8]) { x[0] = bflo(v.x); x[1] = bfhi(v.x); x[2] = bflo(v.y); x[3] = bfhi(v.y); x[4] = bflo(v.z); x[5] = bfhi(v.z); x[6] = bflo(v.w); x[7] = bfhi(v.w); }
__device__ __forceinline__ u32x4 pack8(const float (&x)[8]) { u32x4 w; w.x = cvt_pk_bf16(x[0], x[1]); w.y = cvt_pk_bf16(x[2], x[3]); w.z = cvt_pk_bf16(x[4], x[5]); w.w = cvt_pk_bf16(x[6], x[7]); return w; }
template <int GL> __device__ __forceinline__ u32x4 norm_group(const u32x4 v, const float* gain, bool rope, const float* ct, const float* st, int lane) {
    float x[8]; unpack8(v, x);
    float ss = 0.f;
#pragma unroll
    for (int q = 0; q < 8; ++q) ss += x[q] * x[q];
    if (GL == 16) ss += swz_xor<8>(ss);
    ss += swz_xor<4>(ss); ss += swz_xor<2>(ss); ss += swz_xor<1>(ss);
    const float rs = __builtin_amdgcn_rsqf(ss * (1.0f / (GL * 8)) + EPS);
    const f32x4 g0 = *(const f32x4*)gain, g1 = *(const f32x4*)(gain + 4);
#pragma unroll
    for (int q = 0; q < 4; ++q) { x[q] *= rs * g0[q]; x[4 + q] *= rs * g1[q]; }
    if (rope) {
        const f32x4 c0 = *(const f32x4*)ct, c1 = *(const f32x4*)(ct + 4), s0 = *(const f32x4*)st, s1 = *(const f32x4*)(st + 4);
        const bool first = (lane & (GL - 1)) < GL / 2;
#pragma unroll
        for (int q = 0; q < 8; ++q) { const float p = swz_xor<GL / 2>(x[q]); const float c = q < 4 ? c0[q & 3] : c1[q & 3], sn = q < 4 ? s0[q & 3] : s1[q & 3];
            x[q] = first ? (x[q] * c - p * sn) : (x[q] * c + p * sn); }
    }
    return pack8(x);
}
__device__ __forceinline__ void phase_post1(const Args& a, int l, const int wv0) {
    int tid_ = wv0 * 64 + lane_id(); asm volatile("" : "+v"(tid_)); const int tid = tid_, lane = tid & 63, wv = blockIdx.x * 8 + (tid >> 6);
    const float* rope = (const float*)(a.ws + WS_ROPE); const float* c128 = rope, *s128 = rope + 4096, *c64 = rope + 8192, *s64 = rope + 8192 + 2048;
    const int l16 = lane & 15, l8 = lane & 7;
    const float* gka = a.in[I_KNA] + l * 128 + l16 * 8; const float* gkb = a.in[I_KNB] + l * 128 + l16 * 8; const float* gkd = a.in[I_KND] + l * 64 + l8 * 8;
    const float* gq0 = a.in[I_GQA] + l * 896 + lane * 8; const float* gq1 = a.in[I_GQA] + l * 896 + 512 + (lane < 48 ? lane : 0) * 8; const float* gkv = a.in[I_GKVA] + l * 512 + lane * 8;
    const float* gpe = a.in[I_KNPE] + l * 64 + l8 * 8;
    for (int row = wv; row < MTOT; row += GRID * 8) {
        const bool lat = row < MLAT; const int tpos = row & (SEQ - 1), grow = tpos >> 6, gcol = tpos & 63;
        bf16_t* ka = (bf16_t*)(a.ws + WS_KA) + (size_t)row * 256; bf16_t* kb = (bf16_t*)(a.ws + WS_KB) + (size_t)row * 1024; bf16_t* kd = (bf16_t*)(a.ws + WS_KD) + (size_t)row * 1024;
        bf16_t* cc = (bf16_t*)(a.ws + WS_CC) + (size_t)row * 1536;
        const u32x4 z = {0u, 0u, 0u, 0u};
        const u32x4 rKA = lane < 32 ? *(const u32x4*)(ka + lane * 8) : z;
        const u32x4 rKB0 = *(const u32x4*)(kb + lane * 8), rKB1 = *(const u32x4*)(kb + 512 + lane * 8);
        const u32x4 rKD0 = *(const u32x4*)(kd + lane * 8), rKD1 = *(const u32x4*)(kd + 512 + lane * 8);
        const u32x4 rCQ0 = *(const u32x4*)(cc + lane * 8), rCQ1 = lane < 48 ? *(const u32x4*)(cc + 512 + lane * 8) : z, rCKV = *(const u32x4*)(cc + 896 + lane * 8);
        const u32x4 rPE = lane < 8 ? *(const u32x4*)(cc + 1408 + lane * 8) : z;
        const int p128 = (lane & 7) * 8, p64 = (lane & 3) * 8;
        const float* ct128 = c128 + (p128 < 32 ? grow : gcol) * 32 + (p128 & 31); const float* st128 = ct128 + 4096;
        const float* ct64 = c64 + (p64 < 16 ? grow : gcol) * 16 + (p64 & 15); const float* st64 = ct64 + 2048;
        const u32x4 oKA = norm_group<16>(rKA, gka, lat, ct128, st128, lane);
        const u32x4 oKB0 = norm_group<16>(rKB0, gkb, false, ct128, st128, lane), oKB1 = norm_group<16>(rKB1, gkb, false, ct128, st128, lane);
        const u32x4 oKD0 = norm_group<8>(rKD0, gkd, lat, ct64, st64, lane), oKD1 = norm_group<8>(rKD1, gkd, lat, ct64, st64, lane);
        const u32x4 oPE = norm_group<8>(rPE, gpe, lat, ct64, st64, lane);
        if (lane < 32) *(u32x4*)(ka + lane * 8) = oKA;
        *(u32x4*)(kb + lane * 8) = oKB0; *(u32x4*)(kb + 512 + lane * 8) = oKB1;
        *(u32x4*)(kd + lane * 8) = oKD0; *(u32x4*)(kd + 512 + lane * 8) = oKD1;
        if (lane < 8) *(u32x4*)(cc + 1408 + lane * 8) = oPE;
        {
            float x0[8], x1[8], xk[8]; unpack8(rCQ0, x0); unpack8(rCQ1, x1); unpack8(rCKV, xk);
            float s0 = 0.f, sk = 0.f;
#pragma unroll
            for (int q = 0; q < 8; ++q) { s0 += x0[q] * x0[q] + x1[q] * x1[q]; sk += xk[q] * xk[q]; }
            s0 = wave_sum(s0); sk = wave_sum(sk);
            const float r0 = __builtin_amdgcn_rsqf(s0 * (1.0f / 896.f) + EPS), rk = __builtin_amdgcn_rsqf(sk * (1.0f / 512.f) + EPS);
            const f32x4 ga = *(const f32x4*)gq0, gb = *(const f32x4*)(gq0 + 4), gc = *(const f32x4*)gq1, gd = *(const f32x4*)(gq1 + 4), ge = *(const f32x4*)gkv, gf = *(const f32x4*)(gkv + 4);
#pragma unroll
            for (int q = 0; q < 4; ++q) { x0[q] *= r0 * ga[q]; x0[4 + q] *= r0 * gb[q]; x1[q] *= r0 * gc[q]; x1[4 + q] *= r0 * gd[q]; xk[q] *= rk * ge[q]; xk[4 + q] *= rk * gf[q]; }
            *(u32x4*)(cc + lane * 8) = pack8(x0); if (lane < 48) *(u32x4*)(cc + 512 + lane * 8) = pack8(x1); *(u32x4*)(cc + 896 + lane * 8) = pack8(xk);
        }
    }
}

__device__ __forceinline__ void phase_post2(const Args& a, int l, const int wv0) {
    int tid_ = wv0 * 64 + lane_id(); asm volatile("" : "+v"(tid_)); const int tid = tid_, lane = tid & 63, wv = blockIdx.x * 8 + (tid >> 6);
    const float* gkn = a.in[I_KNNOPE] + l * 128 + (lane & 15) * 8;
    for (int row = wv; row < MTOT; row += GRID * 8) {
        const bf16_t* kv = (const bf16_t*)(a.ws + WS_KVUP) + (size_t)row * 2048 + (lane >> 4) * 256 + (lane & 15) * 8;
        bf16_t* kc = (bf16_t*)(a.ws + WS_KC) + (size_t)row * 1536;
        const u32x4 r0 = *(const u32x4*)kv, r1 = *(const u32x4*)(kv + 1024);
        const u32x4 pe = *(const u32x4*)((const bf16_t*)(a.ws + WS_CC) + (size_t)row * 1536 + 1408 + (lane & 7) * 8);
        const u32x4 o0 = norm_group<16>(r0, gkn, false, gkn, gkn, lane), o1 = norm_group<16>(r1, gkn, false, gkn, gkn, lane);
        *(u32x4*)(kc + (lane >> 4) * 192 + (lane & 15) * 8) = o0; *(u32x4*)(kc + (4 + (lane >> 4)) * 192 + (lane & 15) * 8) = o1;
        *(u32x4*)(kc + (lane >> 3) * 192 + 128 + (lane & 7) * 8) = pe;
    }
}

__device__ __forceinline__ void phase_attn(const Args& a, int l, LAS unsigned char* lds, bool ctx_out, const int wv0) {
    const int c = blockIdx.x, xcd = c & 7, rank = c >> 3;
    const float* bnd = (const float*)(a.ws + WS_BND) + l * 32;
    const float* rope = (const float*)(a.ws + WS_ROPE);
    const bf16_t* QA = (const bf16_t*)(a.ws + WS_QA); const bf16_t* KA = (const bf16_t*)(a.ws + WS_KA); const bf16_t* VA = (const bf16_t*)(a.ws + WS_VA);
    const bf16_t* QB = (const bf16_t*)(a.ws + WS_QB); const bf16_t* KB = (const bf16_t*)(a.ws + WS_KB); const bf16_t* VB = (const bf16_t*)(a.ws + WS_VB);
    const bf16_t* QD = (const bf16_t*)(a.ws + WS_QD); const bf16_t* KD = (const bf16_t*)(a.ws + WS_KD); const bf16_t* VD = (const bf16_t*)(a.ws + WS_VD);
    const bf16_t* QC = (const bf16_t*)(a.ws + WS_QUP); const bf16_t* KC = (const bf16_t*)(a.ws + WS_KC); const bf16_t* VC = (const bf16_t*)(a.ws + WS_KVUP);
    const bf16_t* G4 = (const bf16_t*)(a.ws + WS_G4); bf16_t* Y = (bf16_t*)(a.ws + WS_Y); float* OD = (float*)(a.ws + WS_OD);
    const float li_[4] = {0.2f, 0.35550906759096934f, 0.4707130183435842f, 0.5560582041556406f};
#ifndef ATTK
#define ATTK -1
#endif
    if (ATTK < 0 || ATTK == 0)
    for (int pass = 0; pass < 6; ++pass) {
        const int rnd = pass >> 1, i = pass & 1;
        att::AU u; int b, h; size_t row0;
        if (rnd < 2) { const int bh = xcd + 8 * rnd; b = bh >> 3; h = bh & 7; row0 = (size_t)b * SEQ + rank * 256; u.nlat = 128; u.nt = 132; u.qrope = 1; u.tpos0 = rank * 256; }
        else { if (!ctx_out || c < 48 || c >= 64) break; const int bh = c - 48; b = bh >> 3; h = bh & 7; row0 = (size_t)MLAT + b * CTXL; u.nlat = 0; u.nt = 4; u.qrope = 0; u.tpos0 = 0; }
        const int col = h * 128 + i * 64;
        u.Q = QD + row0 * 1024 + col; u.ldq = 1024;
        u.Kl = KD + (size_t)b * SEQ * 1024 + col; u.Vl = VD + (size_t)b * SEQ * 1024 + h * 128;
        u.Kc = KD + ((size_t)MLAT + b * CTXL) * 1024 + col; u.Vc = VD + ((size_t)MLAT + b * CTXL) * 1024 + h * 128;
        u.ldk = 1024; u.ldv = 1024; u.C = 0.125f * LOG2E; u.MC = bnd[17]; u.sinkL = -1e30f; u.m0 = 0; u.m1 = 0; u.rpb = nullptr;
        u.gq = a.in[I_QND] + l * 64; u.gq2 = nullptr; u.rope = rope;
        u.o0 = OD + row0 * 2048 + h * 256; u.subw = a.in[I_SUBLN] + l * 128; u.lam = bnd[18]; u.om = 1.0f - li_[l];
        if (i == 0) { u.out_mode = 1; u.out = OD + row0 * 2048 + h * 256; u.gate = nullptr; u.ldo = 2048; }
        else { u.out_mode = 2; u.out = Y + row0 * 4096 + 3072 + h * 128; u.gate = G4 + row0 * 4096 + 3072 + h * 128; u.ldo = 4096; }
        att::attn_unit<64, 0>(u, lds, wv0);
    }
    if (ATTK < 0 || ATTK == 1)
    for (int rnd = 0; rnd < 3; ++rnd) {
        att::AU u; int b, h; size_t row0;
        if (rnd < 2) { const int bh = xcd + 8 * rnd; b = bh >> 3; h = bh & 7; row0 = (size_t)b * SEQ + rank * 256; u.nlat = 128; u.nt = 132; u.qrope = 1; u.tpos0 = rank * 256; }
        else { if (!ctx_out || c < 32 || c >= 48) break; const int bh = c - 32; b = bh >> 3; h = bh & 7; row0 = (size_t)MLAT + b * CTXL; u.nlat = 0; u.nt = 4; u.qrope = 0; u.tpos0 = 0; }
        u.Q = QC + row0 * 1536 + h * 192; u.ldq = 1536;
        u.Kl = KC + (size_t)b * SEQ * 1536 + h * 192; u.Vl = VC + (size_t)b * SEQ * 2048 + h * 256 + 128;
        u.Kc = KC + ((size_t)MLAT + b * CTXL) * 1536 + h * 192; u.Vc = VC + ((size_t)MLAT + b * CTXL) * 2048 + h * 256 + 128;
        u.ldk = 1536; u.ldv = 2048; u.C = 0.07216878364870323f * LOG2E; u.MC = bnd[16]; u.sinkL = -1e30f; u.m0 = 0; u.m1 = 0; u.rpb = nullptr;
        u.gq = a.in[I_QNNOPE] + l * 128; u.gq2 = a.in[I_QNPE] + l * 64; u.rope = rope;
        u.o0 = nullptr; u.subw = nullptr; u.lam = 0.f; u.om = 0.f;
        u.out_mode = 0; u.out = Y + row0 * 4096 + 2048 + h * 128; u.gate = G4 + row0 * 4096 + 2048 + h * 128; u.ldo = 4096;
        att::attn_unit<192, 0>(u, lds, wv0);
    }
    if (ATTK < 0 || ATTK >= 2) {
        unsigned* qc = (unsigned*)(a.ws + WS_CTL) + 8192 + l * 128;
        volatile LAS unsigned* misc = (volatile LAS unsigned*)(lds + LDS_MISC);
        const unsigned qlen = ctx_out ? 132u : 128u;
        for (;;) {
            if (wv0 == 0 && lane_id() == 0) {
                unsigned pk = 0xFFFFFFFFu;
                for (int k = 0; k < 8; ++k) { const int x = (xcd + k) & 7; const unsigned v = xb_add(qc + x * 16, 1u); if (v < qlen) { pk = (unsigned)x * 256u + v; break; } }
                misc[8] = pk;
            }
            __syncthreads();
            const unsigned pk = (unsigned)__builtin_amdgcn_readfirstlane((int)misc[8]);
            if (pk == 0xFFFFFFFFu) break;
            const int h = (int)(pk >> 8), id = (int)(pk & 255u);
            att::AU u; size_t row0;
            if (id < 64 || id == 128 || id == 129) {
                int b, kstart = 0, q0 = 0;
                if (id < 64) { b = id >> 5; q0 = (id & 31) * 256; row0 = (size_t)b * SEQ + q0;
                    kstart = q0 - 128 < 0 ? 0 : q0 - 128; const int kend = q0 + 384 > SEQ ? SEQ : q0 + 384; u.nlat = (kend - kstart) >> 6; u.nt = u.nlat + 4; u.qrope = 1; u.tpos0 = q0; }
                else { b = id & 1; row0 = (size_t)MLAT + b * CTXL; u.nlat = 0; u.nt = 4; u.qrope = 0; u.tpos0 = 0; }
                const int kvh = h >> 2;
                u.Q = QA + row0 * 1024 + h * 128; u.ldq = 1024;
                u.Kl = KA + ((size_t)b * SEQ + kstart) * 256 + kvh * 128; u.Vl = VA + ((size_t)b * SEQ + kstart) * 256 + kvh * 128;
                u.Kc = KA + ((size_t)MLAT + b * CTXL) * 256 + kvh * 128; u.Vc = VA + ((size_t)MLAT + b * CTXL) * 256 + kvh * 128;
                u.ldk = 256; u.ldv = 256; u.C = 0.08838834764831845f * LOG2E; u.MC = bnd[h]; u.sinkL = bnd[19 + h]; u.m0 = kstart - q0; u.m1 = 0; u.rpb = nullptr;
                u.gq = a.in[I_QNA] + l * 128; u.gq2 = nullptr; u.rope = rope;
                u.o0 = nullptr; u.subw = nullptr; u.lam = 0.f; u.om = 0.f;
                u.out_mode = 0; u.out = Y + row0 * 4096 + h * 128; u.gate = G4 + row0 * 4096 + h * 128; u.ldo = 4096;
                att::attn_unit<128, 1>(u, lds, wv0);
            } else {
                int b, krow0 = 0, rg = 0;
                if (id < 128) { b = (id - 64) >> 5; rg = id & 31; row0 = (size_t)b * SEQ + rg * 256;
                    krow0 = 4 * rg - 4 < 0 ? 0 : 4 * rg - 4; u.nlat = (rg == 0 || rg == 31) ? 8 : 12; u.nt = u.nlat + 4; }
                else { b = id & 1; row0 = (size_t)MLAT + b * CTXL; u.nlat = 0; u.nt = 4; }
                u.Q = QB + row0 * 1024 + h * 128; u.ldq = 1024;
                u.Kl = KB + ((size_t)b * SEQ + krow0 * 64) * 1024 + h * 128; u.Vl = VB + ((size_t)b * SEQ + krow0 * 64) * 1024 + h * 128;
                u.Kc = KB + ((size_t)MLAT + b * CTXL) * 1024 + h * 128; u.Vc = VB + ((size_t)MLAT + b * CTXL) * 1024 + h * 128;
                u.ldk = 1024; u.ldv = 1024; u.C = 0.08838834764831845f * LOG2E; u.MC = bnd[8 + h]; u.sinkL = -1e30f; u.m0 = 4 * rg; u.m1 = krow0;
                u.rpb = a.in[I_RPB] + ((size_t)l * 8 + h) * 465;
                u.gq = a.in[I_QNB] + l * 128; u.gq2 = nullptr; u.rope = rope; u.qrope = 0; u.tpos0 = 0;
                u.o0 = nullptr; u.subw = nullptr; u.lam = 0.f; u.om = 0.f;
                u.out_mode = 0; u.out = Y + row0 * 4096 + 1024 + h * 128; u.gate = G4 + row0 * 4096 + 1024 + h * 128; u.ldo = 4096;
                att::attn_unit<128, 2>(u, lds, wv0);
            }
        }
    }
}

__device__ __forceinline__ Args load_args(const Args& a) {
#if defined(__HIP_DEVICE_COMPILE__)
    typedef const Args __attribute__((address_space(4)))* KArgsP;
    KArgsP p = (KArgsP)__builtin_amdgcn_kernarg_segment_ptr();
    asm volatile("" : "+s"(p));
    Args b;
#pragma unroll
    for (int i = 0; i < 31; ++i) b.in[i] = p->in[i];
    b.out = p->out; b.ws = p->ws; b.ph_lo = p->ph_lo; b.ph_hi = p->ph_hi;
    return b;
#else
    return a;
#endif
}

constexpr int N_PHASES = 2 + 9 * DEPTH;
__global__ void __launch_bounds__(NTHR, 2) mega_fwd(Args a) {
    extern __shared__ __attribute__((aligned(16))) unsigned char lds_raw[];
    LAS unsigned char* lds = (LAS unsigned char*)lds_raw;
    volatile LAS unsigned* misc = (volatile LAS unsigned*)(lds + LDS_MISC);
    const int wv0 = __builtin_amdgcn_readfirstlane((int)threadIdx.x >> 6);
    if (threadIdx.x < 4) misc[threadIdx.x] = 0u;
    __syncthreads();
    const int lo = a.ph_lo, hi = a.ph_hi;
    XcdBarrier bar; bar.bar = (unsigned*)(a.ws + WS_CTL); bar.x = 0; bar.st = misc;
    if (hi - lo > 1) bar = xcd_barrier_post((unsigned*)(a.ws + WS_CTL), misc, wv0);
#ifndef TESTKIND
#define TESTKIND -1
#endif
#define KIND_OK(kind) (TESTKIND < 0 || TESTKIND == (kind))
#define IN(k) (lo <= (k) && (k) < hi)
#define SEAM(k) do { if (IN((k) + 1)) xcd_barrier(bar, wv0); } while (0)
#ifndef PROBE_K1
#define PROBE_K1 -1
#endif
#ifndef PROBE_K2
#define PROBE_K2 -1
#endif
    unsigned long long pt0 = 0, pacc1 = 0;
#ifndef PROBE_MASK
#define PROBE_MASK 0
#endif
#define PT_BEGIN(kind) do { if ((PROBE_MASK >> (kind)) & 1) pt0 = __builtin_amdgcn_s_memrealtime(); } while (0)
#define PT_END(kind) do { if ((PROBE_MASK >> (kind)) & 1) pacc1 += __builtin_amdgcn_s_memrealtime() - pt0; } while (0)
#define PA() load_args(a)
    if (KIND_OK(0) && IN(0)) { PT_BEGIN(0); phase_pre0(PA(), lds, wv0); SEAM(0); PT_END(0); }
    if (KIND_OK(1) && IN(1)) { PT_BEGIN(1); phase_prologue(PA(), lds, wv0); phase_mods(PA(), wv0); SEAM(1); PT_END(1); }
    for (int l = 0; l < DEPTH; ++l) {
        const Args al = PA(); float* XB = (float*)(al.ws + WS_XBUF);
        const int pb = 2 + 9 * l;
        const bool ctx_out = l < DEPTH - 1;
        const float* xin = l == 0 ? al.in[I_X] : XB;
        const float* cin = l <= 1 ? al.in[I_CTX] : XB + (size_t)MLAT * 4096;
        float* xout = l == DEPTH - 1 ? al.out : XB; float* cout = XB + (size_t)MLAT * 4096;
        if (KIND_OK(2) && IN(pb + 0)) { PT_BEGIN(2); phase_xnorm(PA(), l, xin, cin, cout, wv0); SEAM(pb + 0); PT_END(2); }
        if (KIND_OK(3) && IN(pb + 1)) { PT_BEGIN(3); const Args b = PA();
            { pg8::Gemm g{b.ws + WS_H, (const bf16_t*)(b.ws + WS_WIN) + (size_t)l * NT_BF * 256 * 4096, MTOT, NT_BF * 256, 4096, 8192, 8192};
              pg8::StaticOrder S; S.init(MTOT, NT_BF * 256, (int)gridDim.x, (int)blockIdx.x);
              EpiG1 E{b.ws, 0, nullptr, nullptr}; pg8::NoHook nh;
              pg8::gemm_phase<false>(lds, g, S, E, nh, wv0); }
            { pg8::Gemm g{b.ws + WS_H8, b.ws + WS_W8 + (size_t)l * NT_F8 * 256 * 4096, MTOT, NT_F8 * 256, 4096, 4096, 4096};
              pg8::DynTailOrder S; S.S.init(MTOT, NT_F8 * 256, (int)gridDim.x, (int)blockIdx.x); S.R = 26; S.ctr = (unsigned*)(b.ws + WS_CTL) + 8192 + 512 + l * 128;
              EpiG1 E{b.ws, 1, (const float*)(b.ws + WS_HS), (const float*)(b.ws + WS_WSC) + (size_t)l * NINP}; pg8::NoHook nh;
              pg8::gemm_phase<true>(lds, g, S, E, nh, wv0); }
            SEAM(pb + 1); PT_END(3); }
        if (KIND_OK(4) && IN(pb + 2)) { PT_BEGIN(4); phase_post1(PA(), l, wv0); SEAM(pb + 2); PT_END(4); }
        if (KIND_OK(5) && IN(pb + 3)) { PT_BEGIN(5); const Args b = PA();
            { pg8::Gemm g{(const bf16_t*)(b.ws + WS_CC), (const bf16_t*)(b.ws + WS_WQ) + (size_t)l * 1536 * 896, MTOT, 1536, 896, 1536 * 2, 896 * 2};
              pg8::StaticOrder S; S.init(MTOT, 1536, (int)gridDim.x, (int)blockIdx.x);
              EpiPlain E{(bf16_t*)(b.ws + WS_QUP), 1536}; pg8::NoHook nh;
              pg8::gemm_phase<false>(lds, g, S, E, nh, wv0); }
            { pg8::Gemm g{(const bf16_t*)(b.ws + WS_CC) + 896, (const bf16_t*)(b.ws + WS_WKV) + (size_t)l * 2048 * 512, MTOT, 2048, 512, 1536 * 2, 512 * 2};
              pg8::StaticOrder S; S.init(MTOT, 2048, (int)gridDim.x, (int)((blockIdx.x + 112u) & 255u));
              EpiPlain E{(bf16_t*)(b.ws + WS_KVUP), 2048}; pg8::NoHook nh;
              pg8::gemm_phase<false>(lds, g, S, E, nh, wv0); }
            SEAM(pb + 3); PT_END(5); }
        if (KIND_OK(6) && IN(pb + 4)) { PT_BEGIN(6); phase_post2(PA(), l, wv0); SEAM(pb + 4); PT_END(6); }
        if (KIND_OK(7) && IN(pb + 5)) { PT_BEGIN(7); phase_attn(PA(), l, lds, ctx_out, wv0); SEAM(pb + 5); PT_END(7); }
        if (KIND_OK(9) && IN(pb + 6)) { PT_BEGIN(9); const Args b = PA();
            { pg8::Gemm g{(const bf16_t*)(b.ws + WS_Y), (const bf16_t*)(b.ws + WS_WB) + (size_t)l * 4096 * 4096, MLAT, 4096, 4096, 8192, 8192};
              pg8::StaticOrder S; S.init(MLAT, 4096, (int)gridDim.x, (int)blockIdx.x);
              EpiMerge E{(const bf16_t*)(b.ws + WS_MG), (bf16_t*)(b.ws + WS_MERGED)}; HookMerge hk{(const bf16_t*)(b.ws + WS_MG)};
              pg8::gemm_phase<false>(lds, g, S, E, hk, wv0); }
            if (ctx_out) { pg8::Gemm g{(const bf16_t*)(b.ws + WS_Y), (const bf16_t*)(b.ws + WS_WB) + (size_t)l * 4096 * 4096, MTOT, 4096, 512, 8192, 8192};
              pg8::CtxSplitOrder S{(int)blockIdx.x};
              EpiCtxPart3 E{(const bf16_t*)(b.ws + WS_MG), (float*)(b.ws + WS_P3)}; pg8::NoHook nh;
              pg8::gemm_phase<false>(lds, g, S, E, nh, wv0); }
            SEAM(pb + 6); PT_END(9); }
        if (KIND_OK(10) && IN(pb + 7)) { PT_BEGIN(10); const Args b = PA();
            if (ctx_out) {
                const int tid = wv0 * 64 + lane_id(); const int r = blockIdx.x * 2 + (tid >> 8), c0 = (tid & 255) * 16;
                const float* P3 = (const float*)(b.ws + WS_P3) + (size_t)r * 4096 + c0;
                f32x4 sacc[4];
#pragma unroll
                for (int q = 0; q < 4; ++q) sacc[q] = *(const f32x4*)(P3 + q * 4);
                for (int kc = 1; kc < 8; ++kc)
#pragma unroll
                    for (int q = 0; q < 4; ++q) sacc[q] += *(const f32x4*)(P3 + (size_t)kc * MCTX * 4096 + q * 4);
                u32x4 w0, w1; w0.x = cvt_pk_bf16(sacc[0][0], sacc[0][1]); w0.y = cvt_pk_bf16(sacc[0][2], sacc[0][3]); w0.z = cvt_pk_bf16(sacc[1][0], sacc[1][1]); w0.w = cvt_pk_bf16(sacc[1][2], sacc[1][3]);
                w1.x = cvt_pk_bf16(sacc[2][0], sacc[2][1]); w1.y = cvt_pk_bf16(sacc[2][2], sacc[2][3]); w1.z = cvt_pk_bf16(sacc[3][0], sacc[3][1]); w1.w = cvt_pk_bf16(sacc[3][2], sacc[3][3]);
                bf16_t* mo = (bf16_t*)(b.ws + WS_MERGED) + (size_t)(MLAT + r) * 4096 + c0; *(u32x4*)mo = w0; *(u32x4*)(mo + 8) = w1;
            }
            pg8::Gemm g{(const bf16_t*)(b.ws + WS_MERGED), (const bf16_t*)(b.ws + WS_WO) + (size_t)l * 4096 * 4096, MLAT, 4096, 4096, 8192, 8192};
            pg8::StaticOrder S; S.init(MLAT, 4096, (int)gridDim.x, (int)blockIdx.x);
            EpiResid E{xin, cin, xout, cout, (const float*)(b.ws + WS_MODS) + l * 36864}; pg8::NoHook nh;
            pg8::gemm_phase<false>(lds, g, S, E, nh, wv0);
            if (ctx_out || l + 1 < DEPTH) SEAM(pb + 7); PT_END(10); }
        if (KIND_OK(8) && ctx_out && IN(pb + 8)) { PT_BEGIN(8); const Args b = PA();
            pg8::Gemm g{(const bf16_t*)(b.ws + WS_MERGED), (const bf16_t*)(b.ws + WS_WO) + (size_t)l * 4096 * 4096, MTOT, 4096, 512, 8192, 8192};
            pg8::CtxSplitOrder S{(int)blockIdx.x};
            EpiCtxPart4 E{(float*)(b.ws + WS_P4)}; pg8::NoHook nh;
            pg8::gemm_phase<false>(lds, g, S, E, nh, wv0); SEAM(pb + 8); PT_END(8); }
    }
    if (PROBE_MASK != 0 && blockIdx.x == 0) {
        const unsigned long long t0 = __builtin_amdgcn_s_memrealtime();
        while (__builtin_amdgcn_s_memrealtime() - t0 < pacc1) __builtin_amdgcn_s_sleep(8);
    }
#undef IN
#undef SEAM
#undef PA
}

extern "C" void kernel_launch(void* const* d_in, const int* in_sizes, int n_in, void* d_out, int out_size, void* d_ws, size_t ws_size, hipStream_t stream) {
    static int ready = 0;
    if (ready == 0) {
        if (n_in != 31 || in_sizes[0] != MLAT * DM || out_size != MLAT * DM || ws_size < WS_END) {
            fprintf(stderr, "kernel_launch: shape mismatch: n_in %d in0 %d out %d ws %zu (need >= %zu)\n", n_in, n_in > 0 ? in_sizes[0] : -1, out_size, ws_size, (size_t)WS_END); ready = -1; return; }
        if (hipFuncSetAttribute((const void*)mega_fwd, hipFuncAttributeMaxDynamicSharedMemorySize, LDS_BYTES) != hipSuccess) { fprintf(stderr, "kernel_launch: hipFuncSetAttribute failed\n"); ready = -1; return; }
        int per_cu = 0, dev = 0, cus = 0;
        (void)hipGetDevice(&dev); (void)hipDeviceGetAttribute(&cus, hipDeviceAttributeMultiprocessorCount, dev);
        if (hipOccupancyMaxActiveBlocksPerMultiprocessor(&per_cu, (const void*)mega_fwd, NTHR, LDS_BYTES) != hipSuccess || per_cu < 1 || cus < GRID)
            fprintf(stderr, "kernel_launch: note: occupancy query %d blocks/CU, %d CUs (grid %d needs one resident block per CU)\n", per_cu, cus, GRID);
        (void)hipGetLastError();
        ready = 1;
    }
    if (ready < 0) return;
    (void)hipMemsetAsync((char*)d_ws + WS_CTL, 0, CTL_ZERO_BYTES, stream);
    Args a{};
    for (int i = 0; i < 31; ++i) a.in[i] = (const float*)d_in[i];
    a.out = (float*)d_out; a.ws = (unsigned char*)d_ws;
#if MK_LAUNCH_PER_PHASE
    for (int p = 0; p < N_PHASES; ++p) { a.ph_lo = p; a.ph_hi = p + 1; hipLaunchKernelGGL(mega_fwd, dim3(GRID), dim3(NTHR), LDS_BYTES, stream, a); }
#else
    a.ph_lo = 0; a.ph_hi = N_PHASES;
    hipLaunchKernelGGL(mega_fwd, dim3(GRID), dim3(NTHR), LDS_BYTES, stream, a);
#endif
    const hipError_t le = hipPeekAtLastError();
    if (le != hipSuccess) fprintf(stderr, "kernel_launch: launch failed: %s\n", hipGetErrorName(le));
}
```
